# Optimizing an MI355X kernel written in HIP

```python
import jax, jax.numpy as jnp
from jax import lax
import numpy as np

D_MODEL = 1024
BATCH = 8
SEQ = 2048
DEPTH = 1

GRID_W = 64
CTX_LEN = 256
M_HEADS = 4
M_HEAD_DIM = D_MODEL // M_HEADS
M_WIDTH = M_HEADS * M_HEAD_DIM
P_GROUPS = 4
P_WIDTH = D_MODEL // 2
P_GROUP_DIM = P_WIDTH // P_GROUPS
POOL_WINDOWS = (2, 4, 8, 16)
CHUNK = 128
N_DIR = 2
N_GATE_COLS = N_DIR * 2 * M_HEADS
N_BRANCH = 2
IN_SIZES = (M_WIDTH, M_WIDTH, M_WIDTH, M_WIDTH, M_WIDTH, N_GATE_COLS, P_WIDTH, P_WIDTH, N_BRANCH * D_MODEL)
IN_WIDTH = sum(IN_SIZES)
EPS = 1e-6
M_INIT = -1e30

kernel_name = 'hybrid_mlstm_pool_flow_block'


def _split_proj(p):
    names = ('q', 'k', 'v', 'o', 'z_m', 'gates', 'p', 'z_p', 'g_branch')
    offs = [int(o) for o in np.cumsum(IN_SIZES)[:-1]]
    return dict(zip(names, jnp.split(p, offs, axis=-1)))


def _rmsnorm(x, w):
    xf = x.astype(jnp.float32)
    y = xf * lax.rsqrt(jnp.mean(xf * xf, axis=-1, keepdims=True) + EPS)
    return (y * w.astype(jnp.float32)).astype(x.dtype)


def _adaln(cvec, w, b):
    m = jax.nn.silu(cvec) @ w + b
    return jnp.split(m, 3, axis=-1)


def _zero_state(b):
    return (jnp.zeros((b, M_HEADS, M_HEAD_DIM, M_HEAD_DIM), jnp.float32),
            jnp.zeros((b, M_HEADS, M_HEAD_DIM), jnp.float32),
            jnp.full((b, M_HEADS), M_INIT, jnp.float32))


def _mlstm_inputs(parts, gate_b):
    b, t, _ = parts['q'].shape
    def heads(a):
        return a.reshape(b, t, M_HEADS, M_HEAD_DIM).transpose(0, 2, 1, 3).astype(jnp.float32)
    q = heads(parts['q'])
    k = heads(parts['k']) * (M_HEAD_DIM ** -0.5)
    v = heads(parts['v'])
    pre = parts['gates'].astype(jnp.float32) + gate_b.astype(jnp.float32)
    pre = pre.reshape(b, t, N_DIR, 2, M_HEADS).transpose(2, 3, 0, 4, 1)
    log_i = pre[:, 0]
    log_f = jax.nn.log_sigmoid(pre[:, 1])
    return q, k, v, log_i, log_f


def _mlstm_chunk(carry, xs):
    C, n, m = carry
    q, k, v, b, li = xs
    L = q.shape[2]
    causal = jnp.tril(jnp.ones((L, L), dtype=bool))
    logw = jnp.where(causal, b[..., :, None] - b[..., None, :] + li[..., None, :], -jnp.inf)
    inter = b + m[..., None]
    m_t = jnp.maximum(inter, jnp.max(logw, axis=-1))
    w_intra = jnp.exp(logw - m_t[..., None])
    w_inter = jnp.exp(inter - m_t)
    s = jnp.einsum('bhtk,bhsk->bhts', q, k) * w_intra
    num = w_inter[..., None] * jnp.einsum('bhvk,bhtk->bhtv', C, q) + jnp.einsum('bhts,bhsv->bhtv', s, v)
    den = w_inter * jnp.einsum('bhk,bhtk->bht', n, q) + jnp.sum(s, axis=-1)
    h = num / jnp.maximum(jnp.abs(den), jnp.exp(-m_t))[..., None]
    b_end = b[..., -1]
    w_end = b_end[..., None] - b + li
    m_new = jnp.maximum(b_end + m, jnp.max(w_end, axis=-1))
    decay = jnp.exp(b_end + m - m_new)
    e = jnp.exp(w_end - m_new[..., None])
    C_new = decay[..., None, None] * C + jnp.einsum('bhs,bhsv,bhsk->bhvk', e, v, k)
    n_new = decay[..., None] * n + jnp.einsum('bhs,bhsk->bhk', e, k)
    return (C_new, n_new, m_new), h


def _mlstm_scan(q, k, v, log_i, log_f, state):
    b, h, t, d = q.shape
    nc = t // CHUNK
    def chunks(a):
        return jnp.moveaxis(a.reshape(a.shape[:2] + (nc, CHUNK) + a.shape[3:]), 2, 0)
    bcum = jnp.cumsum(chunks(log_f), axis=-1)
    state, out = lax.scan(_mlstm_chunk, state, (chunks(q), chunks(k), chunks(v), bcum, chunks(log_i)))
    return jnp.moveaxis(out, 0, 2).reshape(b, h, t, d), state


def _bi_mlstm(q, k, v, log_i, log_f, st_f, st_b):
    rev = lambda a: jnp.flip(a, axis=2)
    h_f, st_f = _mlstm_scan(q, k, v, log_i[0], log_f[0], st_f)
    h_b, st_b = _mlstm_scan(rev(q), rev(k), rev(v), rev(log_i[1]), rev(log_f[1]), st_b)
    return h_f + rev(h_b), st_f, st_b


def _mlstm_branch(h, parts, head_norm_w, branch_m_w):
    b, nh, t, d = h.shape
    hn = h * lax.rsqrt(jnp.mean(h * h, axis=-1, keepdims=True) + EPS)
    hn = hn.transpose(0, 2, 1, 3).reshape(b, t, M_WIDTH).astype(parts['o'].dtype) * head_norm_w
    y = hn * jax.nn.sigmoid(parts['o']) * jax.nn.silu(parts['z_m'])
    return y @ branch_m_w


def _box_mean(x, w, axis):
    L = x.shape[axis]
    cs = jnp.cumsum(x.astype(jnp.float32), axis=axis)
    cs = jnp.concatenate([jnp.zeros_like(lax.slice_in_dim(cs, 0, 1, axis=axis)), cs], axis=axis)
    pos = np.arange(L)
    lo = np.clip(pos - w // 2, 0, L)
    hi = np.clip(pos + w - w // 2, 0, L)
    s = jnp.take(cs, hi, axis=axis) - jnp.take(cs, lo, axis=axis)
    shape = [1] * x.ndim
    shape[axis] = L
    cnt = (hi - lo).astype(np.float32).reshape(shape)
    return (s / cnt).astype(x.dtype)


def _pool_branch(parts, grid_shape, axes, pool_w, pool_scale, branch_p_w):
    p = parts['p']
    b, t, _ = p.shape
    pg = p.reshape((b,) + grid_shape + (P_GROUPS, P_GROUP_DIM))
    groups = []
    for g, w in enumerate(POOL_WINDOWS):
        a = pg[..., g, :]
        for ax in axes:
            a = _box_mean(a, w, ax)
        groups.append(a)
    mixed = (jnp.stack(groups, axis=-2) - pg).reshape(b, t, P_GROUPS, P_GROUP_DIM)
    mixed = jnp.einsum('btgc,gcd->btgd', mixed, pool_w).reshape(b, t, P_WIDTH)
    y = mixed * pool_scale * jax.nn.silu(parts['z_p'])
    return y @ branch_p_w


def _merge(parts, y_m, y_p, out_w):
    g_m, g_p = jnp.split(parts['g_branch'], 2, axis=-1)
    return (jax.nn.sigmoid(g_m) * y_m + jax.nn.sigmoid(g_p) * y_p) @ out_w


def _hybrid_layer(x, xc, mod_x, mod_c, norm_w, in_w, gate_b, head_norm_w, pool_w, pool_scale,
                  branch_m_w, branch_p_w, out_w, update_ctx):
    b, t, _ = x.shape
    rows = t // GRID_W
    shift, scale, gate = [m[:, None, :] for m in mod_x]
    shift_c, scale_c, gate_c = mod_c
    parts_x = _split_proj((_rmsnorm(x, norm_w) * (1 + scale) + shift) @ in_w)
    parts_c = _split_proj((_rmsnorm(xc, norm_w) * (1 + scale_c) + shift_c) @ in_w)
    zero = _zero_state(b)
    qc, kc, vc, lic, lfc = _mlstm_inputs(parts_c, gate_b)
    h_c, st_f, st_b = _bi_mlstm(qc, kc, vc, lic, lfc, zero, zero)
    qx, kx, vx, lix, lfx = _mlstm_inputs(parts_x, gate_b)
    h_x, _, _ = _bi_mlstm(qx, kx, vx, lix, lfx, st_f, st_b)
    y_m = _mlstm_branch(h_x, parts_x, head_norm_w, branch_m_w)
    y_p = _pool_branch(parts_x, (rows, GRID_W), (1, 2), pool_w, pool_scale, branch_p_w)
    x = x + gate * _merge(parts_x, y_m, y_p, out_w)
    if update_ctx:
        y_mc = _mlstm_branch(h_c, parts_c, head_norm_w, branch_m_w)
        y_pc = _pool_branch(parts_c, (xc.shape[1],), (1,), pool_w, pool_scale, branch_p_w)
        xc = xc + gate_c * _merge(parts_c, y_mc, y_pc, out_w)
    return x, xc


def setup_inputs(seed: int = 0) -> dict:
    key = jax.random.key(seed)
    ks = jax.random.split(key, 20)
    def nrm(k, shape, s):
        return jax.random.normal(k, shape, jnp.float32) * s
    i_b = nrm(ks[8], (DEPTH, N_DIR, 1, M_HEADS), 0.1)
    f_b = jnp.linspace(3.0, 6.0, M_HEADS, dtype=jnp.float32) + nrm(ks[9], (DEPTH, N_DIR, 1, M_HEADS), 0.1)
    return {
        'x': nrm(ks[0], (BATCH, SEQ, D_MODEL), 1.0),
        'c': nrm(ks[1], (BATCH, D_MODEL), 1.0),
        'ctx': nrm(ks[2], (BATCH, CTX_LEN, D_MODEL), 1.0),
        'c_ctx': nrm(ks[3], (D_MODEL,), 1.0),
        'norm_w': 1.0 + nrm(ks[4], (DEPTH, D_MODEL), 0.02),
        'ada_w': nrm(ks[5], (DEPTH, D_MODEL, 3 * D_MODEL), 0.5 * D_MODEL ** -0.5),
        'ada_b': nrm(ks[6], (DEPTH, 3 * D_MODEL), 0.01),
        'in_w': nrm(ks[7], (DEPTH, D_MODEL, IN_WIDTH), D_MODEL ** -0.5),
        'gate_b': jnp.concatenate([i_b, f_b], axis=2).reshape(DEPTH, N_GATE_COLS),
        'head_norm_w': 1.0 + nrm(ks[10], (DEPTH, M_WIDTH), 0.02),
        'pool_w': nrm(ks[11], (DEPTH, P_GROUPS, P_GROUP_DIM, P_GROUP_DIM), P_GROUP_DIM ** -0.5),
        'pool_scale': 1.0 + nrm(ks[12], (DEPTH, P_WIDTH), 0.1),
        'branch_m_w': nrm(ks[13], (DEPTH, M_WIDTH, D_MODEL), M_WIDTH ** -0.5),
        'branch_p_w': nrm(ks[14], (DEPTH, P_WIDTH, D_MODEL), P_WIDTH ** -0.5),
        'out_w': nrm(ks[15], (DEPTH, D_MODEL, D_MODEL), D_MODEL ** -0.5),
        'final_norm_w': 1.0 + nrm(ks[16], (D_MODEL,), 0.02),
    }


def reference(x, c, ctx, c_ctx, norm_w, ada_w, ada_b, in_w, gate_b, head_norm_w, pool_w, pool_scale,
              branch_m_w, branch_p_w, out_w, final_norm_w):
    xc = ctx
    for l in range(DEPTH):
        mod_x = _adaln(c, ada_w[l], ada_b[l])
        mod_c = _adaln(c_ctx, ada_w[l], ada_b[l])
        x, xc = _hybrid_layer(x, xc, mod_x, mod_c, norm_w[l], in_w[l], gate_b[l], head_norm_w[l],
                              pool_w[l], pool_scale[l], branch_m_w[l], branch_p_w[l], out_w[l],
                              l < DEPTH - 1)
    return _rmsnorm(x, final_norm_w)
```

```cpp
#include <hip/hip_runtime.h>
#include <hip/hip_cooperative_groups.h>
#include <cstdio>
namespace cg = cooperative_groups;

#ifndef MULTI_LAUNCH
#define MULTI_LAUNCH 1
#endif

#define LAS __attribute__((address_space(3)))
typedef unsigned short bf16_t;
typedef short bf16x8 __attribute__((ext_vector_type(8)));
typedef float f32x4 __attribute__((ext_vector_type(4)));
typedef unsigned u32x4 __attribute__((ext_vector_type(4)));
typedef unsigned u32x2 __attribute__((ext_vector_type(2)));

constexpr size_t MiB = 1024u * 1024u;
constexpr int LDS_BYTES = 155648;
constexpr int NWG = 256;
constexpr size_t OFF_AB = 0;
constexpr size_t OFF_BTPOOL = 32 * MiB;
constexpr size_t OFF_Q = 52 * MiB;
constexpr size_t OFF_K = 84 * MiB;
constexpr size_t OFF_VT = 116 * MiB;
constexpr size_t OFF_KC = 148 * MiB;
constexpr size_t OFF_VTC = 152 * MiB;
constexpr size_t OFF_P = 156 * MiB;
constexpr size_t OFF_PM = 148 * MiB;
constexpr size_t OFF_MX = 172 * MiB;
constexpr size_t OFF_CST2 = 188 * MiB;
constexpr size_t OFF_GB = 188 * MiB;
constexpr size_t OFF_WMT = 84 * MiB, OFF_WPT = 86 * MiB, OFF_WOT = 87 * MiB;
constexpr size_t OFF_MG = 116 * MiB;
constexpr size_t OFF_SMALL = 252 * MiB;
constexpr size_t OFF_GL = OFF_SMALL;
constexpr size_t OFF_SSQ = OFF_SMALL;
constexpr size_t OFF_GC = OFF_SMALL + 1 * MiB;
constexpr size_t OFF_NST = OFF_SMALL + 1 * MiB + 128 * 1024;
constexpr size_t OFF_MST = OFF_NST + 1 * MiB;
constexpr size_t OFF_MODP = OFF_MST + 4096;
constexpr size_t OFF_GATEV = OFF_MODP + 8 * 9 * 3072 * 4;

struct Params {
    const float *x, *c, *ctx, *c_ctx, *norm_w, *ada_w, *ada_b, *in_w, *gate_b, *head_norm_w, *pool_w, *pool_scale, *branch_m_w, *branch_p_w, *out_w, *final_norm_w;
    float* out; unsigned char* ws;
    int ph_lo, ph_hi;
};

__device__ __forceinline__ float bf_lo(unsigned w) { return __uint_as_float(w << 16); }
__device__ __forceinline__ float bf_hi(unsigned w) { return __uint_as_float(w & 0xffff0000u); }
__device__ __forceinline__ unsigned cvt_pk_bf16(float lo, float hi) { unsigned r; asm volatile("v_cvt_pk_bf16_f32 %0, %1, %2" : "=v"(r) : "v"(lo), "v"(hi)); return r; }
__device__ __forceinline__ float sigm(float x) { return 1.0f / (1.0f + __expf(-x)); }
__device__ __forceinline__ float siluf(float x) { return x / (1.0f + __expf(-x)); }

namespace pg8 {
constexpr int BM = 256, BK = 64, HALF = 128, HTB = HALF * BK * 2, STAGE_BYTES = 8 * HTB;
__device__ __forceinline__ int lds_byte(int r, int c) { const int st = (r >> 4) * 2 + (c >> 5), rr = r & 15, cc = c & 31, ob = rr * 64 + cc * 2; return st * 1024 + (ob ^ (((ob >> 9) & 1) << 5)); }
__device__ __forceinline__ void stage_rc(int b, int& R, int& C) { const int st = b / 1024, sb = b % 1024, swz = sb ^ (((sb >> 9) & 1) << 5); R = (st >> 1) * 16 + swz / 64; C = (st & 1) * 32 + (swz % 64) / 2; }
__device__ __forceinline__ int perm32(int rho) { const int n = rho >> 4, i = rho & 15; return 8 * (i >> 2) + 4 * n + (i & 3); }
struct Unit { int pm, pn; };
struct Gemm { const bf16_t* A; const bf16_t* Bt; int K; };

template <class Epi, class Sched>
__device__ __forceinline__ void gemm_phase(LAS unsigned char* lds, const Gemm g, const Sched& S, const Epi& E) {
    const int tid = threadIdx.x, wid = __builtin_amdgcn_readfirstlane(tid >> 6), lane = tid & 63, wr = wid >> 2, wc = wid & 3, fr = lane & 15, fq = lane >> 4;
    const int K = g.K, nt = K / BK;
    unsigned voffA[2], voffB[2];
#pragma unroll
    for (int i = 0; i < 2; ++i) { int R, C; stage_rc(tid * 16 + i * 8192, R, C); const int Rb = (R & ~31) + perm32(R & 31);
        voffA[i] = (unsigned)(R * K + C) * 2u; voffB[i] = (unsigned)(Rb * K + C) * 2u; }
    const size_t kstep = (size_t)(BK * 2);
    const size_t hstep = (size_t)HALF * K * 2;
    const size_t tstep = 2 * hstep;
    const unsigned ldsw = (unsigned)wid * 1024u;
    const int aoff = lds_byte(wr * 64 + fr, fq * 8), boff = lds_byte(wc * 32 + fr, fq * 8);
#define PG8_SA(b, h) (((b) * 2 + (h)) * HTB)
#define PG8_SB(b, h) ((4 + (b) * 2 + (h)) * HTB)
#define PG8_STAGE(bufoff, gbase, voff) do { _Pragma("unroll") for (int _i = 0; _i < 2; ++_i) \
        __builtin_amdgcn_global_load_lds((const unsigned*)((const char*)(gbase) + (voff)[_i]), (LAS unsigned*)(lds + (bufoff) + ldsw + _i * 8192), 16, 0, 0); } while (0)
#define PG8_LDA(dst, b, h) do { _Pragma("unroll") for (int m = 0; m < 4; ++m) _Pragma("unroll") for (int k = 0; k < 2; ++k) dst[m][k] = *(const LAS bf16x8*)(lds + PG8_SA(b, h) + aoff + m * 2048 + k * 1024); } while (0)
#define PG8_LDB(dst, b, h) do { _Pragma("unroll") for (int n = 0; n < 2; ++n) _Pragma("unroll") for (int k = 0; k < 2; ++k) dst[n][k] = *(const LAS bf16x8*)(lds + PG8_SB(b, h) + boff + n * 2048 + k * 1024); } while (0)
#define PG8_MMA(ai, bj, At, Bt) do { __builtin_amdgcn_s_setprio(1); _Pragma("unroll") for (int m = 0; m < 4; ++m) _Pragma("unroll") for (int n = 0; n < 2; ++n) _Pragma("unroll") for (int k = 0; k < 2; ++k) \
        acc[ai][bj][m][n] = __builtin_amdgcn_mfma_f32_16x16x32_bf16(Bt[n][k], At[m][k], acc[ai][bj][m][n], 0, 0, 0); __builtin_amdgcn_s_setprio(0); } while (0)
#define PG8_WAIT_V(n) asm volatile("s_waitcnt vmcnt(" #n ")" ::: "memory")
#define PG8_WAIT_L(n) asm volatile("s_waitcnt lgkmcnt(" #n ")" ::: "memory")
#define PG8_BAR __builtin_amdgcn_s_barrier()
#define PG8_SCHED __builtin_amdgcn_sched_barrier(0)
    Unit cur, nxt; int ui = 0;
    if (!S.next(0, cur)) return;
    f32x4 acc[2][2][4][2];
#pragma unroll
    for (int a = 0; a < 2; ++a)
#pragma unroll
        for (int b = 0; b < 2; ++b)
#pragma unroll
            for (int m = 0; m < 4; ++m)
#pragma unroll
                for (int n = 0; n < 2; ++n) acc[a][b][m][n] = (f32x4){0.f, 0.f, 0.f, 0.f};
    bf16x8 At[4][2], B0[2][2], B1[2][2];
    const char* cA = (const char*)g.A + (size_t)cur.pm * tstep; const char* cB = (const char*)g.Bt + (size_t)cur.pn * tstep;
    PG8_STAGE(PG8_SB(0, 0), cB, voffB); PG8_STAGE(PG8_SA(0, 0), cA, voffA); PG8_STAGE(PG8_SB(0, 1), cB + hstep, voffB); PG8_STAGE(PG8_SA(0, 1), cA + hstep, voffA);
    if (wr == 1) PG8_BAR;
    PG8_WAIT_V(4); PG8_BAR;
    PG8_STAGE(PG8_SB(1, 0), cB + kstep, voffB); PG8_STAGE(PG8_SA(1, 0), cA + kstep, voffA); PG8_STAGE(PG8_SB(1, 1), cB + hstep + kstep, voffB);
    PG8_WAIT_V(6); PG8_BAR;
    for (;;) {
        const bool has_next = S.next(ui + 1, nxt);
        const char* nA = has_next ? (const char*)g.A + (size_t)nxt.pm * tstep : cA; const char* nB = has_next ? (const char*)g.Bt + (size_t)nxt.pn * tstep : cB;
        for (int t = 0; t < nt; t += 2) {
            const bool last = (t == nt - 2);
            const char* a1 = cA + (size_t)(t + 1) * kstep;
            const char* a2 = last ? nA : cA + (size_t)(t + 2) * kstep; const char* b2 = last ? nB : cB + (size_t)(t + 2) * kstep;
            const char* a3 = a2 + kstep; const char* b3 = b2 + kstep;
            PG8_LDB(B0, 0, 0); PG8_SCHED; PG8_LDA(At, 0, 0); PG8_STAGE(PG8_SA(1, 1), a1 + hstep, voffA);
            PG8_WAIT_L(8); PG8_BAR; PG8_WAIT_L(0); PG8_MMA(0, 0, At, B0); PG8_BAR; PG8_SCHED;
            PG8_LDB(B1, 0, 1); PG8_STAGE(PG8_SB(0, 0), b2, voffB);
            PG8_BAR; PG8_WAIT_L(0); PG8_MMA(0, 1, At, B1); PG8_BAR;
            PG8_LDA(At, 0, 1); PG8_STAGE(PG8_SA(0, 0), a2, voffA);
            PG8_BAR; PG8_WAIT_L(0); PG8_MMA(1, 0, At, B0); PG8_BAR; PG8_SCHED;
            PG8_STAGE(PG8_SB(0, 1), b2 + hstep, voffB);
            PG8_WAIT_V(6); PG8_BAR; PG8_MMA(1, 1, At, B1); PG8_BAR;
            PG8_LDB(B0, 1, 0); PG8_SCHED; PG8_LDA(At, 1, 0); PG8_STAGE(PG8_SA(0, 1), a2 + hstep, voffA);
            PG8_WAIT_L(8); PG8_BAR; PG8_WAIT_L(0); PG8_MMA(0, 0, At, B0); PG8_BAR; PG8_SCHED;
            PG8_LDB(B1, 1, 1); PG8_STAGE(PG8_SB(1, 0), b3, voffB);
            PG8_BAR; PG8_WAIT_L(0); PG8_MMA(0, 1, At, B1); PG8_BAR;
            PG8_LDA(At, 1, 1); PG8_STAGE(PG8_SA(1, 0), a3, voffA);
            PG8_BAR; PG8_WAIT_L(0); PG8_MMA(1, 0, At, B0); PG8_BAR; PG8_SCHED;
            PG8_STAGE(PG8_SB(1, 1), b3 + hstep, voffB);
            PG8_WAIT_V(6); PG8_BAR; PG8_MMA(1, 1, At, B1); PG8_BAR;
        }
        E(acc, cur, wr, wc, fr, fq);
        if (!has_next) break;
#pragma unroll
        for (int a = 0; a < 2; ++a)
#pragma unroll
            for (int b = 0; b < 2; ++b)
#pragma unroll
                for (int m = 0; m < 4; ++m)
#pragma unroll
                    for (int n = 0; n < 2; ++n) acc[a][b][m][n] = (f32x4){0.f, 0.f, 0.f, 0.f};
        cur = nxt; cA = nA; cB = nB; ++ui;
    }
    PG8_WAIT_V(0);
    if (wr == 0) PG8_BAR;
    PG8_BAR;
#undef PG8_SA
#undef PG8_SB
#undef PG8_STAGE
#undef PG8_LDA
#undef PG8_LDB
#undef PG8_MMA
#undef PG8_WAIT_V
#undef PG8_WAIT_L
#undef PG8_BAR
#undef PG8_SCHED
}
}
using pg8::Unit;

struct SchedG1 {
    int c;
    __device__ __forceinline__ bool next(int i, Unit& u) const {
        const int xcd = c & 7, slot = c >> 3, pmt = xcd * 8 + (slot >> 2), j = slot & 3;
        if (i < 2) { u.pm = pmt; u.pn = 72 + i * 4 + j; return true; }
        if (i == 2) { u.pm = 72 + 8 + j; u.pn = pmt; return true; }
        if (i == 3) {
            if (j < 2) { u.pm = pmt; u.pn = 72 + 20 + j; return true; }
            if (j == 2) { int cu = pmt;
                if (cu < 32) { u.pm = 64 + (cu >> 2); u.pn = 72 + 4 + (cu & 3); }
                else { cu -= 32; u.pm = 72 + 8 + (cu & 3); u.pn = 64 + (cu >> 2); }
                return true; }
        }
        return false;
    }
};
struct SchedG2 {
    int c;
    __device__ __forceinline__ bool next(int i, Unit& u) const {
        const int xcd = c & 7, slot = c >> 3, pmt = xcd * 8 + (slot >> 2), j = slot & 3;
        u.pm = pmt;
        if (i == 0) { u.pn = 72 + 12 + j; return true; }
        if (i == 1) { u.pn = 72 + 16 + j; return true; }
        if (i == 2) { u.pn = 72 + 24 + 2 * j; return true; }
        if (i == 3) { u.pn = 72 + 25 + 2 * j; return true; }
        if (i == 4 && j < 2) { u.pn = 72 + 22 + j; return true; }
        return false;
    }
};
struct Sched64 {
    int c, ncol;
    __device__ __forceinline__ bool next(int i, Unit& u) const {
        const int xcd = c & 7, slot = c >> 3, pmt = xcd * 8 + (slot >> 2), j = slot & 3;
        if (i == 0 && j < ncol) { u.pm = pmt; u.pn = j; return true; }
        return false;
    }
};

struct EpiG1 {
    unsigned char* ws;
    __device__ __forceinline__ void operator()(const f32x4 (&acc)[2][2][4][2], const Unit& u, int wr, int wc, int fr, int fq) const {
        const bool sw = u.pm >= 72;
        const int tokt = sw ? u.pn : u.pm, wt = (sw ? u.pm : u.pn) - 72;
        bf16_t* base; int ld; float sc = 1.0f; int rowbase;
        if (!sw) {
            rowbase = tokt * 256;
            if (wt < 4) { base = (bf16_t*)(ws + OFF_Q) + wt * 256; ld = 1024; }
            else if (wt < 8) { sc = 0.0625f; ld = 1024;
                if (tokt < 64) base = (bf16_t*)(ws + OFF_K) + (wt - 4) * 256;
                else { base = (bf16_t*)(ws + OFF_KC) + (wt - 4) * 256; rowbase -= 16384; } }
            else { base = (bf16_t*)(ws + OFF_P) + (wt - 20) * 256; ld = 512; }
        } else {
            rowbase = (wt - 8) * 256;
            if (tokt < 64) { base = (bf16_t*)(ws + OFF_VT) + tokt * 256; ld = 16384; }
            else { base = (bf16_t*)(ws + OFF_VTC) + (tokt - 64) * 256; ld = 2048; }
        }
        const int row0 = rowbase + wr * 64 + fr, col0 = wc * 32 + 8 * fq;
#pragma unroll
        for (int ai = 0; ai < 2; ++ai)
#pragma unroll
            for (int m = 0; m < 4; ++m) { bf16_t* rowp = base + (size_t)(row0 + ai * 128 + m * 16) * ld + col0;
#pragma unroll
                for (int bj = 0; bj < 2; ++bj) { const f32x4 v0 = acc[ai][bj][m][0] * sc, v1 = acc[ai][bj][m][1] * sc;
                    u32x4 w; w.x = cvt_pk_bf16(v0[0], v0[1]); w.y = cvt_pk_bf16(v0[2], v0[3]); w.z = cvt_pk_bf16(v1[0], v1[1]); w.w = cvt_pk_bf16(v1[2], v1[3]);
                    *(u32x4*)(rowp + bj * 128) = w; } }
    }
};
struct EpiG2 {
    unsigned char* ws;
    __device__ __forceinline__ void operator()(const f32x4 (&acc)[2][2][4][2], const Unit& u, int wr, int wc, int fr, int fq) const {
        const int wt = u.pn - 72;
        bf16_t* base; int ld; int mode;
        if (wt < 16) { base = (bf16_t*)(ws + OFF_Q) + (wt - 12) * 256; ld = 1024; mode = 0; }
        else if (wt < 20) { base = (bf16_t*)(ws + OFF_Q) + (wt - 16) * 256; ld = 1024; mode = 1; }
        else if (wt < 24) { base = (bf16_t*)(ws + OFF_PM) + (wt - 22) * 256; ld = 512; mode = 1; }
        else { base = (bf16_t*)(ws + OFF_GB) + (wt - 24) * 256; ld = 2048; mode = 2; }
        const int row0 = u.pm * 256 + wr * 64 + fr, col0 = wc * 32 + 8 * fq;
#pragma unroll
        for (int ai = 0; ai < 2; ++ai)
#pragma unroll
            for (int m = 0; m < 4; ++m) { bf16_t* rowp = base + (size_t)(row0 + ai * 128 + m * 16) * ld + col0;
#pragma unroll
                for (int bj = 0; bj < 2; ++bj) { const f32x4 a0 = acc[ai][bj][m][0], a1 = acc[ai][bj][m][1];
                    float f[8];
#pragma unroll
                    for (int q = 0; q < 4; ++q) { f[q] = mode == 1 ? siluf(a0[q]) : sigm(a0[q]); f[4 + q] = mode == 1 ? siluf(a1[q]) : sigm(a1[q]); }
                    if (mode != 2) { const u32x4 o = *(const u32x4*)(rowp + bj * 128);
                        f[0] *= bf_lo(o.x); f[1] *= bf_hi(o.x); f[2] *= bf_lo(o.y); f[3] *= bf_hi(o.y); f[4] *= bf_lo(o.z); f[5] *= bf_hi(o.z); f[6] *= bf_lo(o.w); f[7] *= bf_hi(o.w); }
                    u32x4 w; w.x = cvt_pk_bf16(f[0], f[1]); w.y = cvt_pk_bf16(f[2], f[3]); w.z = cvt_pk_bf16(f[4], f[5]); w.w = cvt_pk_bf16(f[6], f[7]);
                    *(u32x4*)(rowp + bj * 128) = w; } }
    }
};
struct EpiPool {
    unsigned char* ws; const float* pool_scale;
    __device__ __forceinline__ void operator()(const f32x4 (&acc)[2][2][4][2], const Unit& u, int wr, int wc, int fr, int fq) const {
        bf16_t* base = (bf16_t*)(ws + OFF_PM) + u.pn * 256;
        const int row0 = u.pm * 256 + wr * 64 + fr, col0 = wc * 32 + 8 * fq;
        f32x4 s[2][2];
#pragma unroll
        for (int bj = 0; bj < 2; ++bj)
#pragma unroll
            for (int n = 0; n < 2; ++n) s[bj][n] = *(const f32x4*)(pool_scale + u.pn * 256 + col0 + bj * 128 + 4 * n);
#pragma unroll
        for (int ai = 0; ai < 2; ++ai)
#pragma unroll
            for (int m = 0; m < 4; ++m) { bf16_t* rowp = base + (size_t)(row0 + ai * 128 + m * 16) * 512 + col0;
#pragma unroll
                for (int bj = 0; bj < 2; ++bj) { const f32x4 v0 = acc[ai][bj][m][0] * s[bj][0], v1 = acc[ai][bj][m][1] * s[bj][1];
                    u32x4 w; w.x = cvt_pk_bf16(v0[0], v0[1]); w.y = cvt_pk_bf16(v0[2], v0[3]); w.z = cvt_pk_bf16(v1[0], v1[1]); w.w = cvt_pk_bf16(v1[2], v1[3]);
                    *(u32x4*)(rowp + bj * 128) = w; } }
    }
};
struct EpiMergeP {
    unsigned char* ws; float* tmp;
    __device__ __forceinline__ void operator()(const f32x4 (&acc)[2][2][4][2], const Unit& u, int wr, int wc, int fr, int fq) const {
        const bf16_t* gb = (const bf16_t*)(ws + OFF_GB) + 1024 + u.pn * 256;
        const int row0 = u.pm * 256 + wr * 64 + fr, col0 = wc * 32 + 8 * fq;
#pragma unroll
        for (int ai = 0; ai < 2; ++ai)
#pragma unroll
            for (int m = 0; m < 4; ++m) { const size_t row = (size_t)(row0 + ai * 128 + m * 16);
#pragma unroll
                for (int bj = 0; bj < 2; ++bj) { const u32x4 g = *(const u32x4*)(gb + row * 2048 + col0 + bj * 128);
                    const f32x4 a0 = acc[ai][bj][m][0], a1 = acc[ai][bj][m][1];
                    f32x4 o0, o1; o0[0] = a0[0] * bf_lo(g.x); o0[1] = a0[1] * bf_hi(g.x); o0[2] = a0[2] * bf_lo(g.y); o0[3] = a0[3] * bf_hi(g.y);
                    o1[0] = a1[0] * bf_lo(g.z); o1[1] = a1[1] * bf_hi(g.z); o1[2] = a1[2] * bf_lo(g.w); o1[3] = a1[3] * bf_hi(g.w);
                    float* tp = tmp + row * 1024 + u.pn * 256 + col0 + bj * 128;
                    *(f32x4*)tp = o0; *(f32x4*)(tp + 4) = o1; } }
    }
};
struct EpiMergeM {
    unsigned char* ws; const float* tmp;
    __device__ __forceinline__ void operator()(const f32x4 (&acc)[2][2][4][2], const Unit& u, int wr, int wc, int fr, int fq) const {
        const bf16_t* gb = (const bf16_t*)(ws + OFF_GB) + u.pn * 256;
        bf16_t* mg = (bf16_t*)(ws + OFF_MG) + u.pn * 256;
        const int row0 = u.pm * 256 + wr * 64 + fr, col0 = wc * 32 + 8 * fq;
#pragma unroll
        for (int ai = 0; ai < 2; ++ai)
#pragma unroll
            for (int m = 0; m < 4; ++m) { const size_t row = (size_t)(row0 + ai * 128 + m * 16);
#pragma unroll
                for (int bj = 0; bj < 2; ++bj) { const u32x4 g = *(const u32x4*)(gb + row * 2048 + col0 + bj * 128);
                    const float* tp = tmp + row * 1024 + u.pn * 256 + col0 + bj * 128;
                    const f32x4 t0 = *(const f32x4*)tp, t1 = *(const f32x4*)(tp + 4);
                    const f32x4 a0 = acc[ai][bj][m][0], a1 = acc[ai][bj][m][1];
                    u32x4 w;
                    w.x = cvt_pk_bf16(a0[0] * bf_lo(g.x) + t0[0], a0[1] * bf_hi(g.x) + t0[1]); w.y = cvt_pk_bf16(a0[2] * bf_lo(g.y) + t0[2], a0[3] * bf_hi(g.y) + t0[3]);
                    w.z = cvt_pk_bf16(a1[0] * bf_lo(g.z) + t1[0], a1[1] * bf_hi(g.z) + t1[1]); w.w = cvt_pk_bf16(a1[2] * bf_lo(g.w) + t1[2], a1[3] * bf_hi(g.w) + t1[3]);
                    *(u32x4*)(mg + row * 1024 + col0 + bj * 128) = w; } }
    }
};
struct EpiOut {
    unsigned char* ws; const float* x; float* out;
    __device__ __forceinline__ void operator()(const f32x4 (&acc)[2][2][4][2], const Unit& u, int wr, int wc, int fr, int fq) const {
        const int b = u.pm >> 3;
        const float* gv = (const float*)(ws + OFF_GATEV) + b * 1024 + u.pn * 256;
        float* ssq = (float*)(ws + OFF_SSQ);
        const int row0 = u.pm * 256 + wr * 64 + fr, col0 = wc * 32 + 8 * fq;
        f32x4 gg[2][2];
#pragma unroll
        for (int bj = 0; bj < 2; ++bj)
#pragma unroll
            for (int n = 0; n < 2; ++n) gg[bj][n] = *(const f32x4*)(gv + col0 + bj * 128 + 4 * n);
#pragma unroll
        for (int ai = 0; ai < 2; ++ai)
#pragma unroll
            for (int m = 0; m < 4; ++m) { const size_t row = (size_t)(row0 + ai * 128 + m * 16); float s = 0.f;
#pragma unroll
                for (int bj = 0; bj < 2; ++bj)
#pragma unroll
                    for (int n = 0; n < 2; ++n) { const size_t off = row * 1024 + u.pn * 256 + col0 + bj * 128 + 4 * n;
                        const f32x4 xv = *(const f32x4*)(x + off); const f32x4 o = xv + gg[bj][n] * acc[ai][bj][m][n];
                        *(f32x4*)(out + off) = o; s += (o[0] * o[0] + o[1] * o[1]) + (o[2] * o[2] + o[3] * o[3]); }
                s += __shfl_xor(s, 16); s += __shfl_xor(s, 32);
                if (fq == 0) ssq[row * 16 + u.pn * 4 + wc] = s; }
    }
};

__device__ __forceinline__ void transpose_tile(const float* src, int ld_src, int k0, int c0, bf16_t* dst, int ld_dst, int n0, LAS float* T) {
    const int tid = threadIdx.x;
#pragma unroll
    for (int i = 0; i < 2; ++i) { const int r = (tid >> 4) + i * 32, c4 = (tid & 15) * 4;
        const f32x4 v = *(const f32x4*)(src + (size_t)(k0 + r) * ld_src + c0 + c4);
        T[r * 65 + c4] = v[0]; T[r * 65 + c4 + 1] = v[1]; T[r * 65 + c4 + 2] = v[2]; T[r * 65 + c4 + 3] = v[3]; }
    __syncthreads();
    { const int n = tid >> 3, kc = (tid & 7) * 8; float f[8];
#pragma unroll
        for (int j = 0; j < 8; ++j) f[j] = T[(kc + j) * 65 + n];
        u32x4 w; w.x = cvt_pk_bf16(f[0], f[1]); w.y = cvt_pk_bf16(f[2], f[3]); w.z = cvt_pk_bf16(f[4], f[5]); w.w = cvt_pk_bf16(f[6], f[7]);
        *(u32x4*)(dst + (size_t)(n0 + n) * ld_dst + k0 + kc) = w; }
    __syncthreads();
}
__device__ __forceinline__ float wave_sum(float v) {
    v += __shfl_xor(v, 32); v += __shfl_xor(v, 16); v += __shfl_xor(v, 8); v += __shfl_xor(v, 4); v += __shfl_xor(v, 2); v += __shfl_xor(v, 1); return v;
}
__device__ __forceinline__ float log_sigmoid(float x) { return fminf(x, 0.f) - log1pf(expf(-fabsf(x))); }

__device__ void phase0(const Params& p, LAS unsigned char* lds) {
    const int tid = threadIdx.x;
    LAS float* T = (LAS float*)lds;
    bf16_t* WinT = (bf16_t*)(p.ws + OFF_AB) + (size_t)18432 * 1024;
    for (int job = blockIdx.x; job < 2048; job += gridDim.x) {
        const int kt = job & 15, ntile = job >> 4; const int n0 = ntile * 64, k0 = kt * 64; const int c0 = n0 < 5120 ? n0 : n0 + 16;
        transpose_tile(p.in_w, 8208, k0, c0, WinT, 1024, n0, T);
    }
    float* modp = (float*)(p.ws + OFF_MODP);
    for (int job = blockIdx.x; job < 256; job += gridDim.x) {
        const int cgp = job & 31, ks = job >> 5;
        LAS float* sl = (LAS float*)lds;
        LAS float* red = sl + 9 * 128;
        for (int i = tid; i < 9 * 128; i += 512) { const int v = i >> 7, kk = i & 127; const float cv = v < 8 ? p.c[v * 1024 + ks * 128 + kk] : p.c_ctx[ks * 128 + kk]; sl[i] = cv / (1.0f + expf(-cv)); }
        __syncthreads();
        const int col = tid % 96, kr = tid / 96;
        float a0 = 0.f, a1 = 0.f, a2 = 0.f, a3 = 0.f, a4 = 0.f, a5 = 0.f, a6 = 0.f, a7 = 0.f, a8 = 0.f;
        if (kr < 5) {
            for (int kk = kr; kk < 128; kk += 5) { const float wv = p.ada_w[(size_t)(ks * 128 + kk) * 3072 + cgp * 96 + col];
                a0 += sl[kk] * wv; a1 += sl[128 + kk] * wv; a2 += sl[256 + kk] * wv; a3 += sl[384 + kk] * wv; a4 += sl[512 + kk] * wv; a5 += sl[640 + kk] * wv; a6 += sl[768 + kk] * wv; a7 += sl[896 + kk] * wv; a8 += sl[1024 + kk] * wv; }
            LAS float* rp = red + (kr * 9) * 96 + col;
            rp[0] = a0; rp[96] = a1; rp[192] = a2; rp[288] = a3; rp[384] = a4; rp[480] = a5; rp[576] = a6; rp[672] = a7; rp[768] = a8;
        }
        __syncthreads();
        for (int i = tid; i < 9 * 96; i += 512) { const int v = i / 96, cc = i % 96; float s = 0.f;
#pragma unroll
            for (int r = 0; r < 5; ++r) s += red[(r * 9 + v) * 96 + cc];
            modp[(size_t)(ks * 9 + v) * 3072 + cgp * 96 + cc] = s; }
        __syncthreads();
    }
}

__device__ __forceinline__ void norm_row(const float* xrow, const LAS float* gs, const LAS float* sh, const LAS float* WgT, bf16_t* orow, float* gout, int T, int t, const float* gate_b, int lane) {
    f32x4 xv[4]; float ss = 0.f;
#pragma unroll
    for (int i = 0; i < 4; ++i) { xv[i] = *(const f32x4*)(xrow + i * 256 + lane * 4); ss += (xv[i][0] * xv[i][0] + xv[i][1] * xv[i][1]) + (xv[i][2] * xv[i][2] + xv[i][3] * xv[i][3]); }
    ss = wave_sum(ss);
    const float rstd = rsqrtf(ss * (1.0f / 1024.0f) + 1e-6f);
    f32x4 y[4];
#pragma unroll
    for (int i = 0; i < 4; ++i) { const f32x4 g = *(const LAS f32x4*)(gs + i * 256 + lane * 4), s = *(const LAS f32x4*)(sh + i * 256 + lane * 4);
        y[i] = xv[i] * rstd * g + s;
        u32x2 w; w.x = cvt_pk_bf16(y[i][0], y[i][1]); w.y = cvt_pk_bf16(y[i][2], y[i][3]);
        *(u32x2*)(orow + i * 256 + lane * 4) = w; }
    float sel = 0.f;
#pragma unroll
    for (int j = 0; j < 16; ++j) { float pj = 0.f;
#pragma unroll
        for (int i = 0; i < 4; ++i) { const f32x4 wv = *(const LAS f32x4*)(WgT + j * 1024 + i * 256 + lane * 4); pj += (y[i][0] * wv[0] + y[i][1] * wv[1]) + (y[i][2] * wv[2] + y[i][3] * wv[3]); }
        pj = wave_sum(pj);
        sel = (lane == j) ? pj : sel; }
    if (lane < 16) { const float pre = sel + gate_b[lane]; const float val = ((lane >> 2) & 1) ? log_sigmoid(pre) : pre; gout[(size_t)lane * T + t] = val; }
}
__device__ void phase1(const Params& p, LAS unsigned char* lds) {
    const int tid = threadIdx.x, wid = tid >> 6, lane = tid & 63;
    LAS float* gs = (LAS float*)lds; LAS float* sh = gs + 1024; LAS float* gsc = sh + 1024; LAS float* shc = gsc + 1024; LAS float* WgT = shc + 1024;
    const float* modp = (const float*)(p.ws + OFF_MODP);
    bf16_t* AB = (bf16_t*)(p.ws + OFF_AB);
    for (int job = blockIdx.x; job < 256; job += gridDim.x) {
        const int b = job >> 5;
        for (int i = tid; i < 1024; i += 512) {
            float s0 = p.ada_b[i], s1 = p.ada_b[1024 + i], s2 = p.ada_b[2048 + i], c0 = s0, c1 = s1;
#pragma unroll
            for (int ks = 0; ks < 8; ++ks) { const float* mp = modp + (size_t)(ks * 9 + b) * 3072; s0 += mp[i]; s1 += mp[1024 + i]; s2 += mp[2048 + i];
                const float* mc = modp + (size_t)(ks * 9 + 8) * 3072; c0 += mc[i]; c1 += mc[1024 + i]; }
            const float nw = p.norm_w[i];
            gs[i] = nw * (1.0f + s1); sh[i] = s0; gsc[i] = nw * (1.0f + c1); shc[i] = c0;
            if ((job & 31) == 0) ((float*)(p.ws + OFF_GATEV))[b * 1024 + i] = s2;
        }
        for (int i = tid; i < 16384; i += 512) { const int j = i & 15, k = i >> 4; WgT[j * 1024 + k] = p.in_w[(size_t)k * 8208 + 5120 + j]; }
        __syncthreads();
        for (int rr = 0; rr < 8; ++rr) { const int row = job * 64 + wid * 8 + rr; const int t = row & 2047;
            norm_row(p.x + (size_t)row * 1024, gs, sh, WgT, AB + (size_t)row * 1024, (float*)(p.ws + OFF_GL) + (size_t)b * 16 * 2048, 2048, t, p.gate_b, lane); }
        { const int crow = job * 8 + wid; const int cb = crow >> 8, t = crow & 255;
            norm_row(p.ctx + (size_t)crow * 1024, gsc, shc, WgT, AB + (size_t)(16384 + crow) * 1024, (float*)(p.ws + OFF_GC) + (size_t)cb * 16 * 256, 256, t, p.gate_b, lane); }
        __syncthreads();
    }
}

__device__ __forceinline__ bf16_t* cst_ptr(const Params& p, int sid, int chunk) {
    bf16_t* base = sid < 32 ? (bf16_t*)p.out : (bf16_t*)(p.ws + OFF_CST2);
    return base + ((size_t)((sid & 31) * 16 + chunk)) * 65536;
}
__device__ void passA(const Params& p, LAS unsigned char* lds, int wg) {
    const int tid = threadIdx.x, wid = tid >> 6, lane = tid & 63, fr = lane & 15, fq = lane >> 4;
    const int sid = wg >> 2, vs = wg & 3; const int b = sid >> 3, h = (sid >> 1) & 3, dir = sid & 1;
    LAS bf16_t* Kt = (LAS bf16_t*)lds;
    LAS bf16_t* Ve = Kt + 256 * 136;
    LAS float* g_li = (LAS float*)(Ve + 64 * 136);
    LAS float* g_lf = g_li + 128; LAS float* e_s = g_lf + 128; LAS float* wend = e_s + 128; LAS float* misc = wend + 128;
    f32x4 acc[2][4];
#pragma unroll
    for (int a = 0; a < 2; ++a)
#pragma unroll
        for (int v = 0; v < 4; ++v) acc[a][v] = (f32x4){0.f, 0.f, 0.f, 0.f};
    float nreg = 0.f, m = -1e30f;
    const float* GL = (const float*)(p.ws + OFF_GL); const float* GC = (const float*)(p.ws + OFF_GC);
    for (int step = 0; step < 18; ++step) {
        const bool isctx = step < 2; int ci, T; const float* G; const bf16_t* Kbase; const bf16_t* Vbase; int ldv;
        if (isctx) { ci = dir ? 1 - step : step; T = 256; G = GC + (size_t)b * 16 * 256;
            Kbase = (const bf16_t*)(p.ws + OFF_KC) + (size_t)(b * 256 + ci * 128) * 1024 + h * 256;
            Vbase = (const bf16_t*)(p.ws + OFF_VTC) + (size_t)(h * 256 + vs * 64) * 2048 + b * 256 + ci * 128; ldv = 2048; }
        else { const int s2 = step - 2; ci = dir ? 15 - s2 : s2; T = 2048; G = GL + (size_t)b * 16 * 2048;
            Kbase = (const bf16_t*)(p.ws + OFF_K) + (size_t)(b * 2048 + ci * 128) * 1024 + h * 256;
            Vbase = (const bf16_t*)(p.ws + OFF_VT) + (size_t)(h * 256 + vs * 64) * 16384 + b * 2048 + ci * 128; ldv = 16384; }
        if (tid < 128) { g_li[tid] = G[(size_t)(dir * 8 + h) * T + ci * 128 + tid]; g_lf[tid] = G[(size_t)(dir * 8 + 4 + h) * T + ci * 128 + tid]; }
        __syncthreads();
        if (tid < 128) { float run = 0.f, bs = 0.f;
            if (dir == 0) { for (int j = 0; j < 128; ++j) { run += g_lf[j]; bs = (j == tid) ? run : bs; } }
            else { for (int j = 127; j >= 0; --j) { run += g_lf[j]; bs = (j == tid) ? run : bs; } }
            wend[tid] = run - bs + g_li[tid];
            if (tid == 0) misc[0] = run; }
        __syncthreads();
        const float bend = misc[0]; float mx = -3.0e38f;
        for (int j = 0; j < 128; ++j) mx = fmaxf(mx, wend[j]);
        const float m_new = fmaxf(bend + m, mx); const float decay = expf(bend + m - m_new);
        if (tid < 128) e_s[tid] = expf(wend[tid] - m_new);
        if (!isctx) {
            bf16_t* cs = cst_ptr(p, sid, ci) + (size_t)(vs * 64) * 256;
#pragma unroll
            for (int kt = 0; kt < 2; ++kt)
#pragma unroll
                for (int vt = 0; vt < 4; ++vt) { u32x2 w; w.x = cvt_pk_bf16(acc[kt][vt][0], acc[kt][vt][1]); w.y = cvt_pk_bf16(acc[kt][vt][2], acc[kt][vt][3]);
                    *(u32x2*)(cs + (size_t)(vt * 16 + fr) * 256 + wid * 32 + kt * 16 + fq * 4) = w; }
            if (vs == 0) { if (tid < 256) ((float*)(p.ws + OFF_NST))[(size_t)(sid * 16 + ci) * 256 + tid] = nreg;
                if (tid == 0) ((float*)(p.ws + OFF_MST))[sid * 16 + ci] = m; }
        }
        if (step == 17) break;
        __syncthreads();
#pragma unroll
        for (int rep = 0; rep < 2; ++rep) { const int it = tid + rep * 512; const int v = it >> 4, sg = (it & 15) * 8;
            const u32x4 raw = *(const u32x4*)(Vbase + (size_t)v * ldv + sg);
            u32x4 w; w.x = cvt_pk_bf16(bf_lo(raw.x) * e_s[sg], bf_hi(raw.x) * e_s[sg + 1]); w.y = cvt_pk_bf16(bf_lo(raw.y) * e_s[sg + 2], bf_hi(raw.y) * e_s[sg + 3]);
            w.z = cvt_pk_bf16(bf_lo(raw.z) * e_s[sg + 4], bf_hi(raw.z) * e_s[sg + 5]); w.w = cvt_pk_bf16(bf_lo(raw.w) * e_s[sg + 6], bf_hi(raw.w) * e_s[sg + 7]);
            *(LAS u32x4*)(Ve + v * 136 + sg) = w; }
#pragma unroll
        for (int rep = 0; rep < 2; ++rep) { const int it = tid + rep * 512; const int sq = (it & 15) | (((it >> 6) & 1) << 4), ko = ((it >> 4) & 3) | ((it >> 7) << 2);
            const bf16_t* src = Kbase + (size_t)(sq * 4) * 1024 + ko * 8;
            const u32x4 r0 = *(const u32x4*)src, r1 = *(const u32x4*)(src + 1024), r2 = *(const u32x4*)(src + 2048), r3 = *(const u32x4*)(src + 3072);
            LAS bf16_t* dst = Kt + (ko * 8) * 136 + sq * 4;
#define TRW(j, a0, a1, a2, a3, HI) { u32x2 w; if (HI) { w.x = (a0 >> 16) | (a1 & 0xffff0000u); w.y = (a2 >> 16) | (a3 & 0xffff0000u); } else { w.x = (a0 & 0xffffu) | (a1 << 16); w.y = (a2 & 0xffffu) | (a3 << 16); } *(LAS u32x2*)(dst + (j) * 136) = w; }
            TRW(0, r0.x, r1.x, r2.x, r3.x, 0) TRW(1, r0.x, r1.x, r2.x, r3.x, 1) TRW(2, r0.y, r1.y, r2.y, r3.y, 0) TRW(3, r0.y, r1.y, r2.y, r3.y, 1)
            TRW(4, r0.z, r1.z, r2.z, r3.z, 0) TRW(5, r0.z, r1.z, r2.z, r3.z, 1) TRW(6, r0.w, r1.w, r2.w, r3.w, 0) TRW(7, r0.w, r1.w, r2.w, r3.w, 1)
#undef TRW
        }
        __syncthreads();
#pragma unroll
        for (int a = 0; a < 2; ++a)
#pragma unroll
            for (int v = 0; v < 4; ++v) acc[a][v] *= decay;
#pragma unroll
        for (int ks = 0; ks < 4; ++ks) { bf16x8 kf[2], vf[4];
#pragma unroll
            for (int kt = 0; kt < 2; ++kt) kf[kt] = *(const LAS bf16x8*)(Kt + (wid * 32 + kt * 16 + fr) * 136 + ks * 32 + fq * 8);
#pragma unroll
            for (int vt = 0; vt < 4; ++vt) vf[vt] = *(const LAS bf16x8*)(Ve + (vt * 16 + fr) * 136 + ks * 32 + fq * 8);
#pragma unroll
            for (int kt = 0; kt < 2; ++kt)
#pragma unroll
                for (int vt = 0; vt < 4; ++vt) acc[kt][vt] = __builtin_amdgcn_mfma_f32_16x16x32_bf16(kf[kt], vf[vt], acc[kt][vt], 0, 0, 0); }
        if (tid < 256) { float s = 0.f;
            for (int s8 = 0; s8 < 16; ++s8) { const u32x4 kv = *(const LAS u32x4*)(Kt + tid * 136 + s8 * 8); const LAS float* ep = e_s + s8 * 8;
                s += bf_lo(kv.x) * ep[0] + bf_hi(kv.x) * ep[1] + bf_lo(kv.y) * ep[2] + bf_hi(kv.y) * ep[3] + bf_lo(kv.z) * ep[4] + bf_hi(kv.z) * ep[5] + bf_lo(kv.w) * ep[6] + bf_hi(kv.w) * ep[7]; }
            nreg = decay * nreg + s; }
        m = m_new;
        __syncthreads();
    }
    __syncthreads();
}

__device__ void boxfilter_unit(const Params& p, LAS unsigned char* lds, int u) {
    const int tid = threadIdx.x;
    const int b = u >> 6, g = (u >> 4) & 3, cb = u & 15; const int hw = 1 << g;
    LAS float* X = (LAS float*)lds; LAS float* Y = X + 2048 * 8;
    const bf16_t* src = (const bf16_t*)(p.ws + OFF_P) + (size_t)(b * 2048) * 512 + g * 128 + cb * 8;
    bf16_t* dst = (bf16_t*)(p.ws + OFF_MX) + (size_t)(b * 2048) * 512 + g * 128 + cb * 8;
#pragma unroll
    for (int i = 0; i < 4; ++i) { const int tok = tid + 512 * i; const u32x4 v = *(const u32x4*)(src + (size_t)tok * 512);
        *(LAS f32x4*)(X + tok * 8) = (f32x4){bf_lo(v.x), bf_hi(v.x), bf_lo(v.y), bf_hi(v.y)}; *(LAS f32x4*)(X + tok * 8 + 4) = (f32x4){bf_lo(v.z), bf_hi(v.z), bf_lo(v.w), bf_hi(v.w)}; }
    __syncthreads();
    for (int i = 0; i < 4; ++i) { const int tok = tid + 512 * i; const int r = tok >> 6, c = tok & 63; const int lo = max(r - hw, 0), hi = min(r + hw, 32);
        f32x4 s0 = (f32x4){0.f, 0.f, 0.f, 0.f}, s1 = s0;
        for (int rr = lo; rr < hi; ++rr) { s0 += *(const LAS f32x4*)(X + (rr * 64 + c) * 8); s1 += *(const LAS f32x4*)(X + (rr * 64 + c) * 8 + 4); }
        const float cnt = (float)(hi - lo);
        *(LAS f32x4*)(Y + tok * 8) = s0 / cnt; *(LAS f32x4*)(Y + tok * 8 + 4) = s1 / cnt; }
    __syncthreads();
    for (int i = 0; i < 4; ++i) { const int tok = tid + 512 * i; const int r = tok >> 6, c = tok & 63; const int lo = max(c - hw, 0), hi = min(c + hw, 64);
        f32x4 s0 = (f32x4){0.f, 0.f, 0.f, 0.f}, s1 = s0;
        for (int cc = lo; cc < hi; ++cc) { s0 += *(const LAS f32x4*)(Y + (r * 64 + cc) * 8); s1 += *(const LAS f32x4*)(Y + (r * 64 + cc) * 8 + 4); }
        const float cnt = (float)(hi - lo);
        const f32x4 m0 = s0 / cnt - *(const LAS f32x4*)(X + tok * 8), m1 = s1 / cnt - *(const LAS f32x4*)(X + tok * 8 + 4);
        u32x4 w; w.x = cvt_pk_bf16(m0[0], m0[1]); w.y = cvt_pk_bf16(m0[2], m0[3]); w.z = cvt_pk_bf16(m1[0], m1[1]); w.w = cvt_pk_bf16(m1[2], m1[3]);
        *(u32x4*)(dst + (size_t)tok * 512) = w; }
    __syncthreads();
}

__device__ void passB_unit(const Params& p, LAS unsigned char* lds, int u) {
    const int tid = threadIdx.x, wid = tid >> 6, lane = tid & 63, fr = lane & 15, fq = lane >> 4;
    const int b = u >> 6, h = (u >> 4) & 3, c = u & 15;
    const int tokbase = b * 2048 + c * 128;
    LAS bf16_t* Qs = (LAS bf16_t*)lds;
    LAS bf16_t* Pd = Qs + 128 * 264;
    LAS float* fl = (LAS float*)(lds + 137216);
    LAS float* lfA = fl; LAS float* liA = fl + 256; LAS float* aA = fl + 512; LAS float* MA = fl + 768; LAS float* winA = fl + 1024; LAS float* clampA = fl + 1280;
    LAS float* nqA = fl + 1536; LAS float* nvec = fl + 1792; LAS float* rsP = fl + 2304; LAS float* ssP = fl + 3328;
    const float* GL = (const float*)(p.ws + OFF_GL) + (size_t)b * 16 * 2048 + c * 128;
    bf16_t* Qg = (bf16_t*)(p.ws + OFF_Q) + (size_t)tokbase * 1024 + h * 256;
    const int sid0 = (b * 4 + h) * 2;
    if (tid < 256) { const int d = tid >> 7, t = tid & 127; liA[tid] = GL[(size_t)(d * 8 + h) * 2048 + t]; lfA[tid] = GL[(size_t)(d * 8 + 4 + h) * 2048 + t]; }
    { const int d = tid >> 8, k = tid & 255; nvec[tid] = ((const float*)(p.ws + OFF_NST))[(size_t)((sid0 + d) * 16 + c) * 256 + k]; }
#pragma unroll
    for (int i = 0; i < 8; ++i) { const int id = tid + 512 * i; const int row = id >> 5, sg = id & 31;
        *(LAS u32x4*)(Qs + row * 264 + sg * 8) = *(const u32x4*)(Qg + (size_t)row * 1024 + sg * 8); }
    __syncthreads();
    if (tid < 256) { const int d = tid >> 7, t = tid & 127; const LAS float* lf = lfA + d * 128; const LAS float* li = liA + d * 128;
        const float mc = ((const float*)(p.ws + OFF_MST))[(sid0 + d) * 16 + c];
        float run = 0.f, bt = 0.f, at = 0.f, pmax = -3.0e38f;
        if (d == 0) { for (int j = 0; j < 128; ++j) { run += lf[j]; const float aj = li[j] - run; if (j <= t) { pmax = fmaxf(pmax, aj); } if (j == t) { bt = run; at = aj; } } }
        else { for (int j = 127; j >= 0; --j) { run += lf[j]; const float aj = li[j] - run; if (j >= t) { pmax = fmaxf(pmax, aj); } if (j == t) { bt = run; at = aj; } } }
        const float Mt = fmaxf(mc, pmax);
        aA[tid] = at; MA[tid] = Mt; winA[tid] = expf(mc - Mt); clampA[tid] = expf(-(bt + Mt));
        float s = 0.f; const LAS float* nv = nvec + d * 256;
        for (int k8 = 0; k8 < 32; ++k8) { const u32x4 qv = *(const LAS u32x4*)(Qs + t * 264 + k8 * 8); const LAS float* np = nv + k8 * 8;
            s += bf_lo(qv.x) * np[0] + bf_hi(qv.x) * np[1] + bf_lo(qv.y) * np[2] + bf_hi(qv.y) * np[3] + bf_lo(qv.z) * np[4] + bf_hi(qv.z) * np[5] + bf_lo(qv.w) * np[6] + bf_hi(qv.w) * np[7]; }
        nqA[tid] = s; }
    __syncthreads();
    const int wt2 = wid >> 2, w4 = wid & 3;
    {
        f32x4 sacc[4][2];
#pragma unroll
        for (int mt = 0; mt < 4; ++mt)
#pragma unroll
            for (int nt = 0; nt < 2; ++nt) sacc[mt][nt] = (f32x4){0.f, 0.f, 0.f, 0.f};
        const bf16_t* Kg = (const bf16_t*)(p.ws + OFF_K) + (size_t)(tokbase + w4 * 32 + fr) * 1024 + h * 256 + fq * 8;
#pragma unroll
        for (int ks = 0; ks < 8; ++ks) { bf16x8 kf[2], qf[4];
#pragma unroll
            for (int nt = 0; nt < 2; ++nt) kf[nt] = *(const bf16x8*)(Kg + (size_t)(nt * 16) * 1024 + ks * 32);
#pragma unroll
            for (int mt = 0; mt < 4; ++mt) qf[mt] = *(const LAS bf16x8*)(Qs + (wt2 * 64 + mt * 16 + fr) * 264 + ks * 32 + fq * 8);
#pragma unroll
            for (int mt = 0; mt < 4; ++mt)
#pragma unroll
                for (int nt = 0; nt < 2; ++nt) sacc[mt][nt] = __builtin_amdgcn_mfma_f32_16x16x32_bf16(kf[nt], qf[mt], sacc[mt][nt], 0, 0, 0); }
#pragma unroll
        for (int mt = 0; mt < 4; ++mt) { const int t = wt2 * 64 + mt * 16 + fr; const float Mf = MA[t], Mb = MA[128 + t]; float rf = 0.f, rb = 0.f;
#pragma unroll
            for (int nt = 0; nt < 2; ++nt) { const int s0 = w4 * 32 + nt * 16 + fq * 4; float pf[4], pb[4];
#pragma unroll
                for (int r = 0; r < 4; ++r) { const int s = s0 + r; const float val = sacc[mt][nt][r];
                    const float ef = __expf(fminf(aA[s] - Mf, 0.f)), eb = __expf(fminf(aA[128 + s] - Mb, 0.f));
                    pf[r] = (s <= t) ? val * ef : 0.f; pb[r] = (s >= t) ? val * eb : 0.f; rf += pf[r]; rb += pb[r]; }
                u32x2 wf, wb; wf.x = cvt_pk_bf16(pf[0], pf[1]); wf.y = cvt_pk_bf16(pf[2], pf[3]); wb.x = cvt_pk_bf16(pb[0], pb[1]); wb.y = cvt_pk_bf16(pb[2], pb[3]);
                *(LAS u32x2*)(Pd + t * 136 + s0) = wf; *(LAS u32x2*)(Pd + 128 * 136 + t * 136 + s0) = wb; }
            rf += __shfl_xor(rf, 16); rf += __shfl_xor(rf, 32); rb += __shfl_xor(rb, 16); rb += __shfl_xor(rb, 32);
            if (fq == 0) { rsP[w4 * 128 + t] = rf; rsP[512 + w4 * 128 + t] = rb; } }
    }
    __syncthreads();
    f32x4 hsum[4][4];
#pragma unroll
    for (int mt = 0; mt < 4; ++mt)
#pragma unroll
        for (int nt = 0; nt < 4; ++nt) hsum[mt][nt] = (f32x4){0.f, 0.f, 0.f, 0.f};
#pragma unroll 1
    for (int d = 0; d < 2; ++d) {
        f32x4 acc[4][4];
#pragma unroll
        for (int mt = 0; mt < 4; ++mt)
#pragma unroll
            for (int nt = 0; nt < 4; ++nt) acc[mt][nt] = (f32x4){0.f, 0.f, 0.f, 0.f};
        const bf16_t* Cg = cst_ptr(p, sid0 + d, c) + (size_t)(w4 * 64 + fr) * 256 + fq * 8;
#pragma unroll 2
        for (int ks = 0; ks < 8; ++ks) { bf16x8 cf[4], qf[4];
#pragma unroll
            for (int nt = 0; nt < 4; ++nt) cf[nt] = *(const bf16x8*)(Cg + (size_t)(nt * 16) * 256 + ks * 32);
#pragma unroll
            for (int mt = 0; mt < 4; ++mt) qf[mt] = *(const LAS bf16x8*)(Qs + (wt2 * 64 + mt * 16 + fr) * 264 + ks * 32 + fq * 8);
#pragma unroll
            for (int mt = 0; mt < 4; ++mt)
#pragma unroll
                for (int nt = 0; nt < 4; ++nt) acc[mt][nt] = __builtin_amdgcn_mfma_f32_16x16x32_bf16(cf[nt], qf[mt], acc[mt][nt], 0, 0, 0); }
#pragma unroll
        for (int mt = 0; mt < 4; ++mt) { const float wi = winA[d * 128 + wt2 * 64 + mt * 16 + fr];
#pragma unroll
            for (int nt = 0; nt < 4; ++nt) acc[mt][nt] *= wi; }
        const bf16_t* Vg = (const bf16_t*)(p.ws + OFF_VT) + (size_t)(h * 256 + w4 * 64 + fr) * 16384 + tokbase + fq * 8;
        const LAS bf16_t* Pp = Pd + d * 128 * 136;
#pragma unroll 2
        for (int ks = 0; ks < 4; ++ks) { bf16x8 vf[4], pf[4];
#pragma unroll
            for (int nt = 0; nt < 4; ++nt) vf[nt] = *(const bf16x8*)(Vg + (size_t)(nt * 16) * 16384 + ks * 32);
#pragma unroll
            for (int mt = 0; mt < 4; ++mt) pf[mt] = *(const LAS bf16x8*)(Pp + (wt2 * 64 + mt * 16 + fr) * 136 + ks * 32 + fq * 8);
#pragma unroll
            for (int mt = 0; mt < 4; ++mt)
#pragma unroll
                for (int nt = 0; nt < 4; ++nt) acc[mt][nt] = __builtin_amdgcn_mfma_f32_16x16x32_bf16(vf[nt], pf[mt], acc[mt][nt], 0, 0, 0); }
#pragma unroll
        for (int mt = 0; mt < 4; ++mt) { const int t = wt2 * 64 + mt * 16 + fr; const int dt = d * 128 + t;
            const float den = winA[dt] * nqA[dt] + ((rsP[d * 512 + t] + rsP[d * 512 + 128 + t]) + (rsP[d * 512 + 256 + t] + rsP[d * 512 + 384 + t]));
            const float inv = 1.0f / fmaxf(fabsf(den), clampA[dt]);
#pragma unroll
            for (int nt = 0; nt < 4; ++nt) hsum[mt][nt] += acc[mt][nt] * inv; }
    }
#pragma unroll
    for (int mt = 0; mt < 4; ++mt) { float s = 0.f;
#pragma unroll
        for (int nt = 0; nt < 4; ++nt) { const f32x4 hv = hsum[mt][nt]; s += (hv[0] * hv[0] + hv[1] * hv[1]) + (hv[2] * hv[2] + hv[3] * hv[3]); }
        s += __shfl_xor(s, 16); s += __shfl_xor(s, 32);
        if (fq == 0) ssP[w4 * 128 + wt2 * 64 + mt * 16 + fr] = s; }
    __syncthreads();
#pragma unroll
    for (int mt = 0; mt < 4; ++mt) { const int t = wt2 * 64 + mt * 16 + fr;
        const float tot = (ssP[t] + ssP[128 + t]) + (ssP[256 + t] + ssP[384 + t]); const float rinv = rsqrtf(tot * (1.0f / 256.0f) + 1e-6f);
#pragma unroll
        for (int nt = 0; nt < 4; ++nt) { const int v = w4 * 64 + nt * 16 + fq * 4; const f32x4 hw = *(const f32x4*)(p.head_norm_w + h * 256 + v);
            const f32x4 o = hsum[mt][nt] * rinv * hw;
            u32x2 w; w.x = cvt_pk_bf16(o[0], o[1]); w.y = cvt_pk_bf16(o[2], o[3]);
            *(u32x2*)(Qg + (size_t)t * 1024 + v) = w; } }
    __syncthreads();
}

__device__ void phase_final(const Params& p) {
    const int tid = threadIdx.x, wid = tid >> 6, lane = tid & 63;
    const float* ssq = (const float*)(p.ws + OFF_SSQ);
    for (int row = blockIdx.x * 8 + wid; row < 16384; row += gridDim.x * 8) {
        const f32x4 s0 = *(const f32x4*)(ssq + (size_t)row * 16), s1 = *(const f32x4*)(ssq + (size_t)row * 16 + 4), s2 = *(const f32x4*)(ssq + (size_t)row * 16 + 8), s3 = *(const f32x4*)(ssq + (size_t)row * 16 + 12);
        const float tot = ((s0[0] + s0[1]) + (s0[2] + s0[3])) + ((s1[0] + s1[1]) + (s1[2] + s1[3])) + ((s2[0] + s2[1]) + (s2[2] + s2[3])) + ((s3[0] + s3[1]) + (s3[2] + s3[3]));
        const float rstd = rsqrtf(tot * (1.0f / 1024.0f) + 1e-6f);
        float* orow = p.out + (size_t)row * 1024;
#pragma unroll
        for (int i = 0; i < 4; ++i) { const f32x4 v = *(const f32x4*)(orow + i * 256 + lane * 4); const f32x4 w = *(const f32x4*)(p.final_norm_w + i * 256 + lane * 4);
            *(f32x4*)(orow + i * 256 + lane * 4) = v * rstd * w; }
    }
}

__device__ __forceinline__ void run_phase(const Params& p, LAS unsigned char* lds, int ph) {
    const int tid = threadIdx.x;
    const bf16_t* AB = (const bf16_t*)(p.ws + OFF_AB);
    switch (ph) {
    case 0: phase0(p, lds); break;
    case 1: phase1(p, lds); break;
    case 2: { SchedG1 S{(int)blockIdx.x}; EpiG1 E{p.ws}; pg8::gemm_phase(lds, pg8::Gemm{AB, AB, 1024}, S, E); } break;
    case 3: {
        passA(p, lds, blockIdx.x);
        boxfilter_unit(p, lds, blockIdx.x); boxfilter_unit(p, lds, 511 - blockIdx.x);
        bf16_t* bt = (bf16_t*)(p.ws + OFF_BTPOOL);
        for (int idx = blockIdx.x * 512 + tid; idx < 512 * 512; idx += NWG * 512) { const int n = idx >> 9, k = idx & 511; const int gn = n >> 7, gk = k >> 7;
            const float v = (gn == gk) ? p.pool_w[(size_t)(gn * 128 + (k & 127)) * 128 + (n & 127)] : 0.f;
            bt[idx] = (bf16_t)(cvt_pk_bf16(v, 0.f) & 0xffffu); }
    } break;
    case 4: {
        passB_unit(p, lds, blockIdx.x * 2); passB_unit(p, lds, blockIdx.x * 2 + 1);
        Sched64 S{(int)blockIdx.x, 2}; EpiPool E{p.ws, p.pool_scale};
        pg8::gemm_phase(lds, pg8::Gemm{(const bf16_t*)(p.ws + OFF_MX), (const bf16_t*)(p.ws + OFF_BTPOOL), 512}, S, E);
    } break;
    case 5: {
        LAS float* T = (LAS float*)lds;
        for (int job = blockIdx.x; job < 640; job += NWG) {
            if (job < 256) { const int kt = job & 15, ntile = job >> 4; transpose_tile(p.branch_m_w, 1024, kt * 64, ntile * 64, (bf16_t*)(p.ws + OFF_WMT), 1024, ntile * 64, T); }
            else if (job < 512) { const int j2 = job - 256; const int kt = j2 & 15, ntile = j2 >> 4; transpose_tile(p.out_w, 1024, kt * 64, ntile * 64, (bf16_t*)(p.ws + OFF_WOT), 1024, ntile * 64, T); }
            else { const int j2 = job - 512; const int kt = j2 & 7, ntile = j2 >> 3; transpose_tile(p.branch_p_w, 1024, kt * 64, ntile * 64, (bf16_t*)(p.ws + OFF_WPT), 512, ntile * 64, T); }
        }
        SchedG2 S{(int)blockIdx.x}; EpiG2 E{p.ws}; pg8::gemm_phase(lds, pg8::Gemm{AB, AB, 1024}, S, E);
    } break;
    case 6: {
        Sched64 S{(int)blockIdx.x, 4};
        { EpiMergeP E{p.ws, p.out}; pg8::gemm_phase(lds, pg8::Gemm{(const bf16_t*)(p.ws + OFF_PM), (const bf16_t*)(p.ws + OFF_WPT), 512}, S, E); }
        { EpiMergeM E{p.ws, p.out}; pg8::gemm_phase(lds, pg8::Gemm{(const bf16_t*)(p.ws + OFF_Q), (const bf16_t*)(p.ws + OFF_WMT), 1024}, S, E); }
    } break;
    case 7: { Sched64 S{(int)blockIdx.x, 4}; EpiOut E{p.ws, p.x, p.out}; pg8::gemm_phase(lds, pg8::Gemm{(const bf16_t*)(p.ws + OFF_MG), (const bf16_t*)(p.ws + OFF_WOT), 1024}, S, E); } break;
    case 8: phase_final(p); break;
    default: break;
    }
}
#if MULTI_LAUNCH
template <int PH> __global__ void __launch_bounds__(512, 2) k_one(Params p) {
    extern __shared__ __attribute__((aligned(16))) unsigned char shm[];
    run_phase(p, (LAS unsigned char*)shm, PH);
}
#else
__global__ void __launch_bounds__(512, 2) fwd_megakernel(Params p) {
    extern __shared__ __attribute__((aligned(16))) unsigned char shm[];
    LAS unsigned char* lds = (LAS unsigned char*)shm;
    for (int ph = 0; ph <= 8; ++ph) {
        if (ph > 0) cg::this_grid().sync();
        run_phase(p, lds, ph);
    }
}
#endif

extern "C" void kernel_launch(void* const* d_in, const int* in_sizes, int n_in, void* d_out, int out_size, void* d_ws, size_t ws_size, hipStream_t stream) {
#if MULTI_LAUNCH
#define SETATTR(PH) (void)hipFuncSetAttribute((const void*)k_one<PH>, hipFuncAttributeMaxDynamicSharedMemorySize, LDS_BYTES)
    static int configured = 0;
    if (!configured) { SETATTR(0); SETATTR(1); SETATTR(2); SETATTR(3); SETATTR(4); SETATTR(5); SETATTR(6); SETATTR(7); SETATTR(8); configured = 1; }
#else
    static int configured = 0;
    if (!configured) {
        (void)hipFuncSetAttribute((const void*)fwd_megakernel, hipFuncAttributeMaxDynamicSharedMemorySize, LDS_BYTES);
        int dev = 0, cus = 0, per_cu = 0;
        (void)hipGetDevice(&dev); (void)hipDeviceGetAttribute(&cus, hipDeviceAttributeMultiprocessorCount, dev);
        (void)hipOccupancyMaxActiveBlocksPerMultiprocessor(&per_cu, fwd_megakernel, 512, LDS_BYTES);
        if (cus * per_cu < NWG) fprintf(stderr, "grid %d exceeds resident capacity %d x %d\n", NWG, cus, per_cu);
        if (ws_size < 256 * MiB) fprintf(stderr, "workspace too small: %zu\n", ws_size);
        configured = 1;
    }
#endif
    Params p{};
    p.x = (const float*)d_in[0]; p.c = (const float*)d_in[1]; p.ctx = (const float*)d_in[2]; p.c_ctx = (const float*)d_in[3]; p.norm_w = (const float*)d_in[4];
    p.ada_w = (const float*)d_in[5]; p.ada_b = (const float*)d_in[6]; p.in_w = (const float*)d_in[7]; p.gate_b = (const float*)d_in[8]; p.head_norm_w = (const float*)d_in[9];
    p.pool_w = (const float*)d_in[10]; p.pool_scale = (const float*)d_in[11]; p.branch_m_w = (const float*)d_in[12]; p.branch_p_w = (const float*)d_in[13]; p.out_w = (const float*)d_in[14];
    p.final_norm_w = (const float*)d_in[15];
    p.out = (float*)d_out; p.ws = (unsigned char*)d_ws;
#if MULTI_LAUNCH
#define LAUNCH(PH) hipLaunchKernelGGL(k_one<PH>, dim3(NWG), dim3(512), LDS_BYTES, stream, p)
    LAUNCH(0); LAUNCH(1); LAUNCH(2); LAUNCH(3); LAUNCH(4); LAUNCH(5); LAUNCH(6); LAUNCH(7); LAUNCH(8);
#else
    p.ph_lo = 0; p.ph_hi = 8;
    void* args[] = {&p};
    hipError_t e = hipLaunchCooperativeKernel((const void*)fwd_megakernel, dim3(NWG), dim3(512), args, LDS_BYTES, stream);
    if (e != hipSuccess) fprintf(stderr, "cooperative launch failed: %s\n", hipGetErrorString(e));
#endif
}
```

```cpp
#include <hip/hip_runtime.h>
#include <hip/hip_cooperative_groups.h>
#include <cstdio>
namespace cg = cooperative_groups;

#ifndef MULTI_LAUNCH
#define MULTI_LAUNCH 0
#endif

#define LAS __attribute__((address_space(3)))
typedef unsigned short bf16_t;
typedef short bf16x8 __attribute__((ext_vector_type(8)));
typedef float f32x4 __attribute__((ext_vector_type(4)));
typedef unsigned u32x4 __attribute__((ext_vector_type(4)));
typedef unsigned u32x2 __attribute__((ext_vector_type(2)));

constexpr size_t MiB = 1024u * 1024u;
constexpr int LDS_BYTES = 155648;
constexpr int NWG = 256;
constexpr size_t OFF_AB = 0;
constexpr size_t OFF_BTPOOL = 32 * MiB;
constexpr size_t OFF_Q = 52 * MiB;
constexpr size_t OFF_K = 84 * MiB;
constexpr size_t OFF_VT = 116 * MiB;
constexpr size_t OFF_KC = 148 * MiB;
constexpr size_t OFF_VTC = 152 * MiB;
constexpr size_t OFF_P = 156 * MiB;
constexpr size_t OFF_PM = 148 * MiB;
constexpr size_t OFF_MX = 172 * MiB;
constexpr size_t OFF_CST2 = 188 * MiB;
constexpr size_t OFF_GB = 188 * MiB;
constexpr size_t OFF_WMT = 36 * MiB, OFF_WPT = 38 * MiB, OFF_WOT = 39 * MiB;
constexpr size_t OFF_MG = 116 * MiB;
constexpr size_t OFF_SMALL = 252 * MiB;
constexpr size_t OFF_GL = OFF_SMALL;
constexpr size_t OFF_SSQ = OFF_SMALL;
constexpr size_t OFF_GC = OFF_SMALL + 1 * MiB;
constexpr size_t OFF_NST = OFF_SMALL + 1 * MiB + 128 * 1024;
constexpr size_t OFF_MST = OFF_NST + 1 * MiB;
constexpr size_t OFF_MODP = OFF_MST + 4096;
constexpr size_t OFF_GATEV = OFF_MODP + 8 * 9 * 3072 * 4;
constexpr size_t OFF_PCNT = OFF_SMALL + 3 * MiB + 512 * 1024 + 16384;
constexpr size_t OFF_PFLAG = OFF_SMALL + 3 * MiB + 512 * 1024 + 32768;
constexpr size_t OFF_ACNT = OFF_SMALL + 3 * MiB + 512 * 1024 + 15360;
constexpr size_t OFF_BAR = OFF_SMALL + 3 * MiB + 512 * 1024;

struct Params {
    const float *x, *c, *ctx, *c_ctx, *norm_w, *ada_w, *ada_b, *in_w, *gate_b, *head_norm_w, *pool_w, *pool_scale, *branch_m_w, *branch_p_w, *out_w, *final_norm_w;
    float* out; unsigned char* ws;
    int ph_lo, ph_hi;
};

__device__ __forceinline__ int opaque_tid() { int t = (int)threadIdx.x; asm volatile("" : "+v"(t)); return t; }
__device__ __forceinline__ float bf_lo(unsigned w) { return __uint_as_float(w << 16); }
__device__ __forceinline__ float bf_hi(unsigned w) { return __uint_as_float(w & 0xffff0000u); }
__device__ __forceinline__ unsigned cvt_pk_bf16(float lo, float hi) { unsigned r; asm volatile("v_cvt_pk_bf16_f32 %0, %1, %2" : "=v"(r) : "v"(lo), "v"(hi)); return r; }
__device__ __forceinline__ float sigm(float x) { return __builtin_amdgcn_rcpf(1.0f + __expf(-x)); }
__device__ __forceinline__ float siluf(float x) { return x * __builtin_amdgcn_rcpf(1.0f + __expf(-x)); }

namespace pg8 {
constexpr int BM = 256, BK = 64, HALF = 128, HTB = HALF * BK * 2, STAGE_BYTES = 8 * HTB;
__device__ __forceinline__ int lds_byte(int r, int c) { const int st = (r >> 4) * 2 + (c >> 5), rr = r & 15, cc = c & 31, ob = rr * 64 + cc * 2; return st * 1024 + (ob ^ (((ob >> 9) & 1) << 5)); }
__device__ __forceinline__ void stage_rc(int b, int& R, int& C) { const int st = b / 1024, sb = b % 1024, swz = sb ^ (((sb >> 9) & 1) << 5); R = (st >> 1) * 16 + swz / 64; C = (st & 1) * 32 + (swz % 64) / 2; }
__device__ __forceinline__ int perm32(int rho) { const int n = rho >> 4, i = rho & 15; return 8 * (i >> 2) + 4 * n + (i & 3); }
struct Unit { int pm, pn; };
struct Gemm { const bf16_t* A; const bf16_t* Bt; int K; };

template <class Epi, class Sched, bool ZERO>
__device__ __forceinline__ void gemm_phase_acc(LAS unsigned char* lds, const Gemm g, const Sched& S, const Epi& E, f32x4 (&acc)[2][2][4][2]) {
    const int tid = opaque_tid(), wid = __builtin_amdgcn_readfirstlane(tid >> 6), lane = tid & 63, wr = wid >> 2, wc = wid & 3, fr = lane & 15, fq = lane >> 4;
    const int K = g.K, nt = K / BK;
    unsigned voffA[2], voffB[2];
#pragma unroll
    for (int i = 0; i < 2; ++i) { int R, C; stage_rc(tid * 16 + i * 8192, R, C); const int Rb = (R & ~31) + perm32(R & 31);
        voffA[i] = (unsigned)(R * K + C) * 2u; voffB[i] = (unsigned)(Rb * K + C) * 2u; }
    const size_t kstep = (size_t)(BK * 2);
    const size_t hstep = (size_t)HALF * K * 2;
    const size_t tstep = 2 * hstep;
    const unsigned ldsw = (unsigned)wid * 1024u;
    const int aoff = lds_byte(wr * 64 + fr, fq * 8), boff = lds_byte(wc * 32 + fr, fq * 8);
#define PG8_SA(b, h) (((b) * 2 + (h)) * HTB)
#define PG8_SB(b, h) ((4 + (b) * 2 + (h)) * HTB)
#define PG8_STAGE(bufoff, gbase, voff) do { _Pragma("unroll") for (int _i = 0; _i < 2; ++_i) \
        __builtin_amdgcn_global_load_lds((const unsigned*)((const char*)(gbase) + (voff)[_i]), (LAS unsigned*)(lds + (bufoff) + ldsw + _i * 8192), 16, 0, 0); } while (0)
#define PG8_LDA(dst, b, h) do { _Pragma("unroll") for (int m = 0; m < 4; ++m) _Pragma("unroll") for (int k = 0; k < 2; ++k) dst[m][k] = *(const LAS bf16x8*)(lds + PG8_SA(b, h) + aoff + m * 2048 + k * 1024); } while (0)
#define PG8_LDB(dst, b, h) do { _Pragma("unroll") for (int n = 0; n < 2; ++n) _Pragma("unroll") for (int k = 0; k < 2; ++k) dst[n][k] = *(const LAS bf16x8*)(lds + PG8_SB(b, h) + boff + n * 2048 + k * 1024); } while (0)
#define PG8_MMA(ai, bj, At, Bt) do { __builtin_amdgcn_s_setprio(1); _Pragma("unroll") for (int m = 0; m < 4; ++m) _Pragma("unroll") for (int n = 0; n < 2; ++n) _Pragma("unroll") for (int k = 0; k < 2; ++k) \
        acc[ai][bj][m][n] = __builtin_amdgcn_mfma_f32_16x16x32_bf16(Bt[n][k], At[m][k], acc[ai][bj][m][n], 0, 0, 0); __builtin_amdgcn_s_setprio(0); } while (0)
#define PG8_WAIT_V(n) asm volatile("s_waitcnt vmcnt(" #n ")" ::: "memory")
#define PG8_WAIT_L(n) asm volatile("s_waitcnt lgkmcnt(" #n ")" ::: "memory")
#define PG8_BAR __builtin_amdgcn_s_barrier()
#define PG8_SCHED __builtin_amdgcn_sched_barrier(0)
    Unit cur, nxt; int ui = 0;
    if (!S.next(0, cur)) return;
    if constexpr (ZERO) {
#pragma unroll
    for (int a = 0; a < 2; ++a)
#pragma unroll
        for (int b = 0; b < 2; ++b)
#pragma unroll
            for (int m = 0; m < 4; ++m)
#pragma unroll
                for (int n = 0; n < 2; ++n) acc[a][b][m][n] = (f32x4){0.f, 0.f, 0.f, 0.f};
    }
    bf16x8 At[4][2], B0[2][2], B1[2][2];
    const char* cA = (const char*)g.A + (size_t)cur.pm * tstep; const char* cB = (const char*)g.Bt + (size_t)cur.pn * tstep;
    PG8_STAGE(PG8_SB(0, 0), cB, voffB); PG8_STAGE(PG8_SA(0, 0), cA, voffA); PG8_STAGE(PG8_SB(0, 1), cB + hstep, voffB); PG8_STAGE(PG8_SA(0, 1), cA + hstep, voffA);
    if (wr == 1) PG8_BAR;
    PG8_WAIT_V(4); PG8_BAR;
    PG8_STAGE(PG8_SB(1, 0), cB + kstep, voffB); PG8_STAGE(PG8_SA(1, 0), cA + kstep, voffA); PG8_STAGE(PG8_SB(1, 1), cB + hstep + kstep, voffB);
    PG8_WAIT_V(6); PG8_BAR;
    for (;;) {
        const bool has_next = S.next(ui + 1, nxt);
        const char* nA = has_next ? (const char*)g.A + (size_t)nxt.pm * tstep : cA; const char* nB = has_next ? (const char*)g.Bt + (size_t)nxt.pn * tstep : cB;
        for (int t = 0; t < nt; t += 2) {
            const bool last = (t == nt - 2);
            const char* a1 = cA + (size_t)(t + 1) * kstep;
            const char* a2 = last ? nA : cA + (size_t)(t + 2) * kstep; const char* b2 = last ? nB : cB + (size_t)(t + 2) * kstep;
            const char* a3 = a2 + kstep; const char* b3 = b2 + kstep;
            PG8_LDB(B0, 0, 0); PG8_SCHED; PG8_LDA(At, 0, 0); PG8_STAGE(PG8_SA(1, 1), a1 + hstep, voffA);
            PG8_WAIT_L(8); PG8_BAR; PG8_WAIT_L(0); PG8_MMA(0, 0, At, B0); PG8_BAR; PG8_SCHED;
            PG8_LDB(B1, 0, 1); PG8_STAGE(PG8_SB(0, 0), b2, voffB);
            PG8_BAR; PG8_WAIT_L(0); PG8_MMA(0, 1, At, B1); PG8_BAR;
            PG8_LDA(At, 0, 1); PG8_STAGE(PG8_SA(0, 0), a2, voffA);
            PG8_BAR; PG8_WAIT_L(0); PG8_MMA(1, 0, At, B0); PG8_BAR; PG8_SCHED;
            PG8_STAGE(PG8_SB(0, 1), b2 + hstep, voffB);
            PG8_WAIT_V(6); PG8_BAR; PG8_MMA(1, 1, At, B1); PG8_BAR;
            PG8_LDB(B0, 1, 0); PG8_SCHED; PG8_LDA(At, 1, 0); PG8_STAGE(PG8_SA(0, 1), a2 + hstep, voffA);
            PG8_WAIT_L(8); PG8_BAR; PG8_WAIT_L(0); PG8_MMA(0, 0, At, B0); PG8_BAR; PG8_SCHED;
            PG8_LDB(B1, 1, 1); PG8_STAGE(PG8_SB(1, 0), b3, voffB);
            PG8_BAR; PG8_WAIT_L(0); PG8_MMA(0, 1, At, B1); PG8_BAR;
            PG8_LDA(At, 1, 1); PG8_STAGE(PG8_SA(1, 0), a3, voffA);
            PG8_BAR; PG8_WAIT_L(0); PG8_MMA(1, 0, At, B0); PG8_BAR; PG8_SCHED;
            PG8_STAGE(PG8_SB(1, 1), b3 + hstep, voffB);
            PG8_WAIT_V(6); PG8_BAR; PG8_MMA(1, 1, At, B1); PG8_BAR;
        }
        if constexpr (!Epi::AFTER_DRAIN) E(acc, cur, wr, wc, fr, fq);
        if constexpr (Epi::DRAIN) __builtin_amdgcn_s_waitcnt(0x0F70);
        if (!has_next) break;
#pragma unroll
        for (int a = 0; a < 2; ++a)
#pragma unroll
            for (int b = 0; b < 2; ++b)
#pragma unroll
                for (int m = 0; m < 4; ++m)
#pragma unroll
                    for (int n = 0; n < 2; ++n) acc[a][b][m][n] = (f32x4){0.f, 0.f, 0.f, 0.f};
        cur = nxt; cA = nA; cB = nB; ++ui;
    }
    PG8_WAIT_V(0);
    if (wr == 0) PG8_BAR;
    PG8_BAR;
    if constexpr (Epi::AFTER_DRAIN) E.fused(acc, cur, wr, wc, fr, fq, lds);
#undef PG8_SA
#undef PG8_SB
#undef PG8_STAGE
#undef PG8_LDA
#undef PG8_LDB
#undef PG8_MMA
#undef PG8_WAIT_V
#undef PG8_WAIT_L
#undef PG8_BAR
#undef PG8_SCHED
}
template <class Epi, class Sched>
__device__ __forceinline__ void gemm_phase(LAS unsigned char* lds, const Gemm g, const Sched& S, const Epi& E) {
    f32x4 acc[2][2][4][2];
    gemm_phase_acc<Epi, Sched, true>(lds, g, S, E, acc);
}
}
using pg8::Unit;

struct SchedG1 {
    int c;
    __device__ __forceinline__ bool next(int i, Unit& u) const {
        const int xcd = c & 7, slot = c >> 3, pmt = xcd * 8 + (slot >> 2), j = slot & 3;
        if (i < 2) { u.pm = pmt; u.pn = 72 + i * 4 + j; return true; }
        if (i == 2) { u.pm = 72 + 8 + j; u.pn = pmt; return true; }
        if (i == 3) {
            if (j < 2) { u.pm = pmt; u.pn = 72 + 20 + j; return true; }
            if (j == 2) { int cu = pmt;
                if (cu < 32) { u.pm = 64 + (cu >> 2); u.pn = 72 + 4 + (cu & 3); }
                else { cu -= 32; u.pm = 72 + 8 + (cu & 3); u.pn = 64 + (cu >> 2); }
                return true; }
        }
        return false;
    }
};
struct SchedG2 {
    int c;
    __device__ __forceinline__ bool next(int i, Unit& u) const {
        const int xcd = c & 7, slot = c >> 3, pmt = xcd * 8 + (slot >> 2), j = slot & 3;
        u.pm = pmt;
        if (i == 0) { u.pn = 72 + 12 + j; return true; }
        if (i == 1) { u.pn = 72 + 16 + j; return true; }
        if (i == 2) { u.pn = 72 + 24 + j; return true; }
        if (i == 3) { u.pn = 72 + 28 + j; return true; }
        return false;
    }
};
struct SchedOne {
    int pm, pn;
    __device__ __forceinline__ bool next(int i, Unit& u) const { if (i == 0) { u.pm = pm; u.pn = pn; return true; } return false; }
};
struct Sched64 {
    int c, ncol;
    __device__ __forceinline__ bool next(int i, Unit& u) const {
        const int xcd = c & 7, slot = c >> 3, pmt = xcd * 8 + (slot >> 2), j = slot & 3;
        if (i == 0 && j < ncol) { u.pm = pmt; u.pn = j; return true; }
        return false;
    }
};

struct EpiG1 {
    static constexpr bool AFTER_DRAIN = false;
    static constexpr bool DRAIN = false;
    unsigned char* ws;
    __device__ __forceinline__ void operator()(const f32x4 (&acc)[2][2][4][2], const Unit& u, int wr, int wc, int fr, int fq) const {
        const bool sw = u.pm >= 72;
        const int tokt = sw ? u.pn : u.pm, wt = (sw ? u.pm : u.pn) - 72;
        bf16_t* base; int ld; float sc = 1.0f; int rowbase;
        if (!sw) {
            rowbase = tokt * 256;
            if (wt < 4) { base = (bf16_t*)(ws + OFF_Q) + (size_t)(tokt * 4 + wt) * 65536 + ((wr * 4 + wc) * 16 * 64 + (fq * 16 + fr)) * 8; ld = 0; }
            else if (wt < 8) { sc = 0.0625f; ld = 0;
                if (tokt < 64) base = (bf16_t*)(ws + OFF_K) + (size_t)((tokt * 2) * 4 + (wt - 4)) * 32768;
                else base = (bf16_t*)(ws + OFF_KC) + (size_t)(((tokt - 64) * 2) * 4 + (wt - 4)) * 32768; }
            else { base = (bf16_t*)(ws + OFF_P); ld = 0; }
        } else {
            rowbase = (wt - 8) * 256;
            if (tokt < 64) base = (bf16_t*)(ws + OFF_VT) + (size_t)(tokt * 2) * 1024 * 128;
            else base = (bf16_t*)(ws + OFF_VTC) + (size_t)((tokt - 64) * 2) * 1024 * 128;
            ld = 128;
        }
        const int row0 = rowbase + wr * 64 + fr, col0 = wc * 32 + 8 * fq;
        const size_t bjstep = sw ? (size_t)1024 * 128 : (wt >= 20 ? (size_t)16 * 2048 * 8 : (wt >= 4 && wt < 8 ? (size_t)4 * 512 : (wt < 4 ? (size_t)512 : (size_t)128)));
#pragma unroll
        for (int ai = 0; ai < 2; ++ai)
#pragma unroll
            for (int m = 0; m < 4; ++m) {
                const bool isp = !sw && wt >= 20, isk = !sw && wt >= 4 && wt < 8, isq = !sw && wt < 4;
                bf16_t* rowp = sw ? base + (size_t)((((rowbase + wr * 64 + ai * 128 + m * 16) >> 4) * 4 + wc) * 512 + (fr * 4 + fq) * 8)
                             : isq ? base + ((ai * 4 + m) * 2) * 512
                             : isk ? base + (size_t)(ai * 4 * 64 + (wr * 4 + m) * 8 + wc) * 512 + (fr * 4 + fq) * 8
                             : isp ? base + ((size_t)((tokt >> 3) * 64 + (wt - 20) * 32 + wc * 4 + fq) * 2048 + ((row0 + ai * 128 + m * 16) & 2047)) * 8
                                   : base + (size_t)(row0 + ai * 128 + m * 16) * ld + col0;
#pragma unroll
                for (int bj = 0; bj < 2; ++bj) { const f32x4 v0 = acc[ai][bj][m][0] * sc, v1 = acc[ai][bj][m][1] * sc;
                    u32x4 w; w.x = cvt_pk_bf16(v0[0], v0[1]); w.y = cvt_pk_bf16(v0[2], v0[3]); w.z = cvt_pk_bf16(v1[0], v1[1]); w.w = cvt_pk_bf16(v1[2], v1[3]);
                    *(u32x4*)(rowp + bj * bjstep) = w; } }
    }
};
struct EpiG2 {
    static constexpr bool AFTER_DRAIN = false;
    static constexpr bool DRAIN = true;
    unsigned char* ws; bf16_t* am;
    __device__ __forceinline__ void operator()(const f32x4 (&acc)[2][2][4][2], const Unit& u, int wr, int wc, int fr, int fq) const {
        const int wt = u.pn - 72;
        const int gl_off = ((wr * 4 + wc) * 16 * 64 + (fq * 16 + fr)) * 8;
        const int row0 = u.pm * 256 + wr * 64 + fr, col0 = wc * 32 + 8 * fq;
        const bf16_t* ldp = nullptr; bf16_t* stp; bool ld_lm = false, st_lm = false, act_silu = false, recip = false; int ld = 0;
        if (wt < 16) { bf16_t* t = (bf16_t*)(ws + OFF_Q) + (size_t)(u.pm * 4 + (wt - 12)) * 65536 + gl_off; ldp = t; stp = t; ld_lm = st_lm = true; }
        else if (wt < 20) { ldp = (const bf16_t*)(ws + OFF_Q) + (size_t)(u.pm * 4 + (wt - 16)) * 65536 + gl_off; ld_lm = true; stp = am + (wt - 16) * 256; ld = 1024; act_silu = true; }
        else if (wt < 24) { bf16_t* t = (bf16_t*)(ws + OFF_PM) + (wt - 22) * 256; ldp = t; stp = t; ld = 512; act_silu = true; }
        else if (wt < 28) { stp = (bf16_t*)(ws + OFF_GB) + (size_t)(u.pm * 8 + (wt - 24)) * 65536 + gl_off; st_lm = true; }
        else { bf16_t* t = (bf16_t*)(ws + OFF_GB) + (size_t)(u.pm * 8 + (wt - 24)) * 65536 + gl_off; stp = t; st_lm = true; ldp = t - 4 * 65536; ld_lm = true; recip = true; }
#pragma unroll
        for (int ai = 0; ai < 2; ++ai) {
            u32x4 old8[4][2];
            if (ldp) {
#pragma unroll
                for (int m = 0; m < 4; ++m)
#pragma unroll
                    for (int bj = 0; bj < 2; ++bj) old8[m][bj] = ld_lm ? *(const u32x4*)(ldp + ((ai * 4 + m) * 2 + bj) * 512)
                                                                       : *(const u32x4*)(ldp + (size_t)(row0 + ai * 128 + m * 16) * ld + col0 + bj * 128);
            }
#pragma unroll
            for (int m = 0; m < 4; ++m)
#pragma unroll
                for (int bj = 0; bj < 2; ++bj) { const f32x4 a0 = acc[ai][bj][m][0], a1 = acc[ai][bj][m][1];
                    float f[8];
#pragma unroll
                    for (int q = 0; q < 4; ++q) { f[q] = act_silu ? siluf(a0[q]) : sigm(a0[q]); f[4 + q] = act_silu ? siluf(a1[q]) : sigm(a1[q]); }
                    if (ldp) { const u32x4 o = old8[m][bj];
                        if (recip) { f[0] *= __builtin_amdgcn_rcpf(bf_lo(o.x)); f[1] *= __builtin_amdgcn_rcpf(bf_hi(o.x)); f[2] *= __builtin_amdgcn_rcpf(bf_lo(o.y)); f[3] *= __builtin_amdgcn_rcpf(bf_hi(o.y));
                            f[4] *= __builtin_amdgcn_rcpf(bf_lo(o.z)); f[5] *= __builtin_amdgcn_rcpf(bf_hi(o.z)); f[6] *= __builtin_amdgcn_rcpf(bf_lo(o.w)); f[7] *= __builtin_amdgcn_rcpf(bf_hi(o.w)); }
                        else { f[0] *= bf_lo(o.x); f[1] *= bf_hi(o.x); f[2] *= bf_lo(o.y); f[3] *= bf_hi(o.y); f[4] *= bf_lo(o.z); f[5] *= bf_hi(o.z); f[6] *= bf_lo(o.w); f[7] *= bf_hi(o.w); } }
                    u32x4 w; w.x = cvt_pk_bf16(f[0], f[1]); w.y = cvt_pk_bf16(f[2], f[3]); w.z = cvt_pk_bf16(f[4], f[5]); w.w = cvt_pk_bf16(f[6], f[7]);
                    if (st_lm) { if (recip) __builtin_nontemporal_store(w, (u32x4*)(stp + ((ai * 4 + m) * 2 + bj) * 512)); else *(u32x4*)(stp + ((ai * 4 + m) * 2 + bj) * 512) = w; }
                    else *(u32x4*)(stp + (size_t)(row0 + ai * 128 + m * 16) * ld + col0 + bj * 128) = w; } }
    }
};
struct EpiPool {
    static constexpr bool AFTER_DRAIN = false;
    static constexpr bool DRAIN = false;
    unsigned char* ws; const float* pool_scale;
    __device__ __forceinline__ void operator()(const f32x4 (&acc)[2][2][4][2], const Unit& u, int wr, int wc, int fr, int fq) const {
        bf16_t* base = (bf16_t*)(ws + OFF_PM) + u.pn * 256;
        const int row0 = u.pm * 256 + wr * 64 + fr, col0 = wc * 32 + 8 * fq;
        f32x4 s[2][2];
#pragma unroll
        for (int bj = 0; bj < 2; ++bj)
#pragma unroll
            for (int n = 0; n < 2; ++n) s[bj][n] = *(const f32x4*)(pool_scale + u.pn * 256 + col0 + bj * 128 + 4 * n);
#pragma unroll
        for (int ai = 0; ai < 2; ++ai)
#pragma unroll
            for (int m = 0; m < 4; ++m) { bf16_t* rowp = base + (size_t)(row0 + ai * 128 + m * 16) * 512 + col0;
#pragma unroll
                for (int bj = 0; bj < 2; ++bj) { const f32x4 v0 = acc[ai][bj][m][0] * s[bj][0], v1 = acc[ai][bj][m][1] * s[bj][1];
                    u32x4 w; w.x = cvt_pk_bf16(v0[0], v0[1]); w.y = cvt_pk_bf16(v0[2], v0[3]); w.z = cvt_pk_bf16(v1[0], v1[1]); w.w = cvt_pk_bf16(v1[2], v1[3]);
                    *(u32x4*)(rowp + bj * 128) = w; } }
    }
};
struct EpiMergeMid {
    static constexpr bool AFTER_DRAIN = false;
    static constexpr bool DRAIN = false;
    unsigned char* ws;
    __device__ __forceinline__ void operator()(f32x4 (&acc)[2][2][4][2], const Unit& u, int wr, int wc, int fr, int fq) const {
        const bf16_t* gr = (const bf16_t*)(ws + OFF_GB) + (size_t)(u.pm * 8 + 4 + u.pn) * 65536 + ((wr * 4 + wc) * 16 * 64 + (fq * 16 + fr)) * 8;
        const int row0 = u.pm * 256 + wr * 64 + fr, col0 = wc * 32 + 8 * fq;
#pragma unroll
        for (int ai = 0; ai < 2; ++ai) {
            u32x4 g8[4][2];
#pragma unroll
            for (int m = 0; m < 4; ++m)
#pragma unroll
                for (int bj = 0; bj < 2; ++bj) g8[m][bj] = __builtin_nontemporal_load((const u32x4*)(gr + ((ai * 4 + m) * 2 + bj) * 512));
#pragma unroll
            for (int m = 0; m < 4; ++m)
#pragma unroll
                for (int bj = 0; bj < 2; ++bj) { const u32x4 g = g8[m][bj];
                    acc[ai][bj][m][0] *= (f32x4){bf_lo(g.x), bf_hi(g.x), bf_lo(g.y), bf_hi(g.y)}; acc[ai][bj][m][1] *= (f32x4){bf_lo(g.z), bf_hi(g.z), bf_lo(g.w), bf_hi(g.w)}; } }
    }
};
struct EpiMergeFin {
    static constexpr bool AFTER_DRAIN = false;
    static constexpr bool DRAIN = false;
    unsigned char* ws;
    __device__ __forceinline__ void operator()(f32x4 (&acc)[2][2][4][2], const Unit& u, int wr, int wc, int fr, int fq) const {
        asm volatile("" : "+v"(fr), "+v"(fq));
        const bf16_t* gb = (const bf16_t*)(ws + OFF_GB) + (size_t)(u.pm * 8 + u.pn) * 65536 + ((wr * 4 + wc) * 16 * 64 + (fq * 16 + fr)) * 8;
        bf16_t* mg = (bf16_t*)(ws + OFF_MG) + u.pn * 256;
        const int row0 = u.pm * 256 + wr * 64 + fr, col0 = wc * 32 + 8 * fq;
#pragma unroll
        for (int ai = 0; ai < 2; ++ai) {
            u32x4 g8[4][2];
#pragma unroll
            for (int m = 0; m < 4; ++m)
#pragma unroll
                for (int bj = 0; bj < 2; ++bj) g8[m][bj] = *(const u32x4*)(gb + ((ai * 4 + m) * 2 + bj) * 512);
#pragma unroll
            for (int m = 0; m < 4; ++m) { const size_t row = (size_t)(row0 + ai * 128 + m * 16);
#pragma unroll
                for (int bj = 0; bj < 2; ++bj) { const u32x4 g = g8[m][bj]; const f32x4 a0 = acc[ai][bj][m][0], a1 = acc[ai][bj][m][1];
                    u32x4 w; w.x = cvt_pk_bf16(a0[0] * bf_lo(g.x), a0[1] * bf_hi(g.x)); w.y = cvt_pk_bf16(a0[2] * bf_lo(g.y), a0[3] * bf_hi(g.y));
                    w.z = cvt_pk_bf16(a1[0] * bf_lo(g.z), a1[1] * bf_hi(g.z)); w.w = cvt_pk_bf16(a1[2] * bf_lo(g.w), a1[3] * bf_hi(g.w));
                    *(u32x4*)(mg + row * 1024 + col0 + bj * 128) = w; } } }
    }
};
struct EpiOut {
    static constexpr bool DRAIN = false;
    static constexpr bool AFTER_DRAIN = true;
    unsigned char* ws; const float* x; float* out; const float* fnw;
    __device__ __forceinline__ void operator()(f32x4 (&acc)[2][2][4][2], const Unit& u, int wr, int wc, int fr, int fq) const {}
    __device__ __forceinline__ void fused(f32x4 (&acc)[2][2][4][2], const Unit& u, int wr, int wc, int fr, int fq, LAS unsigned char* lds) const {
        const int b = u.pm >> 3;
        const float* gv = (const float*)(ws + OFF_GATEV) + b * 1024 + u.pn * 256;
        float* ssq = (float*)(ws + OFF_SSQ);
        unsigned* cnt = (unsigned*)(ws + OFF_PCNT) + 64 * u.pm;
        const int row0 = u.pm * 256 + wr * 64 + fr, col0 = wc * 32 + 8 * fq;
        f32x4 gg[2][2];
#pragma unroll
        for (int bj = 0; bj < 2; ++bj)
#pragma unroll
            for (int n = 0; n < 2; ++n) gg[bj][n] = *(const f32x4*)(gv + col0 + bj * 128 + 4 * n);
        f32x4 xb[2][2][2][2];
#define EO_LOAD(k) do { _Pragma("unroll") for (int m2 = 0; m2 < 2; ++m2) _Pragma("unroll") for (int bj = 0; bj < 2; ++bj) _Pragma("unroll") for (int n = 0; n < 2; ++n) \
            xb[(k) & 1][m2][bj][n] = *(const f32x4*)(x + (size_t)(row0 + ((k) >> 1) * 128 + (((k) & 1) * 2 + m2) * 16) * 1024 + u.pn * 256 + col0 + bj * 128 + 4 * n); } while (0)
        EO_LOAD(0);
#pragma unroll
        for (int k = 0; k < 4; ++k) { const int ai = k >> 1;
            if (k + 1 < 4) EO_LOAD(k + 1);
#pragma unroll
            for (int m2 = 0; m2 < 2; ++m2) { const int m = (k & 1) * 2 + m2; const size_t row = (size_t)(row0 + ai * 128 + m * 16); float s = 0.f;
#pragma unroll
                for (int bj = 0; bj < 2; ++bj)
#pragma unroll
                    for (int n = 0; n < 2; ++n) { const f32x4 o = xb[k & 1][m2][bj][n] + gg[bj][n] * acc[ai][bj][m][n];
                        acc[ai][bj][m][n] = o; s += (o[0] * o[0] + o[1] * o[1]) + (o[2] * o[2] + o[3] * o[3]); }
                s += __shfl_xor(s, 16); s += __shfl_xor(s, 32);
                if (fq == 0) __hip_atomic_store(ssq + row * 16 + u.pn * 4 + wc, s, __ATOMIC_RELAXED, __HIP_MEMORY_SCOPE_AGENT); } }
#undef EO_LOAD
        asm volatile("s_waitcnt vmcnt(0)" ::: "memory");
        const int lane = fr + 16 * fq, wid = wr * 4 + wc;
        if (lane == 0) __hip_atomic_fetch_add(cnt, 1u, __ATOMIC_RELAXED, __HIP_MEMORY_SCOPE_AGENT);
        if (wid == 0) {
            unsigned spins = 0;
            while ((unsigned)__builtin_amdgcn_readfirstlane(__hip_atomic_load(cnt, __ATOMIC_RELAXED, __HIP_MEMORY_SCOPE_AGENT)) < 32u) { __builtin_amdgcn_s_sleep(2); if (++spins > (1u << 20)) break; }
            __builtin_amdgcn_fence(__ATOMIC_ACQUIRE, "agent");
            asm volatile("s_waitcnt vmcnt(0)" ::: "memory");
        }
        __syncthreads();
        LAS float* rs = (LAS float*)lds;
        { const int t = wid * 64 + lane;
          if (t < 256) { const float* sp = ssq + (size_t)(u.pm * 256 + t) * 16;
            float tot = 0.f;
#pragma unroll
            for (int q = 0; q < 16; ++q) tot += __hip_atomic_load(sp + q, __ATOMIC_RELAXED, __HIP_MEMORY_SCOPE_AGENT);
            rs[t] = rsqrtf(tot * (1.0f / 1024.0f) + 1e-6f); } }
        __syncthreads();
        f32x4 fw[2][2];
#pragma unroll
        for (int bj = 0; bj < 2; ++bj)
#pragma unroll
            for (int n = 0; n < 2; ++n) fw[bj][n] = *(const f32x4*)(fnw + u.pn * 256 + col0 + bj * 128 + 4 * n);
#pragma unroll
        for (int ai = 0; ai < 2; ++ai)
#pragma unroll
            for (int m = 0; m < 4; ++m) { const int rl = wr * 64 + fr + ai * 128 + m * 16; const float r = rs[rl]; float* op = out + (size_t)(u.pm * 256 + rl) * 1024 + u.pn * 256 + col0;
#pragma unroll
                for (int bj = 0; bj < 2; ++bj)
#pragma unroll
                    for (int n = 0; n < 2; ++n) *(f32x4*)(op + bj * 128 + 4 * n) = acc[ai][bj][m][n] * r * fw[bj][n]; }
    }
};

__device__ __forceinline__ void transpose_tile(const float* src, int ld_src, int k0, int c0, bf16_t* dst, int ld_dst, int n0, LAS float* T) {
    const int tid = opaque_tid();
#pragma unroll
    for (int i = 0; i < 2; ++i) { const int r = (tid >> 4) + i * 32, c4 = (tid & 15) * 4;
        const f32x4 v = *(const f32x4*)(src + (size_t)(k0 + r) * ld_src + c0 + c4);
        T[r * 65 + c4] = v[0]; T[r * 65 + c4 + 1] = v[1]; T[r * 65 + c4 + 2] = v[2]; T[r * 65 + c4 + 3] = v[3]; }
    __syncthreads();
    { const int n = tid >> 3, kc = (tid & 7) * 8; float f[8];
#pragma unroll
        for (int j = 0; j < 8; ++j) f[j] = T[(kc + j) * 65 + n];
        u32x4 w; w.x = cvt_pk_bf16(f[0], f[1]); w.y = cvt_pk_bf16(f[2], f[3]); w.z = cvt_pk_bf16(f[4], f[5]); w.w = cvt_pk_bf16(f[6], f[7]);
        *(u32x4*)(dst + (size_t)(n0 + n) * ld_dst + k0 + kc) = w; }
    __syncthreads();
}
__device__ __forceinline__ float wave_sum(float v) {
    v += __shfl_xor(v, 32); v += __shfl_xor(v, 16); v += __shfl_xor(v, 8); v += __shfl_xor(v, 4); v += __shfl_xor(v, 2); v += __shfl_xor(v, 1); return v;
}
__device__ __forceinline__ float log_sigmoid(float x) { return fminf(x, 0.f) - log1pf(expf(-fabsf(x))); }

__device__ void phase0(const Params& p, LAS unsigned char* lds) {
    const int tid = opaque_tid();
    LAS float* T = (LAS float*)lds;
    bf16_t* WinT = (bf16_t*)(p.ws + OFF_AB) + (size_t)18432 * 1024;
    float* modp = (float*)(p.ws + OFF_MODP);
    for (int job = blockIdx.x; job < 256; job += gridDim.x) {
        const int cgp = job & 31, ks = job >> 5;
        LAS float* sl = (LAS float*)lds;
        LAS float* red = sl + 9 * 128;
        for (int i = tid; i < 9 * 128; i += 512) { const int v = i >> 7, kk = i & 127; const float cv = v < 8 ? p.c[v * 1024 + ks * 128 + kk] : p.c_ctx[ks * 128 + kk]; sl[i] = cv / (1.0f + expf(-cv)); }
        __syncthreads();
        const int col = tid % 96, kr = tid / 96;
        float a0 = 0.f, a1 = 0.f, a2 = 0.f, a3 = 0.f, a4 = 0.f, a5 = 0.f, a6 = 0.f, a7 = 0.f, a8 = 0.f;
        if (kr < 5) {
#pragma unroll 1
            for (int k0 = kr; k0 < 128; k0 += 65) { float wv13[13];
#pragma unroll
                for (int q = 0; q < 13; ++q) { const int kk = k0 + 5 * q; wv13[q] = kk < 128 ? p.ada_w[(size_t)(ks * 128 + kk) * 3072 + cgp * 96 + col] : 0.f; }
#pragma unroll
                for (int q = 0; q < 13; ++q) { const int kk = min(k0 + 5 * q, 127); const float wv = wv13[q];
                    a0 += sl[kk] * wv; a1 += sl[128 + kk] * wv; a2 += sl[256 + kk] * wv; a3 += sl[384 + kk] * wv; a4 += sl[512 + kk] * wv; a5 += sl[640 + kk] * wv; a6 += sl[768 + kk] * wv; a7 += sl[896 + kk] * wv; a8 += sl[1024 + kk] * wv; } }
            LAS float* rp = red + (kr * 9) * 96 + col;
            rp[0] = a0; rp[96] = a1; rp[192] = a2; rp[288] = a3; rp[384] = a4; rp[480] = a5; rp[576] = a6; rp[672] = a7; rp[768] = a8;
        }
        __syncthreads();
        for (int i = tid; i < 9 * 96; i += 512) { const int v = i / 96, cc = i % 96; float s = 0.f;
#pragma unroll
            for (int r = 0; r < 5; ++r) s += red[(r * 9 + v) * 96 + cc];
            __hip_atomic_store(&modp[(size_t)(ks * 9 + v) * 3072 + cgp * 96 + cc], s, __ATOMIC_RELAXED, __HIP_MEMORY_SCOPE_AGENT); }
        __syncthreads();
    }
    asm volatile("s_waitcnt vmcnt(0)" ::: "memory");
    __syncthreads();
    if (tid == 0) (void)__hip_atomic_fetch_add((unsigned*)(p.ws + OFF_ACNT), 1u, __ATOMIC_RELAXED, __HIP_MEMORY_SCOPE_AGENT);
    {
        const int r0 = tid >> 4, c4 = (tid & 15) * 4;
        int job = blockIdx.x;
        f32x4 va, vb;
        { const int kt = job & 15, ntile = job >> 4; const int n0 = ntile * 64, k0 = kt * 64; const int c0 = n0 < 5120 ? n0 : n0 + 16;
          va = *(const f32x4*)(p.in_w + (size_t)(k0 + r0) * 8208 + c0 + c4); vb = *(const f32x4*)(p.in_w + (size_t)(k0 + r0 + 32) * 8208 + c0 + c4); }
        for (; job < 2048; job += gridDim.x) {
            const int kt = job & 15, ntile = job >> 4; const int n0 = ntile * 64, k0 = kt * 64;
            T[r0 * 65 + c4] = va[0]; T[r0 * 65 + c4 + 1] = va[1]; T[r0 * 65 + c4 + 2] = va[2]; T[r0 * 65 + c4 + 3] = va[3];
            T[(r0 + 32) * 65 + c4] = vb[0]; T[(r0 + 32) * 65 + c4 + 1] = vb[1]; T[(r0 + 32) * 65 + c4 + 2] = vb[2]; T[(r0 + 32) * 65 + c4 + 3] = vb[3];
            __syncthreads();
            const int nj = job + gridDim.x;
            if (nj < 2048) { const int kt2 = nj & 15, nt2 = nj >> 4; const int n2 = nt2 * 64, k2 = kt2 * 64; const int c2 = n2 < 5120 ? n2 : n2 + 16;
                va = *(const f32x4*)(p.in_w + (size_t)(k2 + r0) * 8208 + c2 + c4); vb = *(const f32x4*)(p.in_w + (size_t)(k2 + r0 + 32) * 8208 + c2 + c4); }
            { const int n = tid >> 3, kc = (tid & 7) * 8; float f[8];
#pragma unroll
              for (int j = 0; j < 8; ++j) f[j] = T[(kc + j) * 65 + n];
              u32x4 w; w.x = cvt_pk_bf16(f[0], f[1]); w.y = cvt_pk_bf16(f[2], f[3]); w.z = cvt_pk_bf16(f[4], f[5]); w.w = cvt_pk_bf16(f[6], f[7]);
              *(u32x4*)(WinT + (size_t)(n0 + n) * 1024 + k0 + kc) = w; }
            __syncthreads();
        }
    }
}

__device__ __forceinline__ float dot4(const f32x4 a, const f32x4 b) { return (a[0] * b[0] + a[1] * b[1]) + (a[2] * b[2] + a[3] * b[3]); }
__device__ __forceinline__ float bfly16(const f32x4 p0, const f32x4 p1, const f32x4 p2, const f32x4 p3, int lane) {
    const bool b3 = lane & 8, b2 = lane & 4, b1 = lane & 2, b0 = lane & 1;
    const f32x4 s0 = b3 ? p0 : p2, s1 = b3 ? p1 : p3, k0 = b3 ? p2 : p0, k1 = b3 ? p3 : p1;
    f32x4 a, c;
    a[0] = k0[0] + __shfl_xor(s0[0], 8); a[1] = k0[1] + __shfl_xor(s0[1], 8); a[2] = k0[2] + __shfl_xor(s0[2], 8); a[3] = k0[3] + __shfl_xor(s0[3], 8);
    c[0] = k1[0] + __shfl_xor(s1[0], 8); c[1] = k1[1] + __shfl_xor(s1[1], 8); c[2] = k1[2] + __shfl_xor(s1[2], 8); c[3] = k1[3] + __shfl_xor(s1[3], 8);
    const f32x4 s4 = b2 ? a : c, k4 = b2 ? c : a;
    const float d0 = k4[0] + __shfl_xor(s4[0], 4), d1 = k4[1] + __shfl_xor(s4[1], 4), d2 = k4[2] + __shfl_xor(s4[2], 4), d3 = k4[3] + __shfl_xor(s4[3], 4);
    const float e0 = (b1 ? d2 : d0) + __shfl_xor(b1 ? d0 : d2, 2), e1 = (b1 ? d3 : d1) + __shfl_xor(b1 ? d1 : d3, 2);
    float q1 = (b0 ? e1 : e0) + __shfl_xor(b0 ? e0 : e1, 1);
    q1 += __shfl_xor(q1, 16); q1 += __shfl_xor(q1, 32);
    return q1;
}
__device__ __forceinline__ void norm_rows2(const f32x4 (&xa)[4], const f32x4 (&xb)[4], const LAS float* gsa, const LAS float* sha, const LAS float* gsb, const LAS float* shb, const LAS float* WgT,
                                           bf16_t* oa, bf16_t* ob, float* ga, float* gb, const float* gate_b, int lane) {
    float ssa = 0.f, ssb = 0.f;
#pragma unroll
    for (int i = 0; i < 4; ++i) { ssa += dot4(xa[i], xa[i]); ssb += dot4(xb[i], xb[i]); }
    ssa = wave_sum(ssa); ssb = wave_sum(ssb);
    const float ra = rsqrtf(ssa * (1.0f / 1024.0f) + 1e-6f), rb = rsqrtf(ssb * (1.0f / 1024.0f) + 1e-6f);
    f32x4 ya[4], yb[4];
#pragma unroll
    for (int i = 0; i < 4; ++i) {
        ya[i] = xa[i] * ra * *(const LAS f32x4*)(gsa + i * 256 + lane * 4) + *(const LAS f32x4*)(sha + i * 256 + lane * 4);
        yb[i] = xb[i] * rb * *(const LAS f32x4*)(gsb + i * 256 + lane * 4) + *(const LAS f32x4*)(shb + i * 256 + lane * 4);
        u32x2 w; w.x = cvt_pk_bf16(ya[i][0], ya[i][1]); w.y = cvt_pk_bf16(ya[i][2], ya[i][3]); *(u32x2*)(oa + i * 256 + lane * 4) = w;
        u32x2 v; v.x = cvt_pk_bf16(yb[i][0], yb[i][1]); v.y = cvt_pk_bf16(yb[i][2], yb[i][3]); *(u32x2*)(ob + i * 256 + lane * 4) = v; }
    f32x4 pa[4], pb[4];
#pragma unroll
    for (int jq = 0; jq < 4; ++jq) { f32x4 sa = (f32x4){0.f, 0.f, 0.f, 0.f}, sb = sa;
#pragma unroll
        for (int i = 0; i < 4; ++i) { const LAS float* wp = WgT + (jq * 4) * 1024 + i * 256 + lane * 4;
            const f32x4 w0 = *(const LAS f32x4*)wp, w1 = *(const LAS f32x4*)(wp + 1024), w2 = *(const LAS f32x4*)(wp + 2048), w3 = *(const LAS f32x4*)(wp + 3072);
            sa += (f32x4){dot4(ya[i], w0), dot4(ya[i], w1), dot4(ya[i], w2), dot4(ya[i], w3)};
            sb += (f32x4){dot4(yb[i], w0), dot4(yb[i], w1), dot4(yb[i], w2), dot4(yb[i], w3)}; }
        pa[jq] = sa; pb[jq] = sb; }
    const float qa = bfly16(pa[0], pa[1], pa[2], pa[3], lane), qb = bfly16(pb[0], pb[1], pb[2], pb[3], lane);
    if (lane < 16) { const float gbv = gate_b[lane]; const bool ls = (lane >> 2) & 1;
        const float prea = qa + gbv, preb = qb + gbv;
        ga[0] = ls ? log_sigmoid(prea) : prea; gb[0] = ls ? log_sigmoid(preb) : preb; }
}
__device__ void phase1(const Params& p, LAS unsigned char* lds) {
    const int tid = opaque_tid(), wid = tid >> 6, lane = tid & 63;
    LAS float* gs = (LAS float*)lds; LAS float* sh = gs + 1024; LAS float* gsc = sh + 1024; LAS float* shc = gsc + 1024; LAS float* WgT = shc + 1024;
    const float* modp = (const float*)(p.ws + OFF_MODP);
    bf16_t* AB = (bf16_t*)(p.ws + OFF_AB);
    if (tid < 64) {
        unsigned spins = 0;
        while ((unsigned)__builtin_amdgcn_readfirstlane(__hip_atomic_load((unsigned*)(p.ws + OFF_ACNT), __ATOMIC_RELAXED, __HIP_MEMORY_SCOPE_AGENT)) < gridDim.x) { __builtin_amdgcn_s_sleep(2); if (++spins > (1u << 22)) break; }
        __builtin_amdgcn_fence(__ATOMIC_ACQUIRE, "agent"); asm volatile("s_waitcnt vmcnt(0)" ::: "memory"); }
    __syncthreads();
    for (int job = blockIdx.x; job < 256; job += gridDim.x) {
        const int b = job >> 5;
        for (int i = tid; i < 1024; i += 512) {
            float s0 = p.ada_b[i], s1 = p.ada_b[1024 + i], s2 = p.ada_b[2048 + i], c0 = s0, c1 = s1;
#pragma unroll
            for (int ks = 0; ks < 8; ++ks) { const float* mp = modp + (size_t)(ks * 9 + b) * 3072; s0 += mp[i]; s1 += mp[1024 + i]; s2 += mp[2048 + i];
                const float* mc = modp + (size_t)(ks * 9 + 8) * 3072; c0 += mc[i]; c1 += mc[1024 + i]; }
            const float nw = p.norm_w[i];
            gs[i] = nw * (1.0f + s1); sh[i] = s0; gsc[i] = nw * (1.0f + c1); shc[i] = c0;
            if ((job & 31) == 0) ((float*)(p.ws + OFF_GATEV))[b * 1024 + i] = s2;
        }
        for (int i = tid; i < 16384; i += 512) { const int j = i & 15, k = i >> 4; WgT[j * 1024 + k] = p.in_w[(size_t)k * 8208 + 5120 + j]; }
        __syncthreads();
        const int crow = job * 8 + wid; const int cb = crow >> 8;
        float* gl = (float*)(p.ws + OFF_GL) + (size_t)b * 16 * 2048 + (size_t)lane * 2048; float* gc = (float*)(p.ws + OFF_GC) + (size_t)cb * 16 * 256 + (size_t)lane * 256 + (crow & 255);
        const int rbase = job * 64 + wid * 8;
#pragma unroll 1
        for (int pr = 0; pr < 5; ++pr) {
            const int ra_ = pr < 4 ? rbase + 2 * pr : rbase + 7;
            const float* xa_ = p.x + (size_t)ra_ * 1024; const float* xb_ = pr < 4 ? xa_ + 1024 : p.ctx + (size_t)crow * 1024;
            f32x4 xa[4], xb[4];
#pragma unroll
            for (int i = 0; i < 4; ++i) { xa[i] = *(const f32x4*)(xa_ + i * 256 + lane * 4); xb[i] = *(const f32x4*)(xb_ + i * 256 + lane * 4); }
            const LAS float* gsb_ = pr < 4 ? gs : gsc; const LAS float* shb_ = pr < 4 ? sh : shc;
            bf16_t* ob_ = pr < 4 ? AB + (size_t)(ra_ + 1) * 1024 : AB + (size_t)(16384 + crow) * 1024;
            float* gb_ = pr < 4 ? gl + ((ra_ + 1) & 2047) : gc;
            norm_rows2(xa, xb, gs, sh, gsb_, shb_, WgT, AB + (size_t)ra_ * 1024, ob_, gl + (ra_ & 2047), gb_, p.gate_b, lane);
        }
        __syncthreads();
    }
}

__device__ __forceinline__ bf16_t* cst_ptr(const Params& p, int sid, int chunk) {
    bf16_t* base = sid < 32 ? (bf16_t*)p.out : (bf16_t*)(p.ws + OFF_CST2);
    return base + ((size_t)((sid & 31) * 16 + chunk)) * 65536;
}
__device__ __forceinline__ void passA_chunk(const Params& p, int st, int b, int h, int dir, int vs, bool& isctx, int& ci, const bf16_t*& Kbase, const bf16_t*& Vbase) {
    isctx = st < 2;
    if (isctx) { ci = dir ? 1 - st : st;
        Kbase = (const bf16_t*)(p.ws + OFF_KC) + (size_t)((b * 2 + ci) * 4 + h) * 32768;
        Vbase = (const bf16_t*)(p.ws + OFF_VTC) + (size_t)(b * 2 + ci) * 131072 + (h * 16 + vs * 4) * 2048; }
    else { const int s2 = st - 2; ci = dir ? 15 - s2 : s2;
        Kbase = (const bf16_t*)(p.ws + OFF_K) + (size_t)((b * 16 + ci) * 4 + h) * 32768;
        Vbase = (const bf16_t*)(p.ws + OFF_VT) + (size_t)(b * 16 + ci) * 131072 + (h * 16 + vs * 4) * 2048; }
}
__device__ void passA(const Params& p, LAS unsigned char* lds, int wg) {
    const int tid = opaque_tid(), wid = tid >> 6, lane = tid & 63, fr = lane & 15, fq = lane >> 4;
    const int sid = wg >> 2, vs = wg & 3; const int b = sid >> 3, h = (sid >> 1) & 3, dir = sid & 1;
    LAS bf16_t* Kt = (LAS bf16_t*)lds;
    LAS bf16_t* Ve = Kt + 256 * 136;
    LAS float* eA = (LAS float*)(lds + 87040);
    LAS float* bendA = eA + 18 * 128; LAS float* maxwA = bendA + 32; LAS float* decayA = maxwA + 32; LAS float* mprevA = decayA + 32; LAS float* mnewA = mprevA + 32;
    LAS bf16_t* eB = (LAS bf16_t*)(mnewA + 32);
    const float* GL = (const float*)(p.ws + OFF_GL); const float* GC = (const float*)(p.ws + OFF_GC);
    for (int st = wid; st < 18; st += 8) {
        const bool isctx = st < 2; const int ci = isctx ? (dir ? 1 - st : st) : (dir ? 15 - (st - 2) : st - 2);
        const int T = isctx ? 256 : 2048; const float* G = isctx ? GC + (size_t)b * 16 * 256 : GL + (size_t)b * 16 * 2048;
        const float* pli = G + (size_t)(dir * 8 + h) * T + ci * 128; const float* plf = G + (size_t)(dir * 8 + 4 + h) * T + ci * 128;
        const int s0 = dir ? 127 - 2 * lane : 2 * lane, s1 = dir ? 126 - 2 * lane : 2 * lane + 1;
        const float lf0 = plf[s0], lf1 = plf[s1], li0 = pli[s0], li1 = pli[s1];
        const float p1 = lf0 + lf1; float inc = p1;
#pragma unroll
        for (int off = 1; off < 64; off <<= 1) { const float n = __shfl_up(inc, off); inc += (lane >= off) ? n : 0.f; }
        const float bend = __shfl(inc, 63);
        const float b0 = inc - p1 + lf0, b1 = inc;
        const float w0 = bend - b0 + li0, w1 = bend - b1 + li1;
        float mx = fmaxf(w0, w1);
#pragma unroll
        for (int off = 32; off > 0; off >>= 1) mx = fmaxf(mx, __shfl_xor(mx, off));
        eA[st * 128 + s0] = w0; eA[st * 128 + s1] = w1;
        if (lane == 0) { bendA[st] = bend; maxwA[st] = mx; }
    }
    __syncthreads();
    if (tid == 0) { float m = -1e30f;
        for (int st = 0; st < 18; ++st) { mprevA[st] = m; const float mn = fmaxf(bendA[st] + m, maxwA[st]); decayA[st] = expf(bendA[st] + m - mn); mnewA[st] = mn; m = mn; } }
    __syncthreads();
    for (int i = tid; i < 18 * 128; i += 512) { const float e = expf(eA[i] - mnewA[i >> 7]); eA[i] = e; eB[i] = (bf16_t)(cvt_pk_bf16(e, 0.f) & 0xffffu); }
    __syncthreads();
    f32x4 nacc[2] = {(f32x4){0.f, 0.f, 0.f, 0.f}, (f32x4){0.f, 0.f, 0.f, 0.f}};
    f32x4 acc[2][4];
#pragma unroll
    for (int a = 0; a < 2; ++a)
#pragma unroll
        for (int v = 0; v < 4; ++v) acc[a][v] = (f32x4){0.f, 0.f, 0.f, 0.f};
    u32x4 vr[2], kr[2][4];
    { bool ic; int ci; const bf16_t* Kb; const bf16_t* Vb; passA_chunk(p, 0, b, h, dir, vs, ic, ci, Kb, Vb);
#pragma unroll
        for (int rep = 0; rep < 2; ++rep) { const int it = tid + rep * 512;
            vr[rep] = *(const u32x4*)(Vb + (size_t)it * 8);
            const int sq = (it & 15) | (((it >> 6) & 1) << 4), ko = ((it >> 4) & 3) | ((it >> 7) << 2); const bf16_t* src = Kb + (size_t)((sq >> 2) * 8 + (ko >> 2)) * 512 + ((sq & 3) * 16 + (ko & 3)) * 8;
            kr[rep][0] = *(const u32x4*)src; kr[rep][1] = *(const u32x4*)(src + 32); kr[rep][2] = *(const u32x4*)(src + 64); kr[rep][3] = *(const u32x4*)(src + 96); } }
    for (int st = 0; st < 18; ++st) {
        bool isctx; int ci; const bf16_t* Kb; const bf16_t* Vb; passA_chunk(p, st, b, h, dir, vs, isctx, ci, Kb, Vb);
        if (!isctx) {
            bf16_t* cs = cst_ptr(p, sid, ci);
#pragma unroll
            for (int vt = 0; vt < 4; ++vt) { u32x4 w; w.x = cvt_pk_bf16(acc[0][vt][0], acc[0][vt][1]); w.y = cvt_pk_bf16(acc[0][vt][2], acc[0][vt][3]);
                w.z = cvt_pk_bf16(acc[1][vt][0], acc[1][vt][1]); w.w = cvt_pk_bf16(acc[1][vt][2], acc[1][vt][3]);
                __builtin_nontemporal_store(w, (u32x4*)(cs + (size_t)((vs * 4 + vt) * 8 + wid) * 512 + (fr * 4 + fq) * 8)); }
            if (vs == 0) { if (fr == 0) { float* np = (float*)(p.ws + OFF_NST) + (size_t)(sid * 16 + ci) * 256 + wid * 32 + fq * 8; *(f32x4*)np = nacc[0]; *(f32x4*)(np + 4) = nacc[1]; }
                if (tid == 0) ((float*)(p.ws + OFF_MST))[sid * 16 + ci] = mprevA[st]; }
        }
        if (st == 17) break;
        const LAS float* e_s = eA + st * 128; const float decay = decayA[st];
#pragma unroll
        for (int rep = 0; rep < 2; ++rep) { const int it = tid + rep * 512; const int v = (it >> 8) * 16 + ((it >> 2) & 15), sg = ((it >> 6) & 3) * 32 + (it & 3) * 8;
            const u32x4 raw = vr[rep];
            u32x4 w; w.x = cvt_pk_bf16(bf_lo(raw.x) * e_s[sg], bf_hi(raw.x) * e_s[sg + 1]); w.y = cvt_pk_bf16(bf_lo(raw.y) * e_s[sg + 2], bf_hi(raw.y) * e_s[sg + 3]);
            w.z = cvt_pk_bf16(bf_lo(raw.z) * e_s[sg + 4], bf_hi(raw.z) * e_s[sg + 5]); w.w = cvt_pk_bf16(bf_lo(raw.w) * e_s[sg + 6], bf_hi(raw.w) * e_s[sg + 7]);
            *(LAS u32x4*)(Ve + v * 136 + sg) = w; }
#pragma unroll
        for (int rep = 0; rep < 2; ++rep) { const int it = tid + rep * 512; const int sq = (it & 15) | (((it >> 6) & 1) << 4), ko = ((it >> 4) & 3) | ((it >> 7) << 2);
            const u32x4 r0 = kr[rep][0], r1 = kr[rep][1], r2 = kr[rep][2], r3 = kr[rep][3];
            LAS bf16_t* dst = Kt + (ko * 8) * 136 + sq * 4;
#define TRW(j, a0, a1, a2, a3, HI) { u32x2 w; if (HI) { w.x = (a0 >> 16) | (a1 & 0xffff0000u); w.y = (a2 >> 16) | (a3 & 0xffff0000u); } else { w.x = (a0 & 0xffffu) | (a1 << 16); w.y = (a2 & 0xffffu) | (a3 << 16); } *(LAS u32x2*)(dst + (j) * 136) = w; }
            TRW(0, r0.x, r1.x, r2.x, r3.x, 0) TRW(1, r0.x, r1.x, r2.x, r3.x, 1) TRW(2, r0.y, r1.y, r2.y, r3.y, 0) TRW(3, r0.y, r1.y, r2.y, r3.y, 1)
            TRW(4, r0.z, r1.z, r2.z, r3.z, 0) TRW(5, r0.z, r1.z, r2.z, r3.z, 1) TRW(6, r0.w, r1.w, r2.w, r3.w, 0) TRW(7, r0.w, r1.w, r2.w, r3.w, 1)
#undef TRW
        }
        __syncthreads();
        if (st + 1 < 17) {
            bool ic2; int ci2; const bf16_t* Kb2; const bf16_t* Vb2; passA_chunk(p, st + 1, b, h, dir, vs, ic2, ci2, Kb2, Vb2);
#pragma unroll
            for (int rep = 0; rep < 2; ++rep) { const int it = tid + rep * 512;
                vr[rep] = *(const u32x4*)(Vb2 + (size_t)it * 8);
                const int sq = (it & 15) | (((it >> 6) & 1) << 4), ko = ((it >> 4) & 3) | ((it >> 7) << 2); const bf16_t* src = Kb2 + (size_t)((sq >> 2) * 8 + (ko >> 2)) * 512 + ((sq & 3) * 16 + (ko & 3)) * 8;
                kr[rep][0] = *(const u32x4*)src; kr[rep][1] = *(const u32x4*)(src + 32); kr[rep][2] = *(const u32x4*)(src + 64); kr[rep][3] = *(const u32x4*)(src + 96); } }
#pragma unroll
        for (int a = 0; a < 2; ++a) { nacc[a] *= decay;
#pragma unroll
            for (int v = 0; v < 4; ++v) acc[a][v] *= decay; }
#pragma unroll
        for (int ks = 0; ks < 4; ++ks) { bf16x8 kf[2], vf[4];
#pragma unroll
            for (int kt = 0; kt < 2; ++kt) kf[kt] = *(const LAS bf16x8*)(Kt + (wid * 32 + 8 * (fr >> 2) + 4 * kt + (fr & 3)) * 136 + ks * 32 + fq * 8);
#pragma unroll
            for (int vt = 0; vt < 4; ++vt) vf[vt] = *(const LAS bf16x8*)(Ve + (vt * 16 + fr) * 136 + ks * 32 + fq * 8);
            bf16x8 ef = *(const LAS bf16x8*)(eB + st * 128 + ks * 32 + fq * 8);
            if (fr != 0) ef = (bf16x8){0, 0, 0, 0, 0, 0, 0, 0};
#pragma unroll
            for (int kt = 0; kt < 2; ++kt) {
#pragma unroll
                for (int vt = 0; vt < 4; ++vt) acc[kt][vt] = __builtin_amdgcn_mfma_f32_16x16x32_bf16(kf[kt], vf[vt], acc[kt][vt], 0, 0, 0);
                nacc[kt] = __builtin_amdgcn_mfma_f32_16x16x32_bf16(kf[kt], ef, nacc[kt], 0, 0, 0); } }
        __syncthreads();
    }
    __syncthreads();
}

__device__ void boxfilter_unit(const Params& p, LAS unsigned char* lds, int u) {
    const int tid = opaque_tid();
    const int b = u >> 6, g = (u >> 4) & 3, cb = u & 15; const int hw = 1 << g;
    LAS float* X = (LAS float*)lds; LAS float* Y = X + 2048 * 8;
    const bf16_t* src = (const bf16_t*)(p.ws + OFF_P) + (size_t)(b * 64 + g * 16 + cb) * 2048 * 8;
    bf16_t* dst = (bf16_t*)(p.ws + OFF_MX) + (size_t)(b * 2048) * 512 + g * 128 + cb * 8;
#pragma unroll
    for (int i = 0; i < 4; ++i) { const int tok = tid + 512 * i; const u32x4 v = *(const u32x4*)(src + (size_t)tok * 8);
        *(LAS f32x4*)(X + tok * 8) = (f32x4){bf_lo(v.x), bf_hi(v.x), bf_lo(v.y), bf_hi(v.y)}; *(LAS f32x4*)(X + tok * 8 + 4) = (f32x4){bf_lo(v.z), bf_hi(v.z), bf_lo(v.w), bf_hi(v.w)}; }
    __syncthreads();
    for (int i = 0; i < 4; ++i) { const int tok = tid + 512 * i; const int r = tok >> 6, c = tok & 63; const int lo = max(r - hw, 0), hi = min(r + hw, 32);
        f32x4 s0 = (f32x4){0.f, 0.f, 0.f, 0.f}, s1 = s0;
        for (int rr = lo; rr < hi; ++rr) { s0 += *(const LAS f32x4*)(X + (rr * 64 + c) * 8); s1 += *(const LAS f32x4*)(X + (rr * 64 + c) * 8 + 4); }
        const float cnt = (float)(hi - lo);
        *(LAS f32x4*)(Y + tok * 8) = s0 / cnt; *(LAS f32x4*)(Y + tok * 8 + 4) = s1 / cnt; }
    __syncthreads();
    for (int i = 0; i < 4; ++i) { const int tok = tid + 512 * i; const int r = tok >> 6, c = tok & 63; const int lo = max(c - hw, 0), hi = min(c + hw, 64);
        f32x4 s0 = (f32x4){0.f, 0.f, 0.f, 0.f}, s1 = s0;
        for (int cc = lo; cc < hi; ++cc) { s0 += *(const LAS f32x4*)(Y + (r * 64 + cc) * 8); s1 += *(const LAS f32x4*)(Y + (r * 64 + cc) * 8 + 4); }
        const float cnt = (float)(hi - lo);
        const f32x4 m0 = s0 / cnt - *(const LAS f32x4*)(X + tok * 8), m1 = s1 / cnt - *(const LAS f32x4*)(X + tok * 8 + 4);
        u32x4 w; w.x = cvt_pk_bf16(m0[0], m0[1]); w.y = cvt_pk_bf16(m0[2], m0[3]); w.z = cvt_pk_bf16(m1[0], m1[1]); w.w = cvt_pk_bf16(m1[2], m1[3]);
        *(u32x4*)(dst + (size_t)tok * 512) = w; }
    __syncthreads();
}

__device__ void passB_unit(const Params& p, LAS unsigned char* lds, int u, bool do_store = true) {
    const int tid = opaque_tid(), wid = tid >> 6, lane = tid & 63, fr = lane & 15, fq = lane >> 4;
    const int b = u >> 6, h = (u >> 4) & 3, c = u & 15;
    const int tokbase = b * 2048 + c * 128;
    LAS bf16_t* Qs = (LAS bf16_t*)lds;
    LAS bf16_t* Pd = Qs + 128 * 264;
    LAS float* fl = (LAS float*)(lds + 137216);
    LAS float* lfA = fl; LAS float* liA = fl + 256; LAS float* aA = fl + 512; LAS float* MA = fl + 768; LAS float* winA = fl + 1024; LAS float* clampA = fl + 1280;
    LAS float* nqA = fl + 1536; LAS float* nvec = fl + 1792; LAS float* rsP = fl + 2304; LAS float* ssP = fl + 3328;
    const float* GL = (const float*)(p.ws + OFF_GL) + (size_t)b * 16 * 2048 + c * 128;
    bf16_t* Qg = (bf16_t*)(p.ws + OFF_Q) + (size_t)((tokbase >> 8) * 4 + h) * 65536 + (c & 1) * 8 * 512;
    const int sid0 = (b * 4 + h) * 2;
    LAS float* wtot = lfA; LAS float* wmax = lfA + 8;
    float sc_b = 0.f, sc_li = 0.f; int sc_t = 0;
    if (tid < 256) { const int d = tid >> 7, i = tid & 127; sc_t = d ? 127 - i : i;
        sc_li = GL[(size_t)(d * 8 + h) * 2048 + sc_t]; float inc = GL[(size_t)(d * 8 + 4 + h) * 2048 + sc_t];
#pragma unroll
        for (int off = 1; off < 64; off <<= 1) { const float n = __shfl_up(inc, off); inc += (lane >= off) ? n : 0.f; }
        sc_b = inc; if (lane == 63) wtot[wid] = inc; }
    { const int d = tid >> 8, k = tid & 255; nvec[tid] = ((const float*)(p.ws + OFF_NST))[(size_t)((sid0 + d) * 16 + c) * 256 + k]; }
#pragma unroll
    for (int i = 0; i < 8; ++i) { const int id = tid + 512 * i; const int w = id >> 9, m = (id >> 7) & 3, bj = (id >> 6) & 1, ln = id & 63;
        *(LAS u32x4*)(Qs + ((w >> 2) * 64 + m * 16 + (ln & 15)) * 264 + bj * 128 + (w & 3) * 32 + (ln >> 4) * 8) = *(const u32x4*)(Qg + (size_t)((w * 16 + m * 2 + bj) * 64 + ln) * 8); }
    __syncthreads();
    float sc_a = 0.f, sc_pm = 0.f;
    if (tid < 256) { if (wid & 1) sc_b += wtot[wid - 1];
        sc_a = sc_li - sc_b; float pm = sc_a;
#pragma unroll
        for (int off = 1; off < 64; off <<= 1) { const float n = __shfl_up(pm, off); pm = (lane >= off) ? fmaxf(pm, n) : pm; }
        sc_pm = pm; if (lane == 63) wmax[wid] = pm; }
    __syncthreads();
    const int wt2 = wid >> 2, w4 = wid & 3;
    const bf16_t* Kg = (const bf16_t*)(p.ws + OFF_K) + (size_t)((b * 16 + c) * 4 + h) * 32768 + (size_t)(w4 * 2 * 8) * 512 + (fr * 4 + fq) * 8;
    bf16x8 kfa[8][2];
#pragma unroll
    for (int ks = 0; ks < 8; ++ks)
#pragma unroll
        for (int nt = 0; nt < 2; ++nt) kfa[ks][nt] = *(const bf16x8*)(Kg + (size_t)(nt * 8 + ks) * 512);
    if (tid < 256) { const int d = tid >> 7, t = sc_t; if (wid & 1) sc_pm = fmaxf(sc_pm, wmax[wid - 1]);
        const float mc = ((const float*)(p.ws + OFF_MST))[(sid0 + d) * 16 + c];
        const float Mt = fmaxf(mc, sc_pm); const int dt = d * 128 + t;
        aA[dt] = sc_a; MA[dt] = Mt; winA[dt] = expf(mc - Mt); clampA[dt] = expf(-(sc_b + Mt));
        float s = 0.f; const LAS float* nv = nvec + d * 256;
#pragma unroll 4
        for (int k8 = 0; k8 < 32; ++k8) { const u32x4 qv = *(const LAS u32x4*)(Qs + t * 264 + k8 * 8); const LAS float* np = nv + k8 * 8;
            s += bf_lo(qv.x) * np[0] + bf_hi(qv.x) * np[1] + bf_lo(qv.y) * np[2] + bf_hi(qv.y) * np[3] + bf_lo(qv.z) * np[4] + bf_hi(qv.z) * np[5] + bf_lo(qv.w) * np[6] + bf_hi(qv.w) * np[7]; }
        nqA[dt] = s; }
    __syncthreads();
    const bf16_t* Cd0 = cst_ptr(p, sid0, c) + (size_t)(w4 * 32) * 512 + (fr * 4 + fq) * 8;
    const bf16_t* Cd1 = cst_ptr(p, sid0 + 1, c) + (size_t)(w4 * 32) * 512 + (fr * 4 + fq) * 8;
    const bf16_t* Vd = (const bf16_t*)(p.ws + OFF_VT) + (size_t)(b * 16 + c) * 131072 + (h * 16 + w4 * 4) * 2048 + (fr * 4 + fq) * 8;
    bf16x8 F[3][4][2];
#define PB_ISSUE(q) do { const int _nh = (q) / 6, _d = ((q) % 6) / 3, _kind = (q) % 3; \
        _Pragma("unroll") for (int ks = 0; ks < 4; ++ks) _Pragma("unroll") for (int n2 = 0; n2 < 2; ++n2) \
            F[(q) % 3][ks][n2] = (_kind < 2) ? __builtin_nontemporal_load((const bf16x8*)((_d ? Cd1 : Cd0) + (size_t)((_nh * 2 + n2) * 8 + _kind * 4 + ks) * 512)) \
                                            : *(const bf16x8*)(Vd + (size_t)((_nh * 2 + n2) * 4 + ks) * 512); } while (0)
    {
        f32x4 sacc[4][2];
#pragma unroll
        for (int mt = 0; mt < 4; ++mt)
#pragma unroll
            for (int nt = 0; nt < 2; ++nt) sacc[mt][nt] = (f32x4){0.f, 0.f, 0.f, 0.f};
#pragma unroll
        for (int ks = 0; ks < 8; ++ks) { bf16x8 qf[4];
#pragma unroll
            for (int mt = 0; mt < 4; ++mt) qf[mt] = *(const LAS bf16x8*)(Qs + (wt2 * 64 + mt * 16 + fr) * 264 + ks * 32 + fq * 8);
#pragma unroll
            for (int mt = 0; mt < 4; ++mt)
#pragma unroll
                for (int nt = 0; nt < 2; ++nt) sacc[mt][nt] = __builtin_amdgcn_mfma_f32_16x16x32_bf16(kfa[ks][nt], qf[mt], sacc[mt][nt], 0, 0, 0); }
        PB_ISSUE(0); PB_ISSUE(1);
        __builtin_amdgcn_sched_barrier(0);
#pragma unroll
        for (int mt = 0; mt < 4; ++mt) { const int t = wt2 * 64 + mt * 16 + fr; const float Mf = MA[t], Mb = MA[128 + t]; float rf = 0.f, rb = 0.f;
#pragma unroll
            for (int nt = 0; nt < 2; ++nt) { const int s0 = w4 * 32 + nt * 16 + fq * 4; float pf[4], pb[4];
#pragma unroll
                for (int r = 0; r < 4; ++r) { const int s = s0 + r; const float val = sacc[mt][nt][r];
                    const float ef = __expf(fminf(aA[s] - Mf, 0.f)), eb = __expf(fminf(aA[128 + s] - Mb, 0.f));
                    pf[r] = (s <= t) ? val * ef : 0.f; pb[r] = (s >= t) ? val * eb : 0.f; rf += pf[r]; rb += pb[r]; }
                u32x2 wf, wb; wf.x = cvt_pk_bf16(pf[0], pf[1]); wf.y = cvt_pk_bf16(pf[2], pf[3]); wb.x = cvt_pk_bf16(pb[0], pb[1]); wb.y = cvt_pk_bf16(pb[2], pb[3]);
                *(LAS u32x2*)(Pd + t * 136 + s0) = wf; *(LAS u32x2*)(Pd + 128 * 136 + t * 136 + s0) = wb; }
            rf += __shfl_xor(rf, 16); rf += __shfl_xor(rf, 32); rb += __shfl_xor(rb, 16); rb += __shfl_xor(rb, 32);
            if (fq == 0) { rsP[w4 * 128 + t] = rf; rsP[512 + w4 * 128 + t] = rb; } }
    }
    __syncthreads();
    LAS float* invA = fl + 3840;
    if (tid < 256) { const int d = tid >> 7, t = tid & 127;
        const float den = winA[tid] * nqA[tid] + ((rsP[d * 512 + t] + rsP[d * 512 + 128 + t]) + (rsP[d * 512 + 256 + t] + rsP[d * 512 + 384 + t]));
        invA[tid] = 1.0f / fmaxf(fabsf(den), clampA[tid]); }
    __syncthreads();
    f32x4 hsum[4][4], acc[4][2];
#pragma unroll
    for (int q = 0; q < 12; ++q) {
        const int nh = q / 6, d = (q % 6) / 3, kind = q % 3;
        if (q + 2 < 12) PB_ISSUE(q + 2);
        __builtin_amdgcn_sched_barrier(0);
        if (kind == 0) {
#pragma unroll
            for (int mt = 0; mt < 4; ++mt)
#pragma unroll
                for (int n2 = 0; n2 < 2; ++n2) { acc[mt][n2] = (f32x4){0.f, 0.f, 0.f, 0.f}; if (d == 0) hsum[mt][nh * 2 + n2] = (f32x4){0.f, 0.f, 0.f, 0.f}; }
        }
        if (kind < 2) {
#pragma unroll
            for (int ks = 0; ks < 4; ++ks) { bf16x8 qf[4];
#pragma unroll
                for (int mt = 0; mt < 4; ++mt) qf[mt] = *(const LAS bf16x8*)(Qs + (wt2 * 64 + mt * 16 + fr) * 264 + (kind * 4 + ks) * 32 + fq * 8);
#pragma unroll
                for (int mt = 0; mt < 4; ++mt)
#pragma unroll
                    for (int n2 = 0; n2 < 2; ++n2) acc[mt][n2] = __builtin_amdgcn_mfma_f32_16x16x32_bf16(F[q % 3][ks][n2], qf[mt], acc[mt][n2], 0, 0, 0); }
        } else {
            const LAS bf16_t* Pp = Pd + d * 128 * 136;
#pragma unroll
            for (int mt = 0; mt < 4; ++mt) { const float wv = winA[d * 128 + wt2 * 64 + mt * 16 + fr];
#pragma unroll
                for (int n2 = 0; n2 < 2; ++n2) acc[mt][n2] *= wv; }
#pragma unroll
            for (int ks = 0; ks < 4; ++ks) { bf16x8 pf[4];
#pragma unroll
                for (int mt = 0; mt < 4; ++mt) pf[mt] = *(const LAS bf16x8*)(Pp + (wt2 * 64 + mt * 16 + fr) * 136 + ks * 32 + fq * 8);
#pragma unroll
                for (int mt = 0; mt < 4; ++mt)
#pragma unroll
                    for (int n2 = 0; n2 < 2; ++n2) acc[mt][n2] = __builtin_amdgcn_mfma_f32_16x16x32_bf16(F[q % 3][ks][n2], pf[mt], acc[mt][n2], 0, 0, 0); }
#pragma unroll
            for (int mt = 0; mt < 4; ++mt) { const float iv = invA[d * 128 + wt2 * 64 + mt * 16 + fr];
#pragma unroll
                for (int n2 = 0; n2 < 2; ++n2) hsum[mt][nh * 2 + n2] += acc[mt][n2] * iv; }
        }
    }
#undef PB_ISSUE
#pragma unroll
    for (int mt = 0; mt < 4; ++mt) { float sv = 0.f;
#pragma unroll
        for (int nt = 0; nt < 4; ++nt) { const f32x4 hv = hsum[mt][nt]; sv += (hv[0] * hv[0] + hv[1] * hv[1]) + (hv[2] * hv[2] + hv[3] * hv[3]); }
        sv += __shfl_xor(sv, 16); sv += __shfl_xor(sv, 32);
        if (fq == 0) ssP[w4 * 128 + wt2 * 64 + mt * 16 + fr] = sv; }
    __syncthreads();
#pragma unroll
    for (int mt = 0; mt < 4; ++mt) { const int t = wt2 * 64 + mt * 16 + fr;
        const float tot = (ssP[t] + ssP[128 + t]) + (ssP[256 + t] + ssP[384 + t]); const float rinv = rsqrtf(tot * (1.0f / 256.0f) + 1e-6f);
#pragma unroll
        for (int nt = 0; nt < 4; ++nt) { const int v = w4 * 64 + nt * 16 + fq * 4; const f32x4 hw = *(const f32x4*)(p.head_norm_w + h * 256 + v);
            const f32x4 o = hsum[mt][nt] * rinv * hw;
            u32x2 w; w.x = cvt_pk_bf16(o[0], o[1]); w.y = cvt_pk_bf16(o[2], o[3]);
            *(LAS u32x2*)(Pd + t * 264 + v) = w; } }
    __syncthreads();
    __builtin_amdgcn_sched_barrier(0);
    if (do_store) {
#pragma unroll 2
        for (int i = 0; i < 8; ++i) { const int id = tid + 512 * i; const int w = id >> 9, m = (id >> 7) & 3, bj = (id >> 6) & 1, ln = id & 63;
            *(u32x4*)(Qg + (size_t)((w * 16 + m * 2 + bj) * 64 + ln) * 8) = *(const LAS u32x4*)(Pd + ((w >> 2) * 64 + m * 16 + (ln & 15)) * 264 + bj * 128 + (w & 3) * 32 + (ln >> 4) * 8); } }
    __syncthreads();
}

__device__ void phase_final(const Params& p) {
    const int tid = opaque_tid(), wid = tid >> 6, lane = tid & 63;
    const float* ssq = (const float*)(p.ws + OFF_SSQ);
    for (int row = blockIdx.x * 8 + wid; row < 16384; row += gridDim.x * 8) {
        const f32x4 s0 = *(const f32x4*)(ssq + (size_t)row * 16), s1 = *(const f32x4*)(ssq + (size_t)row * 16 + 4), s2 = *(const f32x4*)(ssq + (size_t)row * 16 + 8), s3 = *(const f32x4*)(ssq + (size_t)row * 16 + 12);
        const float tot = ((s0[0] + s0[1]) + (s0[2] + s0[3])) + ((s1[0] + s1[1]) + (s1[2] + s1[3])) + ((s2[0] + s2[1]) + (s2[2] + s2[3])) + ((s3[0] + s3[1]) + (s3[2] + s3[3]));
        const float rstd = rsqrtf(tot * (1.0f / 1024.0f) + 1e-6f);
        float* orow = p.out + (size_t)row * 1024;
#pragma unroll
        for (int i = 0; i < 4; ++i) { const f32x4 v = *(const f32x4*)(orow + i * 256 + lane * 4); const f32x4 w = *(const f32x4*)(p.final_norm_w + i * 256 + lane * 4);
            *(f32x4*)(orow + i * 256 + lane * 4) = v * rstd * w; }
    }
}


#define XB_TMO      128
#define XB_XCNT(j)  (256  + 64 * (j))
#define XB_XSUB(j)  (1280 + 64 * (j))
#define XB_XGEN(j)  (2304 + 64 * (j))
#define XB_TOP      3328
#define XB_TOPGEN   3392
#define XCD_BAR_WORDS 3456
#define XB_SPIN_CAP (1u << 18)
__device__ __forceinline__ unsigned xb_ld(unsigned* p)              { return __hip_atomic_load(p, __ATOMIC_RELAXED, __HIP_MEMORY_SCOPE_AGENT); }
__device__ __forceinline__ unsigned xb_add(unsigned* p, unsigned v) { return __hip_atomic_fetch_add(p, v, __ATOMIC_RELAXED, __HIP_MEMORY_SCOPE_AGENT); }
__device__ __forceinline__ unsigned xb_xcc_id() { return (unsigned)__builtin_amdgcn_s_getreg((3 << 11) | 20) & 0xFu; }
#define XB_SPIN(cond, bar) do { unsigned _sp = 0; while (cond) { __builtin_amdgcn_s_sleep(1); \
    if ((++_sp & 255u) == 0u) { if (xb_ld(&(bar)[XB_TMO])) break; if (_sp > XB_SPIN_CAP) { atomicAdd(&(bar)[XB_TMO], 1u); break; } } } } while (0)
struct XcdBarrier { unsigned* bar; unsigned x; volatile LAS unsigned* st; };
__device__ __forceinline__ XcdBarrier xcd_barrier_post(unsigned* bar, volatile LAS unsigned* st) {
    XcdBarrier b; b.bar = bar; b.x = xb_xcc_id(); b.st = st;
    if (threadIdx.x == 0) (void)xb_add(&bar[XB_XCNT(b.x)], 1u);
    return b;
}
__device__ __forceinline__ void xcd_barrier_complete(unsigned* bar, unsigned x, unsigned& nloc, unsigned& nx) {
    const unsigned G = gridDim.x * gridDim.y * gridDim.z;
    unsigned sum, cnt, mine, sp = 0u;
    for (;;) {
        sum = 0u; cnt = 0u; mine = 0u;
#pragma unroll
        for (unsigned j = 0; j < 16; ++j) { const unsigned c = xb_ld(&bar[XB_XCNT(j)]); sum += c; cnt += (c > 0u) ? 1u : 0u; mine = (j == x) ? c : mine; }
        if (sum == G) break;
        __builtin_amdgcn_s_sleep(1);
        if ((++sp & 255u) == 0u) { if (xb_ld(&bar[XB_TMO])) break; if (sp > XB_SPIN_CAP) { atomicAdd(&bar[XB_TMO], 1u); break; } }
    }
    nloc = mine > 0u ? mine : 1u; nx = cnt > 0u ? cnt : 1u;
}
__device__ __forceinline__ void xcd_barrier(const XcdBarrier& b) {
    asm volatile("s_waitcnt vmcnt(0)" ::: "memory");
    __syncthreads();
    if (threadIdx.x == 0) {
        unsigned* bar = b.bar;
        __builtin_amdgcn_s_waitcnt(0);
        unsigned nloc = b.st[0], nx = b.st[1];
        if (nloc == 0u) { xcd_barrier_complete(bar, b.x, nloc, nx); b.st[0] = nloc; b.st[1] = nx; }
        const unsigned old = xb_add(&bar[XB_XSUB(b.x)], 1u);
        const unsigned gen = old / nloc;
        if (old + 1u == (gen + 1u) * nloc) {
            __builtin_amdgcn_fence(__ATOMIC_RELEASE, "agent");
            asm volatile("s_waitcnt vmcnt(0)" ::: "memory");
            const unsigned og = xb_add(&bar[XB_TOP], 1u);
            const unsigned tg = og / nx;
            if (og + 1u == (tg + 1u) * nx) xb_add(&bar[XB_TOPGEN], 1u);
            else XB_SPIN(xb_ld(&bar[XB_TOPGEN]) == tg, bar);
            __builtin_amdgcn_fence(__ATOMIC_ACQUIRE, "agent");
            xb_add(&bar[XB_XGEN(b.x)], 1u);
            asm volatile("s_waitcnt vmcnt(0)" ::: "memory");
        } else {
            XB_SPIN(xb_ld(&bar[XB_XGEN(b.x)]) == gen, bar);
            __builtin_amdgcn_fence(__ATOMIC_ACQUIRE, "agent");
            asm volatile("s_waitcnt vmcnt(0)" ::: "memory");
        }
    }
    __syncthreads();
}

__device__ __forceinline__ void run_phase(const Params& p, LAS unsigned char* lds, int ph) {
    const int tid = opaque_tid();
    const bf16_t* AB = (const bf16_t*)(p.ws + OFF_AB);
    switch (ph) {
    case 0: phase0(p, lds); break;
    case 1: phase1(p, lds); break;
    case 2: { SchedG1 S{(int)blockIdx.x}; EpiG1 E{p.ws}; pg8::gemm_phase(lds, pg8::Gemm{AB, AB, 1024}, S, E); } break;
    case 3: {
        { const int c3 = blockIdx.x, xcd = c3 & 7, sl = c3 >> 3;
          passA(p, lds, (xcd * 8 + (sl >> 2)) * 4 + (sl & 3));
          const int G = (sl >> 2) * 8 + xcd, mem = sl & 3;
          boxfilter_unit(p, lds, G * 4 + mem); boxfilter_unit(p, lds, (127 - G) * 4 + mem); }
        bf16_t* bt = (bf16_t*)(p.ws + OFF_BTPOOL);
        for (int idx = blockIdx.x * 512 + tid; idx < 512 * 512; idx += NWG * 512) { const int n = idx >> 9, k = idx & 511; const int gn = n >> 7, gk = k >> 7;
            const float v = (gn == gk) ? p.pool_w[(size_t)(gn * 128 + (k & 127)) * 128 + (n & 127)] : 0.f;
            bt[idx] = (bf16_t)(cvt_pk_bf16(v, 0.f) & 0xffffu); }
    } break;
    case 4: {
        const int c4 = blockIdx.x, pmt = (c4 & 7) * 8 + (c4 >> 5), j = (c4 >> 3) & 3;
        unsigned* flags = (unsigned*)(p.ws + OFF_PFLAG);
        if (j < 2) {
            Sched64 S{c4, 2}; EpiPool E{p.ws, p.pool_scale};
            pg8::gemm_phase(lds, pg8::Gemm{(const bf16_t*)(p.ws + OFF_MX), (const bf16_t*)(p.ws + OFF_BTPOOL), 512}, S, E);
            asm volatile("s_waitcnt vmcnt(0)" ::: "memory");
            __syncthreads();
            if (threadIdx.x == 0) { __builtin_amdgcn_fence(__ATOMIC_RELEASE, "agent"); asm volatile("s_waitcnt vmcnt(0)" ::: "memory");
                __hip_atomic_store(flags + 64 * (pmt * 2 + j), 1u, __ATOMIC_RELAXED, __HIP_MEMORY_SCOPE_AGENT); }
        }
        passB_unit(p, lds, c4 * 2); passB_unit(p, lds, c4 * 2 + 1);
        if (j < 2) {
            LAS float* T = (LAS float*)lds; const int w128 = pmt * 2 + j;
            for (int job = w128; job < 640; job += 128) {
                if (job < 256) { const int kt = job & 15, ntile = job >> 4; transpose_tile(p.branch_m_w, 1024, kt * 64, ntile * 64, (bf16_t*)(p.ws + OFF_WMT), 1024, ntile * 64, T); }
                else if (job < 512) { const int j2 = job - 256; const int kt = j2 & 15, ntile = j2 >> 4; transpose_tile(p.out_w, 1024, kt * 64, ntile * 64, (bf16_t*)(p.ws + OFF_WOT), 1024, ntile * 64, T); }
                else { const int j2 = job - 512; const int kt = j2 & 7, ntile = j2 >> 3; transpose_tile(p.branch_p_w, 1024, kt * 64, ntile * 64, (bf16_t*)(p.ws + OFF_WPT), 512, ntile * 64, T); }
            }
        }
        if (j >= 2) {
            if (threadIdx.x < 64) { unsigned spins = 0;
                while ((unsigned)__builtin_amdgcn_readfirstlane(__hip_atomic_load(flags + 64 * (pmt * 2 + j - 2), __ATOMIC_RELAXED, __HIP_MEMORY_SCOPE_AGENT)) == 0u) { __builtin_amdgcn_s_sleep(2); if (++spins > (1u << 22)) break; }
                __builtin_amdgcn_fence(__ATOMIC_ACQUIRE, "agent"); asm volatile("s_waitcnt vmcnt(0)" ::: "memory"); }
            __syncthreads();
            SchedOne S{pmt, 72 + 22 + (j - 2)}; EpiG2 E{p.ws, (bf16_t*)p.out};
            pg8::gemm_phase(lds, pg8::Gemm{AB, AB, 1024}, S, E);
        }
    } break;
    case 5: {
        SchedG2 S{(int)blockIdx.x}; EpiG2 E{p.ws, (bf16_t*)p.out}; pg8::gemm_phase(lds, pg8::Gemm{AB, AB, 1024}, S, E);
    } break;
    case 6: {
        Sched64 S{(int)blockIdx.x, 4};
        f32x4 macc[2][2][4][2];
        { EpiMergeMid E{p.ws}; pg8::gemm_phase_acc<EpiMergeMid, Sched64, true>(lds, pg8::Gemm{(const bf16_t*)(p.ws + OFF_PM), (const bf16_t*)(p.ws + OFF_WPT), 512}, S, E, macc); }
        { EpiMergeFin E{p.ws}; pg8::gemm_phase_acc<EpiMergeFin, Sched64, false>(lds, pg8::Gemm{(const bf16_t*)p.out, (const bf16_t*)(p.ws + OFF_WMT), 1024}, S, E, macc); }
    } break;
    case 7: { Sched64 S{(int)blockIdx.x, 4}; EpiOut E{p.ws, p.x, p.out, p.final_norm_w}; pg8::gemm_phase(lds, pg8::Gemm{(const bf16_t*)(p.ws + OFF_MG), (const bf16_t*)(p.ws + OFF_WOT), 1024}, S, E); } break;
    case 8: phase_final(p); break;
    default: break;
    }
}
#if MULTI_LAUNCH
template <int PH> __global__ void __launch_bounds__(512, 2) k_one(Params p) {
    extern __shared__ __attribute__((aligned(16))) unsigned char shm[];
    run_phase(p, (LAS unsigned char*)shm, PH);
}
#else
__global__ void __launch_bounds__(512, 2) fwd_megakernel(Params p) {
    extern __shared__ __attribute__((aligned(16))) unsigned char shm[];
    LAS unsigned char* lds = (LAS unsigned char*)shm;
    cg::grid_group grid = cg::this_grid();
    volatile LAS unsigned* xbst = (volatile LAS unsigned*)(lds + LDS_BYTES - 16);
    if (threadIdx.x == 0) { xbst[0] = 0u; xbst[1] = 0u; }
    __syncthreads();
    const XcdBarrier xb = xcd_barrier_post((unsigned*)(p.ws + OFF_BAR), xbst);
    if (p.ph_lo == 0x7fffffff) grid.sync();
    run_phase(p, lds, 0);
    run_phase(p, lds, 1); xcd_barrier(xb);
    run_phase(p, lds, 2); xcd_barrier(xb);
#ifdef PROBE_G1
    run_phase(p, lds, 2); xcd_barrier(xb);
#endif
    run_phase(p, lds, 3); xcd_barrier(xb);
#ifdef PROBE_A
    passA(p, lds, blockIdx.x); xcd_barrier(xb);
#endif
#ifdef PROBE_BOX
    boxfilter_unit(p, lds, blockIdx.x); boxfilter_unit(p, lds, 511 - blockIdx.x); xcd_barrier(xb);
#endif
    run_phase(p, lds, 4); xcd_barrier(xb);
    run_phase(p, lds, 5); xcd_barrier(xb);
    run_phase(p, lds, 6); xcd_barrier(xb);
    run_phase(p, lds, 7);
}
#endif

extern "C" void kernel_launch(void* const* d_in, const int* in_sizes, int n_in, void* d_out, int out_size, void* d_ws, size_t ws_size, hipStream_t stream) {
#if MULTI_LAUNCH
#define SETATTR(PH) (void)hipFuncSetAttribute((const void*)k_one<PH>, hipFuncAttributeMaxDynamicSharedMemorySize, LDS_BYTES)
    static int configured = 0;
    if (!configured) { SETATTR(0); SETATTR(1); SETATTR(2); SETATTR(3); SETATTR(4); SETATTR(5); SETATTR(6); SETATTR(7); SETATTR(8); configured = 1; }
#else
    static int configured = 0;
    if (!configured) {
        (void)hipFuncSetAttribute((const void*)fwd_megakernel, hipFuncAttributeMaxDynamicSharedMemorySize, LDS_BYTES);
        int dev = 0, cus = 0, per_cu = 0;
        (void)hipGetDevice(&dev); (void)hipDeviceGetAttribute(&cus, hipDeviceAttributeMultiprocessorCount, dev);
        (void)hipOccupancyMaxActiveBlocksPerMultiprocessor(&per_cu, fwd_megakernel, 512, LDS_BYTES);
        if (cus * per_cu < NWG) fprintf(stderr, "grid %d exceeds resident capacity %d x %d\n", NWG, cus, per_cu);
        if (ws_size < 256 * MiB) fprintf(stderr, "workspace too small: %zu\n", ws_size);
        configured = 1;
    }
#endif
    Params p{};
    p.x = (const float*)d_in[0]; p.c = (const float*)d_in[1]; p.ctx = (const float*)d_in[2]; p.c_ctx = (const float*)d_in[3]; p.norm_w = (const float*)d_in[4];
    p.ada_w = (const float*)d_in[5]; p.ada_b = (const float*)d_in[6]; p.in_w = (const float*)d_in[7]; p.gate_b = (const float*)d_in[8]; p.head_norm_w = (const float*)d_in[9];
    p.pool_w = (const float*)d_in[10]; p.pool_scale = (const float*)d_in[11]; p.branch_m_w = (const float*)d_in[12]; p.branch_p_w = (const float*)d_in[13]; p.out_w = (const float*)d_in[14];
    p.final_norm_w = (const float*)d_in[15];
    p.out = (float*)d_out; p.ws = (unsigned char*)d_ws;
#if MULTI_LAUNCH
    (void)hipMemsetAsync((unsigned char*)d_ws + OFF_BAR, 0, 65536, stream);
#define LAUNCH(PH) hipLaunchKernelGGL(k_one<PH>, dim3(NWG), dim3(512), LDS_BYTES, stream, p)
    LAUNCH(0); LAUNCH(1); LAUNCH(2); LAUNCH(3); LAUNCH(4); LAUNCH(5); LAUNCH(6); LAUNCH(7);
#else
    p.ph_lo = 0; p.ph_hi = 8;
    (void)hipMemsetAsync((unsigned char*)d_ws + OFF_BAR, 0, 65536, stream);
    void* args[] = {&p};
    hipError_t e = hipLaunchCooperativeKernel((const void*)fwd_megakernel, dim3(NWG), dim3(512), args, LDS_BYTES, stream);
    if (e != hipSuccess) fprintf(stderr, "cooperative launch failed: %s\n", hipGetErrorString(e));
#endif
}
```

```cpp
#include <hip/hip_runtime.h>
#include <hip/hip_cooperative_groups.h>
#include <cstdio>
namespace cg = cooperative_groups;

#ifndef MULTI_LAUNCH
#define MULTI_LAUNCH 0
#endif

#define LAS __attribute__((address_space(3)))
typedef unsigned short bf16_t;
typedef short bf16x8 __attribute__((ext_vector_type(8)));
typedef float f32x4 __attribute__((ext_vector_type(4)));
typedef unsigned u32x4 __attribute__((ext_vector_type(4)));
typedef unsigned u32x2 __attribute__((ext_vector_type(2)));

constexpr size_t MiB = 1024u * 1024u;
constexpr int LDS_BYTES = 155648;
constexpr int NWG = 256;
constexpr size_t OFF_AB = 0;
constexpr size_t OFF_BTPOOL = 32 * MiB;
constexpr size_t OFF_Q = 52 * MiB;
constexpr size_t OFF_K = 84 * MiB;
constexpr size_t OFF_VT = 116 * MiB;
constexpr size_t OFF_KC = 148 * MiB;
constexpr size_t OFF_VTC = 152 * MiB;
constexpr size_t OFF_P = 156 * MiB;
constexpr size_t OFF_PM = 148 * MiB;
constexpr size_t OFF_MX = 172 * MiB;
constexpr size_t OFF_CST2 = 188 * MiB;
constexpr size_t OFF_GB = 188 * MiB;
constexpr size_t OFF_WMT = 36 * MiB, OFF_WPT = 38 * MiB, OFF_WOT = 39 * MiB;
constexpr size_t OFF_MG = 116 * MiB;
constexpr size_t OFF_SMALL = 252 * MiB;
constexpr size_t OFF_GL = OFF_SMALL;
constexpr size_t OFF_SSQ = OFF_SMALL;
constexpr size_t OFF_GC = OFF_SMALL + 1 * MiB;
constexpr size_t OFF_NST = OFF_SMALL + 1 * MiB + 128 * 1024;
constexpr size_t OFF_MST = OFF_NST + 1 * MiB;
constexpr size_t OFF_MODP = OFF_MST + 4096;
constexpr size_t OFF_GATEV = OFF_MODP + 8 * 9 * 3072 * 4;
constexpr size_t OFF_PCNT = OFF_SMALL + 3 * MiB + 512 * 1024 + 16384;
constexpr size_t OFF_PFLAG = OFF_SMALL + 3 * MiB + 512 * 1024 + 32768;
constexpr size_t OFF_ACNT = OFF_SMALL + 3 * MiB + 512 * 1024 + 15360;
constexpr size_t OFF_BAR = OFF_SMALL + 3 * MiB + 512 * 1024;

struct Params {
    const float *x, *c, *ctx, *c_ctx, *norm_w, *ada_w, *ada_b, *in_w, *gate_b, *head_norm_w, *pool_w, *pool_scale, *branch_m_w, *branch_p_w, *out_w, *final_norm_w;
    float* out; unsigned char* ws;
    int ph_lo, ph_hi;
};

__device__ __forceinline__ int opaque_tid() { int t = (int)threadIdx.x; asm volatile("" : "+v"(t)); return t; }
__device__ __forceinline__ float bf_lo(unsigned w) { return __uint_as_float(w << 16); }
__device__ __forceinline__ float bf_hi(unsigned w) { return __uint_as_float(w & 0xffff0000u); }
__device__ __forceinline__ unsigned cvt_pk_bf16(float lo, float hi) { unsigned r; asm volatile("v_cvt_pk_bf16_f32 %0, %1, %2" : "=v"(r) : "v"(lo), "v"(hi)); return r; }
__device__ __forceinline__ float sigm(float x) { return __builtin_amdgcn_rcpf(1.0f + __expf(-x)); }
__device__ __forceinline__ float siluf(float x) { return x * __builtin_amdgcn_rcpf(1.0f + __expf(-x)); }

namespace pg8 {
constexpr int BM = 256, BK = 64, HALF = 128, HTB = HALF * BK * 2, STAGE_BYTES = 8 * HTB;
__device__ __forceinline__ int lds_byte(int r, int c) { const int st = (r >> 4) * 2 + (c >> 5), rr = r & 15, cc = c & 31, ob = rr * 64 + cc * 2; return st * 1024 + (ob ^ (((ob >> 9) & 1) << 5)); }
__device__ __forceinline__ void stage_rc(int b, int& R, int& C) { const int st = b / 1024, sb = b % 1024, swz = sb ^ (((sb >> 9) & 1) << 5); R = (st >> 1) * 16 + swz / 64; C = (st & 1) * 32 + (swz % 64) / 2; }
__device__ __forceinline__ int perm32(int rho) { const int n = rho >> 4, i = rho & 15; return 8 * (i >> 2) + 4 * n + (i & 3); }
struct Unit { int pm, pn; };
struct Gemm { const bf16_t* A; const bf16_t* Bt; int K; };

template <class Epi, class Sched, bool ZERO>
__device__ __forceinline__ void gemm_phase_acc(LAS unsigned char* lds, const Gemm g, const Sched& S, const Epi& E, f32x4 (&acc)[2][2][4][2]) {
    const int tid = opaque_tid(), wid = __builtin_amdgcn_readfirstlane(tid >> 6), lane = tid & 63, wr = wid >> 2, wc = wid & 3, fr = lane & 15, fq = lane >> 4;
    const int K = g.K, nt = K / BK;
    unsigned voffA[2], voffB[2];
#pragma unroll
    for (int i = 0; i < 2; ++i) { int R, C; stage_rc(tid * 16 + i * 8192, R, C); const int Rb = (R & ~31) + perm32(R & 31);
        voffA[i] = (unsigned)(R * K + C) * 2u; voffB[i] = (unsigned)(Rb * K + C) * 2u; }
    const size_t kstep = (size_t)(BK * 2);
    const size_t hstep = (size_t)HALF * K * 2;
    const size_t tstep = 2 * hstep;
    const unsigned ldsw = (unsigned)wid * 1024u;
    const int aoff = lds_byte(wr * 64 + fr, fq * 8), boff = lds_byte(wc * 32 + fr, fq * 8);
#define PG8_SA(b, h) (((b) * 2 + (h)) * HTB)
#define PG8_SB(b, h) ((4 + (b) * 2 + (h)) * HTB)
#define PG8_STAGE(bufoff, gbase, voff) do { _Pragma("unroll") for (int _i = 0; _i < 2; ++_i) \
        __builtin_amdgcn_global_load_lds((const unsigned*)((const char*)(gbase) + (voff)[_i]), (LAS unsigned*)(lds + (bufoff) + ldsw + _i * 8192), 16, 0, 0); } while (0)
#define PG8_LDA(dst, b, h) do { _Pragma("unroll") for (int m = 0; m < 4; ++m) _Pragma("unroll") for (int k = 0; k < 2; ++k) dst[m][k] = *(const LAS bf16x8*)(lds + PG8_SA(b, h) + aoff + m * 2048 + k * 1024); } while (0)
#define PG8_LDB(dst, b, h) do { _Pragma("unroll") for (int n = 0; n < 2; ++n) _Pragma("unroll") for (int k = 0; k < 2; ++k) dst[n][k] = *(const LAS bf16x8*)(lds + PG8_SB(b, h) + boff + n * 2048 + k * 1024); } while (0)
#define PG8_MMA(ai, bj, At, Bt) do { __builtin_amdgcn_s_setprio(1); _Pragma("unroll") for (int m = 0; m < 4; ++m) _Pragma("unroll") for (int n = 0; n < 2; ++n) _Pragma("unroll") for (int k = 0; k < 2; ++k) \
        acc[ai][bj][m][n] = __builtin_amdgcn_mfma_f32_16x16x32_bf16(Bt[n][k], At[m][k], acc[ai][bj][m][n], 0, 0, 0); __builtin_amdgcn_s_setprio(0); } while (0)
#define PG8_WAIT_V(n) asm volatile("s_waitcnt vmcnt(" #n ")" ::: "memory")
#define PG8_WAIT_L(n) asm volatile("s_waitcnt lgkmcnt(" #n ")" ::: "memory")
#define PG8_BAR __builtin_amdgcn_s_barrier()
#define PG8_SCHED __builtin_amdgcn_sched_barrier(0)
    Unit cur, nxt; int ui = 0;
    if (!S.next(0, cur)) return;
    if constexpr (ZERO) {
#pragma unroll
    for (int a = 0; a < 2; ++a)
#pragma unroll
        for (int b = 0; b < 2; ++b)
#pragma unroll
            for (int m = 0; m < 4; ++m)
#pragma unroll
                for (int n = 0; n < 2; ++n) acc[a][b][m][n] = (f32x4){0.f, 0.f, 0.f, 0.f};
    }
    bf16x8 At[4][2], B0[2][2], B1[2][2];
    const char* cA = (const char*)g.A + (size_t)cur.pm * tstep; const char* cB = (const char*)g.Bt + (size_t)cur.pn * tstep;
    PG8_STAGE(PG8_SB(0, 0), cB, voffB); PG8_STAGE(PG8_SA(0, 0), cA, voffA); PG8_STAGE(PG8_SB(0, 1), cB + hstep, voffB); PG8_STAGE(PG8_SA(0, 1), cA + hstep, voffA);
    if (wr == 1) PG8_BAR;
    PG8_WAIT_V(4); PG8_BAR;
    PG8_STAGE(PG8_SB(1, 0), cB + kstep, voffB); PG8_STAGE(PG8_SA(1, 0), cA + kstep, voffA); PG8_STAGE(PG8_SB(1, 1), cB + hstep + kstep, voffB);
    PG8_WAIT_V(6); PG8_BAR;
    for (;;) {
        const bool has_next = S.next(ui + 1, nxt);
        const char* nA = has_next ? (const char*)g.A + (size_t)nxt.pm * tstep : cA; const char* nB = has_next ? (const char*)g.Bt + (size_t)nxt.pn * tstep : cB;
        for (int t = 0; t < nt; t += 2) {
            const bool last = (t == nt - 2);
            const char* a1 = cA + (size_t)(t + 1) * kstep;
            const char* a2 = last ? nA : cA + (size_t)(t + 2) * kstep; const char* b2 = last ? nB : cB + (size_t)(t + 2) * kstep;
            const char* a3 = a2 + kstep; const char* b3 = b2 + kstep;
            PG8_LDB(B0, 0, 0); PG8_SCHED; PG8_LDA(At, 0, 0); PG8_STAGE(PG8_SA(1, 1), a1 + hstep, voffA);
            PG8_WAIT_L(8); PG8_BAR; PG8_WAIT_L(0); PG8_MMA(0, 0, At, B0); PG8_BAR; PG8_SCHED;
            PG8_LDB(B1, 0, 1); PG8_STAGE(PG8_SB(0, 0), b2, voffB);
            PG8_BAR; PG8_WAIT_L(0); PG8_MMA(0, 1, At, B1); PG8_BAR;
            PG8_LDA(At, 0, 1); PG8_STAGE(PG8_SA(0, 0), a2, voffA);
            PG8_BAR; PG8_WAIT_L(0); PG8_MMA(1, 0, At, B0); PG8_BAR; PG8_SCHED;
            PG8_STAGE(PG8_SB(0, 1), b2 + hstep, voffB);
            PG8_WAIT_V(6); PG8_BAR; PG8_MMA(1, 1, At, B1); PG8_BAR;
            PG8_LDB(B0, 1, 0); PG8_SCHED; PG8_LDA(At, 1, 0); PG8_STAGE(PG8_SA(0, 1), a2 + hstep, voffA);
            PG8_WAIT_L(8); PG8_BAR; PG8_WAIT_L(0); PG8_MMA(0, 0, At, B0); PG8_BAR; PG8_SCHED;
            PG8_LDB(B1, 1, 1); PG8_STAGE(PG8_SB(1, 0), b3, voffB);
            PG8_BAR; PG8_WAIT_L(0); PG8_MMA(0, 1, At, B1); PG8_BAR;
            PG8_LDA(At, 1, 1); PG8_STAGE(PG8_SA(1, 0), a3, voffA);
            PG8_BAR; PG8_WAIT_L(0); PG8_MMA(1, 0, At, B0); PG8_BAR; PG8_SCHED;
            PG8_STAGE(PG8_SB(1, 1), b3 + hstep, voffB);
            PG8_WAIT_V(6); PG8_BAR; PG8_MMA(1, 1, At, B1); PG8_BAR;
        }
        if constexpr (!Epi::AFTER_DRAIN) E(acc, cur, wr, wc, fr, fq);
        if constexpr (Epi::DRAIN) __builtin_amdgcn_s_waitcnt(0x0F70);
        if (!has_next) break;
#pragma unroll
        for (int a = 0; a < 2; ++a)
#pragma unroll
            for (int b = 0; b < 2; ++b)
#pragma unroll
                for (int m = 0; m < 4; ++m)
#pragma unroll
                    for (int n = 0; n < 2; ++n) acc[a][b][m][n] = (f32x4){0.f, 0.f, 0.f, 0.f};
        cur = nxt; cA = nA; cB = nB; ++ui;
    }
    PG8_WAIT_V(0);
    if (wr == 0) PG8_BAR;
    PG8_BAR;
    if constexpr (Epi::AFTER_DRAIN) E.fused(acc, cur, wr, wc, fr, fq, lds);
#undef PG8_SA
#undef PG8_SB
#undef PG8_STAGE
#undef PG8_LDA
#undef PG8_LDB
#undef PG8_MMA
#undef PG8_WAIT_V
#undef PG8_WAIT_L
#undef PG8_BAR
#undef PG8_SCHED
}
template <class Epi, class Sched>
__device__ __forceinline__ void gemm_phase(LAS unsigned char* lds, const Gemm g, const Sched& S, const Epi& E) {
    f32x4 acc[2][2][4][2];
    gemm_phase_acc<Epi, Sched, true>(lds, g, S, E, acc);
}
}
using pg8::Unit;

struct SchedG1 {
    int c;
    __device__ __forceinline__ bool next(int i, Unit& u) const {
        const int xcd = c & 7, slot = c >> 3, pmt = xcd * 8 + (slot >> 2), j = slot & 3;
        if (i < 2) { u.pm = pmt; u.pn = 72 + i * 4 + j; return true; }
        if (i == 2) { u.pm = 72 + 8 + j; u.pn = pmt; return true; }
        if (i == 3) {
            if (j < 2) { u.pm = pmt; u.pn = 72 + 20 + j; return true; }
            if (j == 2) { int cu = pmt;
                if (cu < 32) { u.pm = 64 + (cu >> 2); u.pn = 72 + 4 + (cu & 3); }
                else { cu -= 32; u.pm = 72 + 8 + (cu & 3); u.pn = 64 + (cu >> 2); }
                return true; }
        }
        return false;
    }
};
struct SchedG2 {
    int c;
    __device__ __forceinline__ bool next(int i, Unit& u) const {
        const int xcd = c & 7, slot = c >> 3, pmt = xcd * 8 + (slot >> 2), j = slot & 3;
        u.pm = pmt;
        if (i == 0) { u.pn = 72 + 12 + j; return true; }
        if (i == 1) { u.pn = 72 + 16 + j; return true; }
        if (i == 2) { u.pn = 72 + 24 + j; return true; }
        if (i == 3) { u.pn = 72 + 28 + j; return true; }
        return false;
    }
};
struct SchedOne {
    int pm, pn;
    __device__ __forceinline__ bool next(int i, Unit& u) const { if (i == 0) { u.pm = pm; u.pn = pn; return true; } return false; }
};
struct Sched64 {
    int c, ncol;
    __device__ __forceinline__ bool next(int i, Unit& u) const {
        const int xcd = c & 7, slot = c >> 3, pmt = xcd * 8 + (slot >> 2), j = slot & 3;
        if (i == 0 && j < ncol) { u.pm = pmt; u.pn = j; return true; }
        return false;
    }
};

struct EpiG1 {
    static constexpr bool AFTER_DRAIN = false;
    static constexpr bool DRAIN = false;
    unsigned char* ws;
    __device__ __forceinline__ void operator()(const f32x4 (&acc)[2][2][4][2], const Unit& u, int wr, int wc, int fr, int fq) const {
        const bool sw = u.pm >= 72;
        const int tokt = sw ? u.pn : u.pm, wt = (sw ? u.pm : u.pn) - 72;
        bf16_t* base; int ld; float sc = 1.0f; int rowbase;
        if (!sw) {
            rowbase = tokt * 256;
            if (wt < 4) { base = (bf16_t*)(ws + OFF_Q) + (size_t)(tokt * 4 + wt) * 65536 + ((wr * 4 + wc) * 16 * 64 + (fq * 16 + fr)) * 8; ld = 0; }
            else if (wt < 8) { sc = 0.0625f; ld = 0;
                if (tokt < 64) base = (bf16_t*)(ws + OFF_K) + (size_t)((tokt * 2) * 4 + (wt - 4)) * 32768;
                else base = (bf16_t*)(ws + OFF_KC) + (size_t)(((tokt - 64) * 2) * 4 + (wt - 4)) * 32768; }
            else { base = (bf16_t*)(ws + OFF_P); ld = 0; }
        } else {
            rowbase = (wt - 8) * 256;
            if (tokt < 64) base = (bf16_t*)(ws + OFF_VT) + (size_t)(tokt * 2) * 1024 * 128;
            else base = (bf16_t*)(ws + OFF_VTC) + (size_t)((tokt - 64) * 2) * 1024 * 128;
            ld = 128;
        }
        const int row0 = rowbase + wr * 64 + fr, col0 = wc * 32 + 8 * fq;
        const size_t bjstep = sw ? (size_t)1024 * 128 : (wt >= 20 ? (size_t)16 * 2048 * 8 : (wt >= 4 && wt < 8 ? (size_t)4 * 512 : (wt < 4 ? (size_t)512 : (size_t)128)));
#pragma unroll
        for (int ai = 0; ai < 2; ++ai)
#pragma unroll
            for (int m = 0; m < 4; ++m) {
                const bool isp = !sw && wt >= 20, isk = !sw && wt >= 4 && wt < 8, isq = !sw && wt < 4;
                bf16_t* rowp = sw ? base + (size_t)((((rowbase + wr * 64 + ai * 128 + m * 16) >> 4) * 4 + wc) * 512 + (fr * 4 + fq) * 8)
                             : isq ? base + ((ai * 4 + m) * 2) * 512
                             : isk ? base + (size_t)(ai * 4 * 64 + (wr * 4 + m) * 8 + wc) * 512 + (fr * 4 + fq) * 8
                             : isp ? base + ((size_t)((tokt >> 3) * 64 + (wt - 20) * 32 + wc * 4 + fq) * 2048 + ((row0 + ai * 128 + m * 16) & 2047)) * 8
                                   : base + (size_t)(row0 + ai * 128 + m * 16) * ld + col0;
#pragma unroll
                for (int bj = 0; bj < 2; ++bj) { const f32x4 v0 = acc[ai][bj][m][0] * sc, v1 = acc[ai][bj][m][1] * sc;
                    u32x4 w; w.x = cvt_pk_bf16(v0[0], v0[1]); w.y = cvt_pk_bf16(v0[2], v0[3]); w.z = cvt_pk_bf16(v1[0], v1[1]); w.w = cvt_pk_bf16(v1[2], v1[3]);
                    *(u32x4*)(rowp + bj * bjstep) = w; } }
    }
};
struct EpiG2 {
    static constexpr bool AFTER_DRAIN = false;
    static constexpr bool DRAIN = true;
    unsigned char* ws; bf16_t* am;
    __device__ __forceinline__ void operator()(const f32x4 (&acc)[2][2][4][2], const Unit& u, int wr, int wc, int fr, int fq) const {
        const int wt = u.pn - 72;
        const int gl_off = ((wr * 4 + wc) * 16 * 64 + (fq * 16 + fr)) * 8;
        const int row0 = u.pm * 256 + wr * 64 + fr, col0 = wc * 32 + 8 * fq;
        const bf16_t* ldp = nullptr; bf16_t* stp; bool ld_lm = false, st_lm = false, act_silu = false, recip = false; int ld = 0;
        if (wt < 16) { bf16_t* t = (bf16_t*)(ws + OFF_Q) + (size_t)(u.pm * 4 + (wt - 12)) * 65536 + gl_off; ldp = t; stp = t; ld_lm = st_lm = true; }
        else if (wt < 20) { ldp = (const bf16_t*)(ws + OFF_Q) + (size_t)(u.pm * 4 + (wt - 16)) * 65536 + gl_off; ld_lm = true; stp = am + (wt - 16) * 256; ld = 1024; act_silu = true; }
        else if (wt < 24) { bf16_t* t = (bf16_t*)(ws + OFF_PM) + (wt - 22) * 256; ldp = t; stp = t; ld = 512; act_silu = true; }
        else if (wt < 28) { stp = (bf16_t*)(ws + OFF_GB) + (size_t)(u.pm * 8 + (wt - 24)) * 65536 + gl_off; st_lm = true; }
        else { bf16_t* t = (bf16_t*)(ws + OFF_GB) + (size_t)(u.pm * 8 + (wt - 24)) * 65536 + gl_off; stp = t; st_lm = true; ldp = t - 4 * 65536; ld_lm = true; recip = true; }
#pragma unroll
        for (int ai = 0; ai < 2; ++ai) {
            u32x4 old8[4][2];
            if (ldp) {
#pragma unroll
                for (int m = 0; m < 4; ++m)
#pragma unroll
                    for (int bj = 0; bj < 2; ++bj) old8[m][bj] = ld_lm ? *(const u32x4*)(ldp + ((ai * 4 + m) * 2 + bj) * 512)
                                                                       : *(const u32x4*)(ldp + (size_t)(row0 + ai * 128 + m * 16) * ld + col0 + bj * 128);
            }
#pragma unroll
            for (int m = 0; m < 4; ++m)
#pragma unroll
                for (int bj = 0; bj < 2; ++bj) { const f32x4 a0 = acc[ai][bj][m][0], a1 = acc[ai][bj][m][1];
                    float f[8];
#pragma unroll
                    for (int q = 0; q < 4; ++q) { f[q] = act_silu ? siluf(a0[q]) : sigm(a0[q]); f[4 + q] = act_silu ? siluf(a1[q]) : sigm(a1[q]); }
                    if (ldp) { const u32x4 o = old8[m][bj];
                        if (recip) { f[0] *= __builtin_amdgcn_rcpf(bf_lo(o.x)); f[1] *= __builtin_amdgcn_rcpf(bf_hi(o.x)); f[2] *= __builtin_amdgcn_rcpf(bf_lo(o.y)); f[3] *= __builtin_amdgcn_rcpf(bf_hi(o.y));
                            f[4] *= __builtin_amdgcn_rcpf(bf_lo(o.z)); f[5] *= __builtin_amdgcn_rcpf(bf_hi(o.z)); f[6] *= __builtin_amdgcn_rcpf(bf_lo(o.w)); f[7] *= __builtin_amdgcn_rcpf(bf_hi(o.w)); }
                        else { f[0] *= bf_lo(o.x); f[1] *= bf_hi(o.x); f[2] *= bf_lo(o.y); f[3] *= bf_hi(o.y); f[4] *= bf_lo(o.z); f[5] *= bf_hi(o.z); f[6] *= bf_lo(o.w); f[7] *= bf_hi(o.w); } }
                    u32x4 w; w.x = cvt_pk_bf16(f[0], f[1]); w.y = cvt_pk_bf16(f[2], f[3]); w.z = cvt_pk_bf16(f[4], f[5]); w.w = cvt_pk_bf16(f[6], f[7]);
                    if (st_lm) { if (recip) __builtin_nontemporal_store(w, (u32x4*)(stp + ((ai * 4 + m) * 2 + bj) * 512)); else *(u32x4*)(stp + ((ai * 4 + m) * 2 + bj) * 512) = w; }
                    else *(u32x4*)(stp + (size_t)(row0 + ai * 128 + m * 16) * ld + col0 + bj * 128) = w; } }
    }
};
struct EpiPool {
    static constexpr bool AFTER_DRAIN = false;
    static constexpr bool DRAIN = false;
    unsigned char* ws; const float* pool_scale;
    __device__ __forceinline__ void operator()(const f32x4 (&acc)[2][2][4][2], const Unit& u, int wr, int wc, int fr, int fq) const {
        bf16_t* base = (bf16_t*)(ws + OFF_PM) + u.pn * 256;
        const int row0 = u.pm * 256 + wr * 64 + fr, col0 = wc * 32 + 8 * fq;
        f32x4 s[2][2];
#pragma unroll
        for (int bj = 0; bj < 2; ++bj)
#pragma unroll
            for (int n = 0; n < 2; ++n) s[bj][n] = *(const f32x4*)(pool_scale + u.pn * 256 + col0 + bj * 128 + 4 * n);
#pragma unroll
        for (int ai = 0; ai < 2; ++ai)
#pragma unroll
            for (int m = 0; m < 4; ++m) { bf16_t* rowp = base + (size_t)(row0 + ai * 128 + m * 16) * 512 + col0;
#pragma unroll
                for (int bj = 0; bj < 2; ++bj) { const f32x4 v0 = acc[ai][bj][m][0] * s[bj][0], v1 = acc[ai][bj][m][1] * s[bj][1];
                    u32x4 w; w.x = cvt_pk_bf16(v0[0], v0[1]); w.y = cvt_pk_bf16(v0[2], v0[3]); w.z = cvt_pk_bf16(v1[0], v1[1]); w.w = cvt_pk_bf16(v1[2], v1[3]);
                    *(u32x4*)(rowp + bj * 128) = w; } }
    }
};
struct EpiMergeMid {
    static constexpr bool AFTER_DRAIN = false;
    static constexpr bool DRAIN = false;
    unsigned char* ws;
    __device__ __forceinline__ void operator()(f32x4 (&acc)[2][2][4][2], const Unit& u, int wr, int wc, int fr, int fq) const {
        const bf16_t* gr = (const bf16_t*)(ws + OFF_GB) + (size_t)(u.pm * 8 + 4 + u.pn) * 65536 + ((wr * 4 + wc) * 16 * 64 + (fq * 16 + fr)) * 8;
        const int row0 = u.pm * 256 + wr * 64 + fr, col0 = wc * 32 + 8 * fq;
#pragma unroll
        for (int ai = 0; ai < 2; ++ai) {
            u32x4 g8[4][2];
#pragma unroll
            for (int m = 0; m < 4; ++m)
#pragma unroll
                for (int bj = 0; bj < 2; ++bj) g8[m][bj] = __builtin_nontemporal_load((const u32x4*)(gr + ((ai * 4 + m) * 2 + bj) * 512));
#pragma unroll
            for (int m = 0; m < 4; ++m)
#pragma unroll
                for (int bj = 0; bj < 2; ++bj) { const u32x4 g = g8[m][bj];
                    acc[ai][bj][m][0] *= (f32x4){bf_lo(g.x), bf_hi(g.x), bf_lo(g.y), bf_hi(g.y)}; acc[ai][bj][m][1] *= (f32x4){bf_lo(g.z), bf_hi(g.z), bf_lo(g.w), bf_hi(g.w)}; } }
    }
};
struct EpiMergeFin {
    static constexpr bool AFTER_DRAIN = false;
    static constexpr bool DRAIN = false;
    unsigned char* ws;
    __device__ __forceinline__ void operator()(f32x4 (&acc)[2][2][4][2], const Unit& u, int wr, int wc, int fr, int fq) const {
        asm volatile("" : "+v"(fr), "+v"(fq));
        const bf16_t* gb = (const bf16_t*)(ws + OFF_GB) + (size_t)(u.pm * 8 + u.pn) * 65536 + ((wr * 4 + wc) * 16 * 64 + (fq * 16 + fr)) * 8;
        bf16_t* mg = (bf16_t*)(ws + OFF_MG) + u.pn * 256;
        const int row0 = u.pm * 256 + wr * 64 + fr, col0 = wc * 32 + 8 * fq;
#pragma unroll
        for (int ai = 0; ai < 2; ++ai) {
            u32x4 g8[4][2];
#pragma unroll
            for (int m = 0; m < 4; ++m)
#pragma unroll
                for (int bj = 0; bj < 2; ++bj) g8[m][bj] = *(const u32x4*)(gb + ((ai * 4 + m) * 2 + bj) * 512);
#pragma unroll
            for (int m = 0; m < 4; ++m) { const size_t row = (size_t)(row0 + ai * 128 + m * 16);
#pragma unroll
                for (int bj = 0; bj < 2; ++bj) { const u32x4 g = g8[m][bj]; const f32x4 a0 = acc[ai][bj][m][0], a1 = acc[ai][bj][m][1];
                    u32x4 w; w.x = cvt_pk_bf16(a0[0] * bf_lo(g.x), a0[1] * bf_hi(g.x)); w.y = cvt_pk_bf16(a0[2] * bf_lo(g.y), a0[3] * bf_hi(g.y));
                    w.z = cvt_pk_bf16(a1[0] * bf_lo(g.z), a1[1] * bf_hi(g.z)); w.w = cvt_pk_bf16(a1[2] * bf_lo(g.w), a1[3] * bf_hi(g.w));
                    *(u32x4*)(mg + row * 1024 + col0 + bj * 128) = w; } } }
    }
};
struct EpiOut {
    static constexpr bool DRAIN = false;
    static constexpr bool AFTER_DRAIN = true;
    unsigned char* ws; const float* x; float* out; const float* fnw;
    __device__ __forceinline__ void operator()(f32x4 (&acc)[2][2][4][2], const Unit& u, int wr, int wc, int fr, int fq) const {}
    __device__ __forceinline__ void fused(f32x4 (&acc)[2][2][4][2], const Unit& u, int wr, int wc, int fr, int fq, LAS unsigned char* lds) const {
        const int b = u.pm >> 3;
        const float* gv = (const float*)(ws + OFF_GATEV) + b * 1024 + u.pn * 256;
        float* ssq = (float*)(ws + OFF_SSQ);
        unsigned* cnt = (unsigned*)(ws + OFF_PCNT) + 64 * u.pm;
        const int row0 = u.pm * 256 + wr * 64 + fr, col0 = wc * 32 + 8 * fq;
        f32x4 gg[2][2];
#pragma unroll
        for (int bj = 0; bj < 2; ++bj)
#pragma unroll
            for (int n = 0; n < 2; ++n) gg[bj][n] = *(const f32x4*)(gv + col0 + bj * 128 + 4 * n);
        f32x4 xb[2][2][2][2];
#define EO_LOAD(k) do { _Pragma("unroll") for (int m2 = 0; m2 < 2; ++m2) _Pragma("unroll") for (int bj = 0; bj < 2; ++bj) _Pragma("unroll") for (int n = 0; n < 2; ++n) \
            xb[(k) & 1][m2][bj][n] = __builtin_nontemporal_load((const f32x4*)(x + (size_t)(row0 + ((k) >> 1) * 128 + (((k) & 1) * 2 + m2) * 16) * 1024 + u.pn * 256 + col0 + bj * 128 + 4 * n)); } while (0)
        EO_LOAD(0);
#pragma unroll
        for (int k = 0; k < 4; ++k) { const int ai = k >> 1;
            if (k + 1 < 4) EO_LOAD(k + 1);
#pragma unroll
            for (int m2 = 0; m2 < 2; ++m2) { const int m = (k & 1) * 2 + m2; const size_t row = (size_t)(row0 + ai * 128 + m * 16); float s = 0.f;
#pragma unroll
                for (int bj = 0; bj < 2; ++bj)
#pragma unroll
                    for (int n = 0; n < 2; ++n) { const f32x4 o = xb[k & 1][m2][bj][n] + gg[bj][n] * acc[ai][bj][m][n];
                        acc[ai][bj][m][n] = o; s += (o[0] * o[0] + o[1] * o[1]) + (o[2] * o[2] + o[3] * o[3]); }
                s += __shfl_xor(s, 16); s += __shfl_xor(s, 32);
                if (fq == 0) __hip_atomic_store(ssq + row * 16 + u.pn * 4 + wc, s, __ATOMIC_RELAXED, __HIP_MEMORY_SCOPE_AGENT); } }
#undef EO_LOAD
        asm volatile("s_waitcnt vmcnt(0)" ::: "memory");
        const int lane = fr + 16 * fq, wid = wr * 4 + wc;
        if (lane == 0) __hip_atomic_fetch_add(cnt, 1u, __ATOMIC_RELAXED, __HIP_MEMORY_SCOPE_AGENT);
        if (wid == 0) {
            unsigned spins = 0;
            while ((unsigned)__builtin_amdgcn_readfirstlane(__hip_atomic_load(cnt, __ATOMIC_RELAXED, __HIP_MEMORY_SCOPE_AGENT)) < 32u) { __builtin_amdgcn_s_sleep(2); if (++spins > (1u << 20)) break; }
            __builtin_amdgcn_fence(__ATOMIC_ACQUIRE, "agent");
            asm volatile("s_waitcnt vmcnt(0)" ::: "memory");
        }
        __syncthreads();
        LAS float* rs = (LAS float*)lds;
        { const int t = wid * 64 + lane;
          if (t < 256) { const float* sp = ssq + (size_t)(u.pm * 256 + t) * 16;
            float tot = 0.f;
#pragma unroll
            for (int q = 0; q < 16; ++q) tot += __hip_atomic_load(sp + q, __ATOMIC_RELAXED, __HIP_MEMORY_SCOPE_AGENT);
            rs[t] = rsqrtf(tot * (1.0f / 1024.0f) + 1e-6f); } }
        __syncthreads();
        f32x4 fw[2][2];
#pragma unroll
        for (int bj = 0; bj < 2; ++bj)
#pragma unroll
            for (int n = 0; n < 2; ++n) fw[bj][n] = *(const f32x4*)(fnw + u.pn * 256 + col0 + bj * 128 + 4 * n);
#pragma unroll
        for (int ai = 0; ai < 2; ++ai)
#pragma unroll
            for (int m = 0; m < 4; ++m) { const int rl = wr * 64 + fr + ai * 128 + m * 16; const float r = rs[rl]; float* op = out + (size_t)(u.pm * 256 + rl) * 1024 + u.pn * 256 + col0;
#pragma unroll
                for (int bj = 0; bj < 2; ++bj)
#pragma unroll
                    for (int n = 0; n < 2; ++n) *(f32x4*)(op + bj * 128 + 4 * n) = acc[ai][bj][m][n] * r * fw[bj][n]; }
    }
};

__device__ __forceinline__ void transpose_tile(const float* src, int ld_src, int k0, int c0, bf16_t* dst, int ld_dst, int n0, LAS float* T) {
    const int tid = opaque_tid();
#pragma unroll
    for (int i = 0; i < 2; ++i) { const int r = (tid >> 4) + i * 32, c4 = (tid & 15) * 4;
        const f32x4 v = *(const f32x4*)(src + (size_t)(k0 + r) * ld_src + c0 + c4);
        T[r * 65 + c4] = v[0]; T[r * 65 + c4 + 1] = v[1]; T[r * 65 + c4 + 2] = v[2]; T[r * 65 + c4 + 3] = v[3]; }
    __syncthreads();
    { const int n = tid >> 3, kc = (tid & 7) * 8; float f[8];
#pragma unroll
        for (int j = 0; j < 8; ++j) f[j] = T[(kc + j) * 65 + n];
        u32x4 w; w.x = cvt_pk_bf16(f[0], f[1]); w.y = cvt_pk_bf16(f[2], f[3]); w.z = cvt_pk_bf16(f[4], f[5]); w.w = cvt_pk_bf16(f[6], f[7]);
        *(u32x4*)(dst + (size_t)(n0 + n) * ld_dst + k0 + kc) = w; }
    __syncthreads();
}
__device__ __forceinline__ float wave_sum(float v) {
    v += __shfl_xor(v, 32); v += __shfl_xor(v, 16); v += __shfl_xor(v, 8); v += __shfl_xor(v, 4); v += __shfl_xor(v, 2); v += __shfl_xor(v, 1); return v;
}
__device__ __forceinline__ float log_sigmoid(float x) { return fminf(x, 0.f) - log1pf(expf(-fabsf(x))); }

__device__ void phase0(const Params& p, LAS unsigned char* lds) {
    const int tid = opaque_tid();
    LAS float* T = (LAS float*)lds;
    bf16_t* WinT = (bf16_t*)(p.ws + OFF_AB) + (size_t)18432 * 1024;
    float* modp = (float*)(p.ws + OFF_MODP);
    for (int job = blockIdx.x; job < 256; job += gridDim.x) {
        const int cgp = job & 31, ks = job >> 5;
        LAS float* sl = (LAS float*)lds;
        LAS float* red = sl + 9 * 128;
        for (int i = tid; i < 9 * 128; i += 512) { const int v = i >> 7, kk = i & 127; const float cv = v < 8 ? p.c[v * 1024 + ks * 128 + kk] : p.c_ctx[ks * 128 + kk]; sl[i] = cv / (1.0f + expf(-cv)); }
        __syncthreads();
        const int col = tid % 96, kr = tid / 96;
        float a0 = 0.f, a1 = 0.f, a2 = 0.f, a3 = 0.f, a4 = 0.f, a5 = 0.f, a6 = 0.f, a7 = 0.f, a8 = 0.f;
        if (kr < 5) {
#pragma unroll 1
            for (int k0 = kr; k0 < 128; k0 += 65) { float wv13[13];
#pragma unroll
                for (int q = 0; q < 13; ++q) { const int kk = k0 + 5 * q; wv13[q] = kk < 128 ? p.ada_w[(size_t)(ks * 128 + kk) * 3072 + cgp * 96 + col] : 0.f; }
#pragma unroll
                for (int q = 0; q < 13; ++q) { const int kk = min(k0 + 5 * q, 127); const float wv = wv13[q];
                    a0 += sl[kk] * wv; a1 += sl[128 + kk] * wv; a2 += sl[256 + kk] * wv; a3 += sl[384 + kk] * wv; a4 += sl[512 + kk] * wv; a5 += sl[640 + kk] * wv; a6 += sl[768 + kk] * wv; a7 += sl[896 + kk] * wv; a8 += sl[1024 + kk] * wv; } }
            LAS float* rp = red + (kr * 9) * 96 + col;
            rp[0] = a0; rp[96] = a1; rp[192] = a2; rp[288] = a3; rp[384] = a4; rp[480] = a5; rp[576] = a6; rp[672] = a7; rp[768] = a8;
        }
        __syncthreads();
        for (int i = tid; i < 9 * 96; i += 512) { const int v = i / 96, cc = i % 96; float s = 0.f;
#pragma unroll
            for (int r = 0; r < 5; ++r) s += red[(r * 9 + v) * 96 + cc];
            __hip_atomic_store(&modp[(size_t)(ks * 9 + v) * 3072 + cgp * 96 + cc], s, __ATOMIC_RELAXED, __HIP_MEMORY_SCOPE_AGENT); }
        __syncthreads();
    }
    asm volatile("s_waitcnt vmcnt(0)" ::: "memory");
    __syncthreads();
    if (tid == 0) (void)__hip_atomic_fetch_add((unsigned*)(p.ws + OFF_ACNT), 1u, __ATOMIC_RELAXED, __HIP_MEMORY_SCOPE_AGENT);
    {
        const int r0 = tid >> 4, c4 = (tid & 15) * 4;
        int job = blockIdx.x;
        f32x4 va, vb;
        { const int kt = job & 15, ntile = job >> 4; const int n0 = ntile * 64, k0 = kt * 64; const int c0 = n0 < 5120 ? n0 : n0 + 16;
          va = *(const f32x4*)(p.in_w + (size_t)(k0 + r0) * 8208 + c0 + c4); vb = *(const f32x4*)(p.in_w + (size_t)(k0 + r0 + 32) * 8208 + c0 + c4); }
        for (; job < 2048; job += gridDim.x) {
            const int kt = job & 15, ntile = job >> 4; const int n0 = ntile * 64, k0 = kt * 64;
            T[r0 * 65 + c4] = va[0]; T[r0 * 65 + c4 + 1] = va[1]; T[r0 * 65 + c4 + 2] = va[2]; T[r0 * 65 + c4 + 3] = va[3];
            T[(r0 + 32) * 65 + c4] = vb[0]; T[(r0 + 32) * 65 + c4 + 1] = vb[1]; T[(r0 + 32) * 65 + c4 + 2] = vb[2]; T[(r0 + 32) * 65 + c4 + 3] = vb[3];
            __syncthreads();
            const int nj = job + gridDim.x;
            if (nj < 2048) { const int kt2 = nj & 15, nt2 = nj >> 4; const int n2 = nt2 * 64, k2 = kt2 * 64; const int c2 = n2 < 5120 ? n2 : n2 + 16;
                va = *(const f32x4*)(p.in_w + (size_t)(k2 + r0) * 8208 + c2 + c4); vb = *(const f32x4*)(p.in_w + (size_t)(k2 + r0 + 32) * 8208 + c2 + c4); }
            { const int n = tid >> 3, kc = (tid & 7) * 8; float f[8];
#pragma unroll
              for (int j = 0; j < 8; ++j) f[j] = T[(kc + j) * 65 + n];
              u32x4 w; w.x = cvt_pk_bf16(f[0], f[1]); w.y = cvt_pk_bf16(f[2], f[3]); w.z = cvt_pk_bf16(f[4], f[5]); w.w = cvt_pk_bf16(f[6], f[7]);
              *(u32x4*)(WinT + (size_t)(n0 + n) * 1024 + k0 + kc) = w; }
            __syncthreads();
        }
    }
}

__device__ __forceinline__ float dot4(const f32x4 a, const f32x4 b) { return (a[0] * b[0] + a[1] * b[1]) + (a[2] * b[2] + a[3] * b[3]); }
__device__ __forceinline__ float bfly16(const f32x4 p0, const f32x4 p1, const f32x4 p2, const f32x4 p3, int lane) {
    const bool b3 = lane & 8, b2 = lane & 4, b1 = lane & 2, b0 = lane & 1;
    const f32x4 s0 = b3 ? p0 : p2, s1 = b3 ? p1 : p3, k0 = b3 ? p2 : p0, k1 = b3 ? p3 : p1;
    f32x4 a, c;
    a[0] = k0[0] + __shfl_xor(s0[0], 8); a[1] = k0[1] + __shfl_xor(s0[1], 8); a[2] = k0[2] + __shfl_xor(s0[2], 8); a[3] = k0[3] + __shfl_xor(s0[3], 8);
    c[0] = k1[0] + __shfl_xor(s1[0], 8); c[1] = k1[1] + __shfl_xor(s1[1], 8); c[2] = k1[2] + __shfl_xor(s1[2], 8); c[3] = k1[3] + __shfl_xor(s1[3], 8);
    const f32x4 s4 = b2 ? a : c, k4 = b2 ? c : a;
    const float d0 = k4[0] + __shfl_xor(s4[0], 4), d1 = k4[1] + __shfl_xor(s4[1], 4), d2 = k4[2] + __shfl_xor(s4[2], 4), d3 = k4[3] + __shfl_xor(s4[3], 4);
    const float e0 = (b1 ? d2 : d0) + __shfl_xor(b1 ? d0 : d2, 2), e1 = (b1 ? d3 : d1) + __shfl_xor(b1 ? d1 : d3, 2);
    float q1 = (b0 ? e1 : e0) + __shfl_xor(b0 ? e0 : e1, 1);
    q1 += __shfl_xor(q1, 16); q1 += __shfl_xor(q1, 32);
    return q1;
}
__device__ __forceinline__ void norm_rows2(const f32x4 (&xa)[4], const f32x4 (&xb)[4], const LAS float* gsa, const LAS float* sha, const LAS float* gsb, const LAS float* shb, const LAS float* WgT,
                                           bf16_t* oa, bf16_t* ob, float* ga, float* gb, const float* gate_b, int lane) {
    float ssa = 0.f, ssb = 0.f;
#pragma unroll
    for (int i = 0; i < 4; ++i) { ssa += dot4(xa[i], xa[i]); ssb += dot4(xb[i], xb[i]); }
    ssa = wave_sum(ssa); ssb = wave_sum(ssb);
    const float ra = rsqrtf(ssa * (1.0f / 1024.0f) + 1e-6f), rb = rsqrtf(ssb * (1.0f / 1024.0f) + 1e-6f);
    f32x4 ya[4], yb[4];
#pragma unroll
    for (int i = 0; i < 4; ++i) {
        ya[i] = xa[i] * ra * *(const LAS f32x4*)(gsa + i * 256 + lane * 4) + *(const LAS f32x4*)(sha + i * 256 + lane * 4);
        yb[i] = xb[i] * rb * *(const LAS f32x4*)(gsb + i * 256 + lane * 4) + *(const LAS f32x4*)(shb + i * 256 + lane * 4);
        u32x2 w; w.x = cvt_pk_bf16(ya[i][0], ya[i][1]); w.y = cvt_pk_bf16(ya[i][2], ya[i][3]); *(u32x2*)(oa + i * 256 + lane * 4) = w;
        u32x2 v; v.x = cvt_pk_bf16(yb[i][0], yb[i][1]); v.y = cvt_pk_bf16(yb[i][2], yb[i][3]); *(u32x2*)(ob + i * 256 + lane * 4) = v; }
    f32x4 pa[4], pb[4];
#pragma unroll
    for (int jq = 0; jq < 4; ++jq) { f32x4 sa = (f32x4){0.f, 0.f, 0.f, 0.f}, sb = sa;
#pragma unroll
        for (int i = 0; i < 4; ++i) { const LAS float* wp = WgT + (jq * 4) * 1024 + i * 256 + lane * 4;
            const f32x4 w0 = *(const LAS f32x4*)wp, w1 = *(const LAS f32x4*)(wp + 1024), w2 = *(const LAS f32x4*)(wp + 2048), w3 = *(const LAS f32x4*)(wp + 3072);
            sa += (f32x4){dot4(ya[i], w0), dot4(ya[i], w1), dot4(ya[i], w2), dot4(ya[i], w3)};
            sb += (f32x4){dot4(yb[i], w0), dot4(yb[i], w1), dot4(yb[i], w2), dot4(yb[i], w3)}; }
        pa[jq] = sa; pb[jq] = sb; }
    const float qa = bfly16(pa[0], pa[1], pa[2], pa[3], lane), qb = bfly16(pb[0], pb[1], pb[2], pb[3], lane);
    if (lane < 16) { const float gbv = gate_b[lane]; const bool ls = (lane >> 2) & 1;
        const float prea = qa + gbv, preb = qb + gbv;
        ga[0] = ls ? log_sigmoid(prea) : prea; gb[0] = ls ? log_sigmoid(preb) : preb; }
}
__device__ void phase1(const Params& p, LAS unsigned char* lds) {
    const int tid = opaque_tid(), wid = tid >> 6, lane = tid & 63;
    LAS float* gs = (LAS float*)lds; LAS float* sh = gs + 1024; LAS float* gsc = sh + 1024; LAS float* shc = gsc + 1024; LAS float* WgT = shc + 1024;
    const float* modp = (const float*)(p.ws + OFF_MODP);
    bf16_t* AB = (bf16_t*)(p.ws + OFF_AB);
    if (tid < 64) {
        unsigned spins = 0;
        while ((unsigned)__builtin_amdgcn_readfirstlane(__hip_atomic_load((unsigned*)(p.ws + OFF_ACNT), __ATOMIC_RELAXED, __HIP_MEMORY_SCOPE_AGENT)) < gridDim.x) { __builtin_amdgcn_s_sleep(2); if (++spins > (1u << 22)) break; }
        __builtin_amdgcn_fence(__ATOMIC_ACQUIRE, "agent"); asm volatile("s_waitcnt vmcnt(0)" ::: "memory"); }
    __syncthreads();
    for (int job = blockIdx.x; job < 256; job += gridDim.x) {
        const int b = job >> 5;
        for (int i = tid; i < 1024; i += 512) {
            float s0 = p.ada_b[i], s1 = p.ada_b[1024 + i], s2 = p.ada_b[2048 + i], c0 = s0, c1 = s1;
#pragma unroll
            for (int ks = 0; ks < 8; ++ks) { const float* mp = modp + (size_t)(ks * 9 + b) * 3072; s0 += mp[i]; s1 += mp[1024 + i]; s2 += mp[2048 + i];
                const float* mc = modp + (size_t)(ks * 9 + 8) * 3072; c0 += mc[i]; c1 += mc[1024 + i]; }
            const float nw = p.norm_w[i];
            gs[i] = nw * (1.0f + s1); sh[i] = s0; gsc[i] = nw * (1.0f + c1); shc[i] = c0;
            if ((job & 31) == 0) ((float*)(p.ws + OFF_GATEV))[b * 1024 + i] = s2;
        }
        for (int i = tid; i < 16384; i += 512) { const int j = i & 15, k = i >> 4; WgT[j * 1024 + k] = p.in_w[(size_t)k * 8208 + 5120 + j]; }
        __syncthreads();
        const int crow = job * 8 + wid; const int cb = crow >> 8;
        float* gl = (float*)(p.ws + OFF_GL) + (size_t)b * 16 * 2048 + (size_t)lane * 2048; float* gc = (float*)(p.ws + OFF_GC) + (size_t)cb * 16 * 256 + (size_t)lane * 256 + (crow & 255);
        const int rbase = job * 64 + wid * 8;
#pragma unroll 1
        for (int pr = 0; pr < 5; ++pr) {
            const int ra_ = pr < 4 ? rbase + 2 * pr : rbase + 7;
            const float* xa_ = p.x + (size_t)ra_ * 1024; const float* xb_ = pr < 4 ? xa_ + 1024 : p.ctx + (size_t)crow * 1024;
            f32x4 xa[4], xb[4];
#pragma unroll
            for (int i = 0; i < 4; ++i) { xa[i] = __builtin_nontemporal_load((const f32x4*)(xa_ + i * 256 + lane * 4)); xb[i] = __builtin_nontemporal_load((const f32x4*)(xb_ + i * 256 + lane * 4)); }
            const LAS float* gsb_ = pr < 4 ? gs : gsc; const LAS float* shb_ = pr < 4 ? sh : shc;
            bf16_t* ob_ = pr < 4 ? AB + (size_t)(ra_ + 1) * 1024 : AB + (size_t)(16384 + crow) * 1024;
            float* gb_ = pr < 4 ? gl + ((ra_ + 1) & 2047) : gc;
            norm_rows2(xa, xb, gs, sh, gsb_, shb_, WgT, AB + (size_t)ra_ * 1024, ob_, gl + (ra_ & 2047), gb_, p.gate_b, lane);
        }
        __syncthreads();
    }
}

__device__ __forceinline__ bf16_t* cst_ptr(const Params& p, int sid, int chunk) {
    bf16_t* base = sid < 32 ? (bf16_t*)p.out : (bf16_t*)(p.ws + OFF_CST2);
    return base + ((size_t)((sid & 31) * 16 + chunk)) * 65536;
}
__device__ __forceinline__ void passA_chunk(const Params& p, int st, int b, int h, int dir, int vs, bool& isctx, int& ci, const bf16_t*& Kbase, const bf16_t*& Vbase) {
    isctx = st < 2;
    if (isctx) { ci = dir ? 1 - st : st;
        Kbase = (const bf16_t*)(p.ws + OFF_KC) + (size_t)((b * 2 + ci) * 4 + h) * 32768;
        Vbase = (const bf16_t*)(p.ws + OFF_VTC) + (size_t)(b * 2 + ci) * 131072 + (h * 16 + vs * 4) * 2048; }
    else { const int s2 = st - 2; ci = dir ? 15 - s2 : s2;
        Kbase = (const bf16_t*)(p.ws + OFF_K) + (size_t)((b * 16 + ci) * 4 + h) * 32768;
        Vbase = (const bf16_t*)(p.ws + OFF_VT) + (size_t)(b * 16 + ci) * 131072 + (h * 16 + vs * 4) * 2048; }
}
__device__ void passA(const Params& p, LAS unsigned char* lds, int wg) {
    const int tid = opaque_tid(), wid = tid >> 6, lane = tid & 63, fr = lane & 15, fq = lane >> 4;
    const int sid = wg >> 2, vs = wg & 3; const int b = sid >> 3, h = (sid >> 1) & 3, dir = sid & 1;
    LAS bf16_t* Kt = (LAS bf16_t*)lds;
    LAS bf16_t* Ve = Kt + 256 * 136;
    LAS float* eA = (LAS float*)(lds + 87040);
    LAS float* bendA = eA + 18 * 128; LAS float* maxwA = bendA + 32; LAS float* decayA = maxwA + 32; LAS float* mprevA = decayA + 32; LAS float* mnewA = mprevA + 32;
    LAS bf16_t* eB = (LAS bf16_t*)(mnewA + 32);
    const float* GL = (const float*)(p.ws + OFF_GL); const float* GC = (const float*)(p.ws + OFF_GC);
    for (int st = wid; st < 18; st += 8) {
        const bool isctx = st < 2; const int ci = isctx ? (dir ? 1 - st : st) : (dir ? 15 - (st - 2) : st - 2);
        const int T = isctx ? 256 : 2048; const float* G = isctx ? GC + (size_t)b * 16 * 256 : GL + (size_t)b * 16 * 2048;
        const float* pli = G + (size_t)(dir * 8 + h) * T + ci * 128; const float* plf = G + (size_t)(dir * 8 + 4 + h) * T + ci * 128;
        const int s0 = dir ? 127 - 2 * lane : 2 * lane, s1 = dir ? 126 - 2 * lane : 2 * lane + 1;
        const float lf0 = plf[s0], lf1 = plf[s1], li0 = pli[s0], li1 = pli[s1];
        const float p1 = lf0 + lf1; float inc = p1;
#pragma unroll
        for (int off = 1; off < 64; off <<= 1) { const float n = __shfl_up(inc, off); inc += (lane >= off) ? n : 0.f; }
        const float bend = __shfl(inc, 63);
        const float b0 = inc - p1 + lf0, b1 = inc;
        const float w0 = bend - b0 + li0, w1 = bend - b1 + li1;
        float mx = fmaxf(w0, w1);
#pragma unroll
        for (int off = 32; off > 0; off >>= 1) mx = fmaxf(mx, __shfl_xor(mx, off));
        eA[st * 128 + s0] = w0; eA[st * 128 + s1] = w1;
        if (lane == 0) { bendA[st] = bend; maxwA[st] = mx; }
    }
    __syncthreads();
    if (tid == 0) { float m = -1e30f;
        for (int st = 0; st < 18; ++st) { mprevA[st] = m; const float mn = fmaxf(bendA[st] + m, maxwA[st]); decayA[st] = expf(bendA[st] + m - mn); mnewA[st] = mn; m = mn; } }
    __syncthreads();
    for (int i = tid; i < 18 * 128; i += 512) { const float e = expf(eA[i] - mnewA[i >> 7]); eA[i] = e; eB[i] = (bf16_t)(cvt_pk_bf16(e, 0.f) & 0xffffu); }
    __syncthreads();
    f32x4 nacc[2] = {(f32x4){0.f, 0.f, 0.f, 0.f}, (f32x4){0.f, 0.f, 0.f, 0.f}};
    f32x4 acc[2][4];
#pragma unroll
    for (int a = 0; a < 2; ++a)
#pragma unroll
        for (int v = 0; v < 4; ++v) acc[a][v] = (f32x4){0.f, 0.f, 0.f, 0.f};
    u32x4 vr[2], kr[2][4];
    { bool ic; int ci; const bf16_t* Kb; const bf16_t* Vb; passA_chunk(p, 0, b, h, dir, vs, ic, ci, Kb, Vb);
#pragma unroll
        for (int rep = 0; rep < 2; ++rep) { const int it = tid + rep * 512;
            vr[rep] = *(const u32x4*)(Vb + (size_t)it * 8);
            const int sq = (it & 15) | (((it >> 6) & 1) << 4), ko = ((it >> 4) & 3) | ((it >> 7) << 2); const bf16_t* src = Kb + (size_t)((sq >> 2) * 8 + (ko >> 2)) * 512 + ((sq & 3) * 16 + (ko & 3)) * 8;
            kr[rep][0] = *(const u32x4*)src; kr[rep][1] = *(const u32x4*)(src + 32); kr[rep][2] = *(const u32x4*)(src + 64); kr[rep][3] = *(const u32x4*)(src + 96); } }
    for (int st = 0; st < 18; ++st) {
        bool isctx; int ci; const bf16_t* Kb; const bf16_t* Vb; passA_chunk(p, st, b, h, dir, vs, isctx, ci, Kb, Vb);
        if (!isctx) {
            bf16_t* cs = cst_ptr(p, sid, ci);
#pragma unroll
            for (int vt = 0; vt < 4; ++vt) { u32x4 w; w.x = cvt_pk_bf16(acc[0][vt][0], acc[0][vt][1]); w.y = cvt_pk_bf16(acc[0][vt][2], acc[0][vt][3]);
                w.z = cvt_pk_bf16(acc[1][vt][0], acc[1][vt][1]); w.w = cvt_pk_bf16(acc[1][vt][2], acc[1][vt][3]);
                __builtin_nontemporal_store(w, (u32x4*)(cs + (size_t)((vs * 4 + vt) * 8 + wid) * 512 + (fr * 4 + fq) * 8)); }
            if (vs == 0) { if (fr == 0) { float* np = (float*)(p.ws + OFF_NST) + (size_t)(sid * 16 + ci) * 256 + wid * 32 + fq * 8; *(f32x4*)np = nacc[0]; *(f32x4*)(np + 4) = nacc[1]; }
                if (tid == 0) ((float*)(p.ws + OFF_MST))[sid * 16 + ci] = mprevA[st]; }
        }
        if (st == 17) break;
        const LAS float* e_s = eA + st * 128; const float decay = decayA[st];
#pragma unroll
        for (int rep = 0; rep < 2; ++rep) { const int it = tid + rep * 512; const int v = (it >> 8) * 16 + ((it >> 2) & 15), sg = ((it >> 6) & 3) * 32 + (it & 3) * 8;
            const u32x4 raw = vr[rep];
            u32x4 w; w.x = cvt_pk_bf16(bf_lo(raw.x) * e_s[sg], bf_hi(raw.x) * e_s[sg + 1]); w.y = cvt_pk_bf16(bf_lo(raw.y) * e_s[sg + 2], bf_hi(raw.y) * e_s[sg + 3]);
            w.z = cvt_pk_bf16(bf_lo(raw.z) * e_s[sg + 4], bf_hi(raw.z) * e_s[sg + 5]); w.w = cvt_pk_bf16(bf_lo(raw.w) * e_s[sg + 6], bf_hi(raw.w) * e_s[sg + 7]);
            *(LAS u32x4*)(Ve + v * 136 + sg) = w; }
#pragma unroll
        for (int rep = 0; rep < 2; ++rep) { const int it = tid + rep * 512; const int sq = (it & 15) | (((it >> 6) & 1) << 4), ko = ((it >> 4) & 3) | ((it >> 7) << 2);
            const u32x4 r0 = kr[rep][0], r1 = kr[rep][1], r2 = kr[rep][2], r3 = kr[rep][3];
            LAS bf16_t* dst = Kt + (ko * 8) * 136 + sq * 4;
#define TRW(j, a0, a1, a2, a3, HI) { u32x2 w; if (HI) { w.x = (a0 >> 16) | (a1 & 0xffff0000u); w.y = (a2 >> 16) | (a3 & 0xffff0000u); } else { w.x = (a0 & 0xffffu) | (a1 << 16); w.y = (a2 & 0xffffu) | (a3 << 16); } *(LAS u32x2*)(dst + (j) * 136) = w; }
            TRW(0, r0.x, r1.x, r2.x, r3.x, 0) TRW(1, r0.x, r1.x, r2.x, r3.x, 1) TRW(2, r0.y, r1.y, r2.y, r3.y, 0) TRW(3, r0.y, r1.y, r2.y, r3.y, 1)
            TRW(4, r0.z, r1.z, r2.z, r3.z, 0) TRW(5, r0.z, r1.z, r2.z, r3.z, 1) TRW(6, r0.w, r1.w, r2.w, r3.w, 0) TRW(7, r0.w, r1.w, r2.w, r3.w, 1)
#undef TRW
        }
        __syncthreads();
        if (st + 1 < 17) {
            bool ic2; int ci2; const bf16_t* Kb2; const bf16_t* Vb2; passA_chunk(p, st + 1, b, h, dir, vs, ic2, ci2, Kb2, Vb2);
#pragma unroll
            for (int rep = 0; rep < 2; ++rep) { const int it = tid + rep * 512;
                vr[rep] = *(const u32x4*)(Vb2 + (size_t)it * 8);
                const int sq = (it & 15) | (((it >> 6) & 1) << 4), ko = ((it >> 4) & 3) | ((it >> 7) << 2); const bf16_t* src = Kb2 + (size_t)((sq >> 2) * 8 + (ko >> 2)) * 512 + ((sq & 3) * 16 + (ko & 3)) * 8;
                kr[rep][0] = *(const u32x4*)src; kr[rep][1] = *(const u32x4*)(src + 32); kr[rep][2] = *(const u32x4*)(src + 64); kr[rep][3] = *(const u32x4*)(src + 96); } }
#pragma unroll
        for (int a = 0; a < 2; ++a) { nacc[a] *= decay;
#pragma unroll
            for (int v = 0; v < 4; ++v) acc[a][v] *= decay; }
#pragma unroll
        for (int ks = 0; ks < 4; ++ks) { bf16x8 kf[2], vf[4];
#pragma unroll
            for (int kt = 0; kt < 2; ++kt) kf[kt] = *(const LAS bf16x8*)(Kt + (wid * 32 + 8 * (fr >> 2) + 4 * kt + (fr & 3)) * 136 + ks * 32 + fq * 8);
#pragma unroll
            for (int vt = 0; vt < 4; ++vt) vf[vt] = *(const LAS bf16x8*)(Ve + (vt * 16 + fr) * 136 + ks * 32 + fq * 8);
            bf16x8 ef = *(const LAS bf16x8*)(eB + st * 128 + ks * 32 + fq * 8);
            if (fr != 0) ef = (bf16x8){0, 0, 0, 0, 0, 0, 0, 0};
#pragma unroll
            for (int kt = 0; kt < 2; ++kt) {
#pragma unroll
                for (int vt = 0; vt < 4; ++vt) acc[kt][vt] = __builtin_amdgcn_mfma_f32_16x16x32_bf16(kf[kt], vf[vt], acc[kt][vt], 0, 0, 0);
                nacc[kt] = __builtin_amdgcn_mfma_f32_16x16x32_bf16(kf[kt], ef, nacc[kt], 0, 0, 0); } }
        __syncthreads();
    }
    __syncthreads();
}

__device__ void boxfilter_unit(const Params& p, LAS unsigned char* lds, int u) {
    const int tid = opaque_tid();
    const int b = u >> 6, g = (u >> 4) & 3, cb = u & 15; const int hw = 1 << g;
    LAS float* X = (LAS float*)lds; LAS float* Y = X + 2048 * 8;
    const bf16_t* src = (const bf16_t*)(p.ws + OFF_P) + (size_t)(b * 64 + g * 16 + cb) * 2048 * 8;
    bf16_t* dst = (bf16_t*)(p.ws + OFF_MX) + (size_t)(b * 2048) * 512 + g * 128 + cb * 8;
#pragma unroll
    for (int i = 0; i < 4; ++i) { const int tok = tid + 512 * i; const u32x4 v = *(const u32x4*)(src + (size_t)tok * 8);
        *(LAS f32x4*)(X + tok * 8) = (f32x4){bf_lo(v.x), bf_hi(v.x), bf_lo(v.y), bf_hi(v.y)}; *(LAS f32x4*)(X + tok * 8 + 4) = (f32x4){bf_lo(v.z), bf_hi(v.z), bf_lo(v.w), bf_hi(v.w)}; }
    __syncthreads();
    for (int i = 0; i < 4; ++i) { const int tok = tid + 512 * i; const int r = tok >> 6, c = tok & 63; const int lo = max(r - hw, 0), hi = min(r + hw, 32);
        f32x4 s0 = (f32x4){0.f, 0.f, 0.f, 0.f}, s1 = s0;
        for (int rr = lo; rr < hi; ++rr) { s0 += *(const LAS f32x4*)(X + (rr * 64 + c) * 8); s1 += *(const LAS f32x4*)(X + (rr * 64 + c) * 8 + 4); }
        const float cnt = (float)(hi - lo);
        *(LAS f32x4*)(Y + tok * 8) = s0 / cnt; *(LAS f32x4*)(Y + tok * 8 + 4) = s1 / cnt; }
    __syncthreads();
    for (int i = 0; i < 4; ++i) { const int tok = tid + 512 * i; const int r = tok >> 6, c = tok & 63; const int lo = max(c - hw, 0), hi = min(c + hw, 64);
        f32x4 s0 = (f32x4){0.f, 0.f, 0.f, 0.f}, s1 = s0;
        for (int cc = lo; cc < hi; ++cc) { s0 += *(const LAS f32x4*)(Y + (r * 64 + cc) * 8); s1 += *(const LAS f32x4*)(Y + (r * 64 + cc) * 8 + 4); }
        const float cnt = (float)(hi - lo);
        const f32x4 m0 = s0 / cnt - *(const LAS f32x4*)(X + tok * 8), m1 = s1 / cnt - *(const LAS f32x4*)(X + tok * 8 + 4);
        u32x4 w; w.x = cvt_pk_bf16(m0[0], m0[1]); w.y = cvt_pk_bf16(m0[2], m0[3]); w.z = cvt_pk_bf16(m1[0], m1[1]); w.w = cvt_pk_bf16(m1[2], m1[3]);
        *(u32x4*)(dst + (size_t)tok * 512) = w; }
    __syncthreads();
}

__device__ void passB_unit(const Params& p, LAS unsigned char* lds, int u, bool do_store = true) {
    const int tid = opaque_tid(), wid = tid >> 6, lane = tid & 63, fr = lane & 15, fq = lane >> 4;
    const int b = u >> 6, h = (u >> 4) & 3, c = u & 15;
    const int tokbase = b * 2048 + c * 128;
    LAS bf16_t* Qs = (LAS bf16_t*)lds;
    LAS bf16_t* Pd = Qs + 128 * 264;
    LAS float* fl = (LAS float*)(lds + 137216);
    LAS float* lfA = fl; LAS float* liA = fl + 256; LAS float* aA = fl + 512; LAS float* MA = fl + 768; LAS float* winA = fl + 1024; LAS float* clampA = fl + 1280;
    LAS float* nqA = fl + 1536; LAS float* nvec = fl + 1792; LAS float* rsP = fl + 2304; LAS float* ssP = fl + 3328;
    const float* GL = (const float*)(p.ws + OFF_GL) + (size_t)b * 16 * 2048 + c * 128;
    bf16_t* Qg = (bf16_t*)(p.ws + OFF_Q) + (size_t)((tokbase >> 8) * 4 + h) * 65536 + (c & 1) * 8 * 512;
    const int sid0 = (b * 4 + h) * 2;
    LAS float* wtot = lfA; LAS float* wmax = lfA + 8;
    float sc_b = 0.f, sc_li = 0.f; int sc_t = 0;
    if (tid < 256) { const int d = tid >> 7, i = tid & 127; sc_t = d ? 127 - i : i;
        sc_li = GL[(size_t)(d * 8 + h) * 2048 + sc_t]; float inc = GL[(size_t)(d * 8 + 4 + h) * 2048 + sc_t];
#pragma unroll
        for (int off = 1; off < 64; off <<= 1) { const float n = __shfl_up(inc, off); inc += (lane >= off) ? n : 0.f; }
        sc_b = inc; if (lane == 63) wtot[wid] = inc; }
    { const int d = tid >> 8, k = tid & 255; nvec[tid] = ((const float*)(p.ws + OFF_NST))[(size_t)((sid0 + d) * 16 + c) * 256 + k]; }
#pragma unroll
    for (int i = 0; i < 8; ++i) { const int id = tid + 512 * i; const int w = id >> 9, m = (id >> 7) & 3, bj = (id >> 6) & 1, ln = id & 63;
        *(LAS u32x4*)(Qs + ((w >> 2) * 64 + m * 16 + (ln & 15)) * 264 + bj * 128 + (w & 3) * 32 + (ln >> 4) * 8) = *(const u32x4*)(Qg + (size_t)((w * 16 + m * 2 + bj) * 64 + ln) * 8); }
    __syncthreads();
    float sc_a = 0.f, sc_pm = 0.f;
    if (tid < 256) { if (wid & 1) sc_b += wtot[wid - 1];
        sc_a = sc_li - sc_b; float pm = sc_a;
#pragma unroll
        for (int off = 1; off < 64; off <<= 1) { const float n = __shfl_up(pm, off); pm = (lane >= off) ? fmaxf(pm, n) : pm; }
        sc_pm = pm; if (lane == 63) wmax[wid] = pm; }
    __syncthreads();
    const int wt2 = wid >> 2, w4 = wid & 3;
    const bf16_t* Kg = (const bf16_t*)(p.ws + OFF_K) + (size_t)((b * 16 + c) * 4 + h) * 32768 + (size_t)(w4 * 2 * 8) * 512 + (fr * 4 + fq) * 8;
    bf16x8 kfa[8][2];
#pragma unroll
    for (int ks = 0; ks < 8; ++ks)
#pragma unroll
        for (int nt = 0; nt < 2; ++nt) kfa[ks][nt] = *(const bf16x8*)(Kg + (size_t)(nt * 8 + ks) * 512);
    if (tid < 256) { const int d = tid >> 7, t = sc_t; if (wid & 1) sc_pm = fmaxf(sc_pm, wmax[wid - 1]);
        const float mc = ((const float*)(p.ws + OFF_MST))[(sid0 + d) * 16 + c];
        const float Mt = fmaxf(mc, sc_pm); const int dt = d * 128 + t;
        aA[dt] = sc_a; MA[dt] = Mt; winA[dt] = expf(mc - Mt); clampA[dt] = expf(-(sc_b + Mt));
        float s = 0.f; const LAS float* nv = nvec + d * 256;
#pragma unroll 4
        for (int k8 = 0; k8 < 32; ++k8) { const u32x4 qv = *(const LAS u32x4*)(Qs + t * 264 + k8 * 8); const LAS float* np = nv + k8 * 8;
            s += bf_lo(qv.x) * np[0] + bf_hi(qv.x) * np[1] + bf_lo(qv.y) * np[2] + bf_hi(qv.y) * np[3] + bf_lo(qv.z) * np[4] + bf_hi(qv.z) * np[5] + bf_lo(qv.w) * np[6] + bf_hi(qv.w) * np[7]; }
        nqA[dt] = s; }
    __syncthreads();
    const bf16_t* Cd0 = cst_ptr(p, sid0, c) + (size_t)(w4 * 32) * 512 + (fr * 4 + fq) * 8;
    const bf16_t* Cd1 = cst_ptr(p, sid0 + 1, c) + (size_t)(w4 * 32) * 512 + (fr * 4 + fq) * 8;
    const bf16_t* Vd = (const bf16_t*)(p.ws + OFF_VT) + (size_t)(b * 16 + c) * 131072 + (h * 16 + w4 * 4) * 2048 + (fr * 4 + fq) * 8;
    bf16x8 F[3][4][2];
#define PB_ISSUE(q) do { const int _nh = (q) / 6, _d = ((q) % 6) / 3, _kind = (q) % 3; \
        _Pragma("unroll") for (int ks = 0; ks < 4; ++ks) _Pragma("unroll") for (int n2 = 0; n2 < 2; ++n2) \
            F[(q) % 3][ks][n2] = (_kind < 2) ? __builtin_nontemporal_load((const bf16x8*)((_d ? Cd1 : Cd0) + (size_t)((_nh * 2 + n2) * 8 + _kind * 4 + ks) * 512)) \
                                            : *(const bf16x8*)(Vd + (size_t)((_nh * 2 + n2) * 4 + ks) * 512); } while (0)
    {
        f32x4 sacc[4][2];
#pragma unroll
        for (int mt = 0; mt < 4; ++mt)
#pragma unroll
            for (int nt = 0; nt < 2; ++nt) sacc[mt][nt] = (f32x4){0.f, 0.f, 0.f, 0.f};
#pragma unroll
        for (int ks = 0; ks < 8; ++ks) { bf16x8 qf[4];
#pragma unroll
            for (int mt = 0; mt < 4; ++mt) qf[mt] = *(const LAS bf16x8*)(Qs + (wt2 * 64 + mt * 16 + fr) * 264 + ks * 32 + fq * 8);
#pragma unroll
            for (int mt = 0; mt < 4; ++mt)
#pragma unroll
                for (int nt = 0; nt < 2; ++nt) sacc[mt][nt] = __builtin_amdgcn_mfma_f32_16x16x32_bf16(kfa[ks][nt], qf[mt], sacc[mt][nt], 0, 0, 0); }
        PB_ISSUE(0); PB_ISSUE(1);
        __builtin_amdgcn_sched_barrier(0);
#pragma unroll
        for (int mt = 0; mt < 4; ++mt) { const int t = wt2 * 64 + mt * 16 + fr; const float Mf = MA[t], Mb = MA[128 + t]; float rf = 0.f, rb = 0.f;
#pragma unroll
            for (int nt = 0; nt < 2; ++nt) { const int s0 = w4 * 32 + nt * 16 + fq * 4; float pf[4], pb[4];
#pragma unroll
                for (int r = 0; r < 4; ++r) { const int s = s0 + r; const float val = sacc[mt][nt][r];
                    const float ef = __expf(fminf(aA[s] - Mf, 0.f)), eb = __expf(fminf(aA[128 + s] - Mb, 0.f));
                    pf[r] = (s <= t) ? val * ef : 0.f; pb[r] = (s >= t) ? val * eb : 0.f; rf += pf[r]; rb += pb[r]; }
                u32x2 wf, wb; wf.x = cvt_pk_bf16(pf[0], pf[1]); wf.y = cvt_pk_bf16(pf[2], pf[3]); wb.x = cvt_pk_bf16(pb[0], pb[1]); wb.y = cvt_pk_bf16(pb[2], pb[3]);
                *(LAS u32x2*)(Pd + t * 136 + s0) = wf; *(LAS u32x2*)(Pd + 128 * 136 + t * 136 + s0) = wb; }
            rf += __shfl_xor(rf, 16); rf += __shfl_xor(rf, 32); rb += __shfl_xor(rb, 16); rb += __shfl_xor(rb, 32);
            if (fq == 0) { rsP[w4 * 128 + t] = rf; rsP[512 + w4 * 128 + t] = rb; } }
    }
    __syncthreads();
    LAS float* invA = fl + 3840;
    if (tid < 256) { const int d = tid >> 7, t = tid & 127;
        const float den = winA[tid] * nqA[tid] + ((rsP[d * 512 + t] + rsP[d * 512 + 128 + t]) + (rsP[d * 512 + 256 + t] + rsP[d * 512 + 384 + t]));
        invA[tid] = 1.0f / fmaxf(fabsf(den), clampA[tid]); }
    __syncthreads();
    f32x4 hsum[4][4], acc[4][2];
#pragma unroll
    for (int q = 0; q < 12; ++q) {
        const int nh = q / 6, d = (q % 6) / 3, kind = q % 3;
        if (q + 2 < 12) PB_ISSUE(q + 2);
        __builtin_amdgcn_sched_barrier(0);
        if (kind == 0) {
#pragma unroll
            for (int mt = 0; mt < 4; ++mt)
#pragma unroll
                for (int n2 = 0; n2 < 2; ++n2) { acc[mt][n2] = (f32x4){0.f, 0.f, 0.f, 0.f}; if (d == 0) hsum[mt][nh * 2 + n2] = (f32x4){0.f, 0.f, 0.f, 0.f}; }
        }
        if (kind < 2) {
#pragma unroll
            for (int ks = 0; ks < 4; ++ks) { bf16x8 qf[4];
#pragma unroll
                for (int mt = 0; mt < 4; ++mt) qf[mt] = *(const LAS bf16x8*)(Qs + (wt2 * 64 + mt * 16 + fr) * 264 + (kind * 4 + ks) * 32 + fq * 8);
#pragma unroll
                for (int mt = 0; mt < 4; ++mt)
#pragma unroll
                    for (int n2 = 0; n2 < 2; ++n2) acc[mt][n2] = __builtin_amdgcn_mfma_f32_16x16x32_bf16(F[q % 3][ks][n2], qf[mt], acc[mt][n2], 0, 0, 0); }
        } else {
            const LAS bf16_t* Pp = Pd + d * 128 * 136;
#pragma unroll
            for (int mt = 0; mt < 4; ++mt) { const float wv = winA[d * 128 + wt2 * 64 + mt * 16 + fr];
#pragma unroll
                for (int n2 = 0; n2 < 2; ++n2) acc[mt][n2] *= wv; }
#pragma unroll
            for (int ks = 0; ks < 4; ++ks) { bf16x8 pf[4];
#pragma unroll
                for (int mt = 0; mt < 4; ++mt) pf[mt] = *(const LAS bf16x8*)(Pp + (wt2 * 64 + mt * 16 + fr) * 136 + ks * 32 + fq * 8);
#pragma unroll
                for (int mt = 0; mt < 4; ++mt)
#pragma unroll
                    for (int n2 = 0; n2 < 2; ++n2) acc[mt][n2] = __builtin_amdgcn_mfma_f32_16x16x32_bf16(F[q % 3][ks][n2], pf[mt], acc[mt][n2], 0, 0, 0); }
#pragma unroll
            for (int mt = 0; mt < 4; ++mt) { const float iv = invA[d * 128 + wt2 * 64 + mt * 16 + fr];
#pragma unroll
                for (int n2 = 0; n2 < 2; ++n2) hsum[mt][nh * 2 + n2] += acc[mt][n2] * iv; }
        }
    }
#undef PB_ISSUE
#pragma unroll
    for (int mt = 0; mt < 4; ++mt) { float sv = 0.f;
#pragma unroll
        for (int nt = 0; nt < 4; ++nt) { const f32x4 hv = hsum[mt][nt]; sv += (hv[0] * hv[0] + hv[1] * hv[1]) + (hv[2] * hv[2] + hv[3] * hv[3]); }
        sv += __shfl_xor(sv, 16); sv += __shfl_xor(sv, 32);
        if (fq == 0) ssP[w4 * 128 + wt2 * 64 + mt * 16 + fr] = sv; }
    __syncthreads();
#pragma unroll
    for (int mt = 0; mt < 4; ++mt) { const int t = wt2 * 64 + mt * 16 + fr;
        const float tot = (ssP[t] + ssP[128 + t]) + (ssP[256 + t] + ssP[384 + t]); const float rinv = rsqrtf(tot * (1.0f / 256.0f) + 1e-6f);
#pragma unroll
        for (int nt = 0; nt < 4; ++nt) { const int v = w4 * 64 + nt * 16 + fq * 4; const f32x4 hw = *(const f32x4*)(p.head_norm_w + h * 256 + v);
            const f32x4 o = hsum[mt][nt] * rinv * hw;
            u32x2 w; w.x = cvt_pk_bf16(o[0], o[1]); w.y = cvt_pk_bf16(o[2], o[3]);
            *(LAS u32x2*)(Pd + t * 264 + v) = w; } }
    __syncthreads();
    __builtin_amdgcn_sched_barrier(0);
    if (do_store) {
#pragma unroll 2
        for (int i = 0; i < 8; ++i) { const int id = tid + 512 * i; const int w = id >> 9, m = (id >> 7) & 3, bj = (id >> 6) & 1, ln = id & 63;
            *(u32x4*)(Qg + (size_t)((w * 16 + m * 2 + bj) * 64 + ln) * 8) = *(const LAS u32x4*)(Pd + ((w >> 2) * 64 + m * 16 + (ln & 15)) * 264 + bj * 128 + (w & 3) * 32 + (ln >> 4) * 8); } }
    __syncthreads();
}

__device__ void phase_final(const Params& p) {
    const int tid = opaque_tid(), wid = tid >> 6, lane = tid & 63;
    const float* ssq = (const float*)(p.ws + OFF_SSQ);
    for (int row = blockIdx.x * 8 + wid; row < 16384; row += gridDim.x * 8) {
        const f32x4 s0 = *(const f32x4*)(ssq + (size_t)row * 16), s1 = *(const f32x4*)(ssq + (size_t)row * 16 + 4), s2 = *(const f32x4*)(ssq + (size_t)row * 16 + 8), s3 = *(const f32x4*)(ssq + (size_t)row * 16 + 12);
        const float tot = ((s0[0] + s0[1]) + (s0[2] + s0[3])) + ((s1[0] + s1[1]) + (s1[2] + s1[3])) + ((s2[0] + s2[1]) + (s2[2] + s2[3])) + ((s3[0] + s3[1]) + (s3[2] + s3[3]));
        const float rstd = rsqrtf(tot * (1.0f / 1024.0f) + 1e-6f);
        float* orow = p.out + (size_t)row * 1024;
#pragma unroll
        for (int i = 0; i < 4; ++i) { const f32x4 v = *(const f32x4*)(orow + i * 256 + lane * 4); const f32x4 w = *(const f32x4*)(p.final_norm_w + i * 256 + lane * 4);
            *(f32x4*)(orow + i * 256 + lane * 4) = v * rstd * w; }
    }
}


#define XB_TMO      128
#define XB_XCNT(j)  (256  + 64 * (j))
#define XB_XSUB(j)  (1280 + 64 * (j))
#define XB_XGEN(j)  (2304 + 64 * (j))
#define XB_TOP      3328
#define XB_TOPGEN   3392
#define XCD_BAR_WORDS 3456
#define XB_SPIN_CAP (1u << 18)
__device__ __forceinline__ unsigned xb_ld(unsigned* p)              { return __hip_atomic_load(p, __ATOMIC_RELAXED, __HIP_MEMORY_SCOPE_AGENT); }
__device__ __forceinline__ unsigned xb_add(unsigned* p, unsigned v) { return __hip_atomic_fetch_add(p, v, __ATOMIC_RELAXED, __HIP_MEMORY_SCOPE_AGENT); }
__device__ __forceinline__ unsigned xb_xcc_id() { return (unsigned)__builtin_amdgcn_s_getreg((3 << 11) | 20) & 0xFu; }
#define XB_SPIN(cond, bar) do { unsigned _sp = 0; while (cond) { __builtin_amdgcn_s_sleep(1); \
    if ((++_sp & 255u) == 0u) { if (xb_ld(&(bar)[XB_TMO])) break; if (_sp > XB_SPIN_CAP) { atomicAdd(&(bar)[XB_TMO], 1u); break; } } } } while (0)
struct XcdBarrier { unsigned* bar; unsigned x; volatile LAS unsigned* st; };
__device__ __forceinline__ XcdBarrier xcd_barrier_post(unsigned* bar, volatile LAS unsigned* st) {
    XcdBarrier b; b.bar = bar; b.x = xb_xcc_id(); b.st = st;
    if (threadIdx.x == 0) (void)xb_add(&bar[XB_XCNT(b.x)], 1u);
    return b;
}
__device__ __forceinline__ void xcd_barrier_complete(unsigned* bar, unsigned x, unsigned& nloc, unsigned& nx) {
    const unsigned G = gridDim.x * gridDim.y * gridDim.z;
    unsigned sum, cnt, mine, sp = 0u;
    for (;;) {
        sum = 0u; cnt = 0u; mine = 0u;
#pragma unroll
        for (unsigned j = 0; j < 16; ++j) { const unsigned c = xb_ld(&bar[XB_XCNT(j)]); sum += c; cnt += (c > 0u) ? 1u : 0u; mine = (j == x) ? c : mine; }
        if (sum == G) break;
        __builtin_amdgcn_s_sleep(1);
        if ((++sp & 255u) == 0u) { if (xb_ld(&bar[XB_TMO])) break; if (sp > XB_SPIN_CAP) { atomicAdd(&bar[XB_TMO], 1u); break; } }
    }
    nloc = mine > 0u ? mine : 1u; nx = cnt > 0u ? cnt : 1u;
}
__device__ __forceinline__ void xcd_barrier(const XcdBarrier& b) {
    asm volatile("s_waitcnt vmcnt(0)" ::: "memory");
    __syncthreads();
    if (threadIdx.x == 0) {
        unsigned* bar = b.bar;
        __builtin_amdgcn_s_waitcnt(0);
        unsigned nloc = b.st[0], nx = b.st[1];
        if (nloc == 0u) { xcd_barrier_complete(bar, b.x, nloc, nx); b.st[0] = nloc; b.st[1] = nx; }
        const unsigned old = xb_add(&bar[XB_XSUB(b.x)], 1u);
        const unsigned gen = old / nloc;
        if (old + 1u == (gen + 1u) * nloc) {
            __builtin_amdgcn_fence(__ATOMIC_RELEASE, "agent");
            asm volatile("s_waitcnt vmcnt(0)" ::: "memory");
            const unsigned og = xb_add(&bar[XB_TOP], 1u);
            const unsigned tg = og / nx;
            if (og + 1u == (tg + 1u) * nx) xb_add(&bar[XB_TOPGEN], 1u);
            else XB_SPIN(xb_ld(&bar[XB_TOPGEN]) == tg, bar);
            __builtin_amdgcn_fence(__ATOMIC_ACQUIRE, "agent");
            xb_add(&bar[XB_XGEN(b.x)], 1u);
            asm volatile("s_waitcnt vmcnt(0)" ::: "memory");
        } else {
            XB_SPIN(xb_ld(&bar[XB_XGEN(b.x)]) == gen, bar);
            __builtin_amdgcn_fence(__ATOMIC_ACQUIRE, "agent");
            asm volatile("s_waitcnt vmcnt(0)" ::: "memory");
        }
    }
    __syncthreads();
}

__device__ __forceinline__ void run_phase(const Params& p, LAS unsigned char* lds, int ph) {
    const int tid = opaque_tid();
    const bf16_t* AB = (const bf16_t*)(p.ws + OFF_AB);
    switch (ph) {
    case 0: phase0(p, lds); break;
    case 1: phase1(p, lds); break;
    case 2: { SchedG1 S{(int)blockIdx.x}; EpiG1 E{p.ws}; pg8::gemm_phase(lds, pg8::Gemm{AB, AB, 1024}, S, E); } break;
    case 3: {
        { const int c3 = blockIdx.x, xcd = c3 & 7, sl = c3 >> 3;
          passA(p, lds, (xcd * 8 + (sl >> 2)) * 4 + (sl & 3));
          const int G = (sl >> 2) * 8 + xcd, mem = sl & 3;
          boxfilter_unit(p, lds, G * 4 + mem); boxfilter_unit(p, lds, (127 - G) * 4 + mem); }
        bf16_t* bt = (bf16_t*)(p.ws + OFF_BTPOOL);
        for (int idx = blockIdx.x * 512 + tid; idx < 512 * 512; idx += NWG * 512) { const int n = idx >> 9, k = idx & 511; const int gn = n >> 7, gk = k >> 7;
            const float v = (gn == gk) ? p.pool_w[(size_t)(gn * 128 + (k & 127)) * 128 + (n & 127)] : 0.f;
            bt[idx] = (bf16_t)(cvt_pk_bf16(v, 0.f) & 0xffffu); }
    } break;
    case 4: {
        const int c4 = blockIdx.x, pmt = (c4 & 7) * 8 + (c4 >> 5), j = (c4 >> 3) & 3;
        unsigned* flags = (unsigned*)(p.ws + OFF_PFLAG);
        if (j < 2) {
            Sched64 S{c4, 2}; EpiPool E{p.ws, p.pool_scale};
            pg8::gemm_phase(lds, pg8::Gemm{(const bf16_t*)(p.ws + OFF_MX), (const bf16_t*)(p.ws + OFF_BTPOOL), 512}, S, E);
            asm volatile("s_waitcnt vmcnt(0)" ::: "memory");
            __syncthreads();
            if (threadIdx.x == 0) { __builtin_amdgcn_fence(__ATOMIC_RELEASE, "agent"); asm volatile("s_waitcnt vmcnt(0)" ::: "memory");
                __hip_atomic_store(flags + 64 * (pmt * 2 + j), 1u, __ATOMIC_RELAXED, __HIP_MEMORY_SCOPE_AGENT); }
        }
        passB_unit(p, lds, c4 * 2); passB_unit(p, lds, c4 * 2 + 1);
        if (j < 2) {
            LAS float* T = (LAS float*)lds; const int w128 = pmt * 2 + j;
            for (int job = w128; job < 640; job += 128) {
                if (job < 256) { const int kt = job & 15, ntile = job >> 4; transpose_tile(p.branch_m_w, 1024, kt * 64, ntile * 64, (bf16_t*)(p.ws + OFF_WMT), 1024, ntile * 64, T); }
                else if (job < 512) { const int j2 = job - 256; const int kt = j2 & 15, ntile = j2 >> 4; transpose_tile(p.out_w, 1024, kt * 64, ntile * 64, (bf16_t*)(p.ws + OFF_WOT), 1024, ntile * 64, T); }
                else { const int j2 = job - 512; const int kt = j2 & 7, ntile = j2 >> 3; transpose_tile(p.branch_p_w, 1024, kt * 64, ntile * 64, (bf16_t*)(p.ws + OFF_WPT), 512, ntile * 64, T); }
            }
        }
        if (j >= 2) {
            if (threadIdx.x < 64) { unsigned spins = 0;
                while ((unsigned)__builtin_amdgcn_readfirstlane(__hip_atomic_load(flags + 64 * (pmt * 2 + j - 2), __ATOMIC_RELAXED, __HIP_MEMORY_SCOPE_AGENT)) == 0u) { __builtin_amdgcn_s_sleep(2); if (++spins > (1u << 22)) break; }
                __builtin_amdgcn_fence(__ATOMIC_ACQUIRE, "agent"); asm volatile("s_waitcnt vmcnt(0)" ::: "memory"); }
            __syncthreads();
            SchedOne S{pmt, 72 + 22 + (j - 2)}; EpiG2 E{p.ws, (bf16_t*)p.out};
            pg8::gemm_phase(lds, pg8::Gemm{AB, AB, 1024}, S, E);
        }
    } break;
    case 5: {
        SchedG2 S{(int)blockIdx.x}; EpiG2 E{p.ws, (bf16_t*)p.out}; pg8::gemm_phase(lds, pg8::Gemm{AB, AB, 1024}, S, E);
    } break;
    case 6: {
        Sched64 S{(int)blockIdx.x, 4};
        f32x4 macc[2][2][4][2];
        { EpiMergeMid E{p.ws}; pg8::gemm_phase_acc<EpiMergeMid, Sched64, true>(lds, pg8::Gemm{(const bf16_t*)(p.ws + OFF_PM), (const bf16_t*)(p.ws + OFF_WPT), 512}, S, E, macc); }
        { EpiMergeFin E{p.ws}; pg8::gemm_phase_acc<EpiMergeFin, Sched64, false>(lds, pg8::Gemm{(const bf16_t*)p.out, (const bf16_t*)(p.ws + OFF_WMT), 1024}, S, E, macc); }
    } break;
    case 7: { Sched64 S{(int)blockIdx.x, 4}; EpiOut E{p.ws, p.x, p.out, p.final_norm_w}; pg8::gemm_phase(lds, pg8::Gemm{(const bf16_t*)(p.ws + OFF_MG), (const bf16_t*)(p.ws + OFF_WOT), 1024}, S, E); } break;
    case 8: phase_final(p); break;
    default: break;
    }
}
#if MULTI_LAUNCH
template <int PH> __global__ void __launch_bounds__(512, 2) k_one(Params p) {
    extern __shared__ __attribute__((aligned(16))) unsigned char shm[];
    run_phase(p, (LAS unsigned char*)shm, PH);
}
#else
__global__ void __launch_bounds__(512, 2) fwd_megakernel(Params p) {
    extern __shared__ __attribute__((aligned(16))) unsigned char shm[];
    LAS unsigned char* lds = (LAS unsigned char*)shm;
    cg::grid_group grid = cg::this_grid();
    volatile LAS unsigned* xbst = (volatile LAS unsigned*)(lds + LDS_BYTES - 16);
    if (threadIdx.x == 0) { xbst[0] = 0u; xbst[1] = 0u; }
    __syncthreads();
    const XcdBarrier xb = xcd_barrier_post((unsigned*)(p.ws + OFF_BAR), xbst);
    if (p.ph_lo == 0x7fffffff) grid.sync();
    run_phase(p, lds, 0);
    run_phase(p, lds, 1); xcd_barrier(xb);
    run_phase(p, lds, 2); xcd_barrier(xb);
#ifdef PROBE_G1
    run_phase(p, lds, 2); xcd_barrier(xb);
#endif
    run_phase(p, lds, 3); xcd_barrier(xb);
#ifdef PROBE_A
    passA(p, lds, blockIdx.x); xcd_barrier(xb);
#endif
#ifdef PROBE_BOX
    boxfilter_unit(p, lds, blockIdx.x); boxfilter_unit(p, lds, 511 - blockIdx.x); xcd_barrier(xb);
#endif
    run_phase(p, lds, 4); xcd_barrier(xb);
    run_phase(p, lds, 5); xcd_barrier(xb);
    run_phase(p, lds, 6); xcd_barrier(xb);
    run_phase(p, lds, 7);
}
#endif

extern "C" void kernel_launch(void* const* d_in, const int* in_sizes, int n_in, void* d_out, int out_size, void* d_ws, size_t ws_size, hipStream_t stream) {
#if MULTI_LAUNCH
#define SETATTR(PH) (void)hipFuncSetAttribute((const void*)k_one<PH>, hipFuncAttributeMaxDynamicSharedMemorySize, LDS_BYTES)
    static int configured = 0;
    if (!configured) { SETATTR(0); SETATTR(1); SETATTR(2); SETATTR(3); SETATTR(4); SETATTR(5); SETATTR(6); SETATTR(7); SETATTR(8); configured = 1; }
#else
    static int configured = 0;
    if (!configured) {
        (void)hipFuncSetAttribute((const void*)fwd_megakernel, hipFuncAttributeMaxDynamicSharedMemorySize, LDS_BYTES);
        int dev = 0, cus = 0, per_cu = 0;
        (void)hipGetDevice(&dev); (void)hipDeviceGetAttribute(&cus, hipDeviceAttributeMultiprocessorCount, dev);
        (void)hipOccupancyMaxActiveBlocksPerMultiprocessor(&per_cu, fwd_megakernel, 512, LDS_BYTES);
        if (cus * per_cu < NWG) fprintf(stderr, "grid %d exceeds resident capacity %d x %d\n", NWG, cus, per_cu);
        if (ws_size < 256 * MiB) fprintf(stderr, "workspace too small: %zu\n", ws_size);
        configured = 1;
    }
#endif
    Params p{};
    p.x = (const float*)d_in[0]; p.c = (const float*)d_in[1]; p.ctx = (const float*)d_in[2]; p.c_ctx = (const float*)d_in[3]; p.norm_w = (const float*)d_in[4];
    p.ada_w = (const float*)d_in[5]; p.ada_b = (const float*)d_in[6]; p.in_w = (const float*)d_in[7]; p.gate_b = (const float*)d_in[8]; p.head_norm_w = (const float*)d_in[9];
    p.pool_w = (const float*)d_in[10]; p.pool_scale = (const float*)d_in[11]; p.branch_m_w = (const float*)d_in[12]; p.branch_p_w = (const float*)d_in[13]; p.out_w = (const float*)d_in[14];
    p.final_norm_w = (const float*)d_in[15];
    p.out = (float*)d_out; p.ws = (unsigned char*)d_ws;
#if MULTI_LAUNCH
    (void)hipMemsetAsync((unsigned char*)d_ws + OFF_BAR, 0, 65536, stream);
#define LAUNCH(PH) hipLaunchKernelGGL(k_one<PH>, dim3(NWG), dim3(512), LDS_BYTES, stream, p)
    LAUNCH(0); LAUNCH(1); LAUNCH(2); LAUNCH(3); LAUNCH(4); LAUNCH(5); LAUNCH(6); LAUNCH(7);
#else
    p.ph_lo = 0; p.ph_hi = 8;
    (void)hipMemsetAsync((unsigned char*)d_ws + OFF_BAR, 0, 65536, stream);
    void* args[] = {&p};
    hipError_t e = hipLaunchCooperativeKernel((const void*)fwd_megakernel, dim3(NWG), dim3(512), args, LDS_BYTES, stream);
    if (e != hipSuccess) fprintf(stderr, "cooperative launch failed: %s\n", hipGetErrorString(e));
#endif
}
```

```cpp
#include <hip/hip_runtime.h>
#include <hip/hip_cooperative_groups.h>
#include <cstdio>
namespace cg = cooperative_groups;

#ifndef MULTI_LAUNCH
#define MULTI_LAUNCH 0
#endif

#define LAS __attribute__((address_space(3)))
typedef unsigned short bf16_t;
typedef short bf16x8 __attribute__((ext_vector_type(8)));
typedef float f32x4 __attribute__((ext_vector_type(4)));
typedef unsigned u32x4 __attribute__((ext_vector_type(4)));
typedef unsigned u32x2 __attribute__((ext_vector_type(2)));

constexpr size_t MiB = 1024u * 1024u;
constexpr int LDS_BYTES = 155648;
constexpr int NWG = 256;
constexpr size_t OFF_AB = 0;
constexpr size_t OFF_BTPOOL = 32 * MiB;
constexpr size_t OFF_Q = 52 * MiB;
constexpr size_t OFF_K = 84 * MiB;
constexpr size_t OFF_VT = 116 * MiB;
constexpr size_t OFF_KC = 148 * MiB;
constexpr size_t OFF_VTC = 152 * MiB;
constexpr size_t OFF_P = 156 * MiB;
constexpr size_t OFF_PM = 148 * MiB;
constexpr size_t OFF_MX = 172 * MiB;
constexpr size_t OFF_CST2 = 188 * MiB;
constexpr size_t OFF_GB = 188 * MiB;
constexpr size_t OFF_WMT = 36 * MiB, OFF_WPT = 38 * MiB, OFF_WOT = 39 * MiB;
constexpr size_t OFF_MG = 116 * MiB;
constexpr size_t OFF_SMALL = 252 * MiB;
constexpr size_t OFF_GL = OFF_SMALL;
constexpr size_t OFF_SSQ = OFF_SMALL;
constexpr size_t OFF_GC = OFF_SMALL + 1 * MiB;
constexpr size_t OFF_NST = OFF_SMALL + 1 * MiB + 128 * 1024;
constexpr size_t OFF_MST = OFF_NST + 1 * MiB;
constexpr size_t OFF_MODP = OFF_MST + 4096;
constexpr size_t OFF_GATEV = OFF_MODP + 8 * 9 * 3072 * 4;
constexpr size_t OFF_PCNT = OFF_SMALL + 3 * MiB + 512 * 1024 + 16384;
constexpr size_t OFF_PFLAG = OFF_SMALL + 3 * MiB + 512 * 1024 + 32768;
constexpr size_t OFF_ACNT = OFF_SMALL + 3 * MiB + 512 * 1024 + 15360;
constexpr size_t OFF_BAR = OFF_SMALL + 3 * MiB + 512 * 1024;

struct Params {
    const float *x, *c, *ctx, *c_ctx, *norm_w, *ada_w, *ada_b, *in_w, *gate_b, *head_norm_w, *pool_w, *pool_scale, *branch_m_w, *branch_p_w, *out_w, *final_norm_w;
    float* out; unsigned char* ws;
    int ph_lo, ph_hi;
};

__device__ __forceinline__ int opaque_tid() { int t = (int)threadIdx.x; asm volatile("" : "+v"(t)); return t; }
__device__ __forceinline__ float bf_lo(unsigned w) { return __uint_as_float(w << 16); }
__device__ __forceinline__ float bf_hi(unsigned w) { return __uint_as_float(w & 0xffff0000u); }
__device__ __forceinline__ unsigned cvt_pk_bf16(float lo, float hi) { unsigned r; asm volatile("v_cvt_pk_bf16_f32 %0, %1, %2" : "=v"(r) : "v"(lo), "v"(hi)); return r; }
__device__ __forceinline__ float sigm(float x) { return __builtin_amdgcn_rcpf(1.0f + __expf(-x)); }
__device__ __forceinline__ float siluf(float x) { return x * __builtin_amdgcn_rcpf(1.0f + __expf(-x)); }

namespace pg8 {
constexpr int BM = 256, BK = 64, HALF = 128, HTB = HALF * BK * 2, STAGE_BYTES = 8 * HTB;
__device__ __forceinline__ int lds_byte(int r, int c) { const int st = (r >> 4) * 2 + (c >> 5), rr = r & 15, cc = c & 31, ob = rr * 64 + cc * 2; return st * 1024 + (ob ^ (((ob >> 9) & 1) << 5)); }
__device__ __forceinline__ void stage_rc(int b, int& R, int& C) { const int st = b / 1024, sb = b % 1024, swz = sb ^ (((sb >> 9) & 1) << 5); R = (st >> 1) * 16 + swz / 64; C = (st & 1) * 32 + (swz % 64) / 2; }
__device__ __forceinline__ int perm32(int rho) { const int n = rho >> 4, i = rho & 15; return 8 * (i >> 2) + 4 * n + (i & 3); }
struct Unit { int pm, pn; };
struct Gemm { const bf16_t* A; const bf16_t* Bt; int K; };

template <class Epi, class Sched, bool ZERO>
__device__ __forceinline__ void gemm_phase_acc(LAS unsigned char* lds, const Gemm g, const Sched& S, const Epi& E, f32x4 (&acc)[2][2][4][2]) {
    const int tid = opaque_tid(), wid = __builtin_amdgcn_readfirstlane(tid >> 6), lane = tid & 63, wr = wid >> 2, wc = wid & 3, fr = lane & 15, fq = lane >> 4;
    const int K = g.K, nt = K / BK;
    unsigned voffA[2], voffB[2];
#pragma unroll
    for (int i = 0; i < 2; ++i) { int R, C; stage_rc(tid * 16 + i * 8192, R, C); const int Rb = (R & ~31) + perm32(R & 31);
        voffA[i] = (unsigned)(R * K + C) * 2u; voffB[i] = (unsigned)(Rb * K + C) * 2u; }
    const size_t kstep = (size_t)(BK * 2);
    const size_t hstep = (size_t)HALF * K * 2;
    const size_t tstep = 2 * hstep;
    const unsigned ldsw = (unsigned)wid * 1024u;
    const int aoff = lds_byte(wr * 64 + fr, fq * 8), boff = lds_byte(wc * 32 + fr, fq * 8);
#define PG8_SA(b, h) (((b) * 2 + (h)) * HTB)
#define PG8_SB(b, h) ((4 + (b) * 2 + (h)) * HTB)
#define PG8_STAGE(bufoff, gbase, voff) do { _Pragma("unroll") for (int _i = 0; _i < 2; ++_i) \
        __builtin_amdgcn_global_load_lds((const unsigned*)((const char*)(gbase) + (voff)[_i]), (LAS unsigned*)(lds + (bufoff) + ldsw + _i * 8192), 16, 0, 0); } while (0)
#define PG8_LDA(dst, b, h) do { _Pragma("unroll") for (int m = 0; m < 4; ++m) _Pragma("unroll") for (int k = 0; k < 2; ++k) dst[m][k] = *(const LAS bf16x8*)(lds + PG8_SA(b, h) + aoff + m * 2048 + k * 1024); } while (0)
#define PG8_LDB(dst, b, h) do { _Pragma("unroll") for (int n = 0; n < 2; ++n) _Pragma("unroll") for (int k = 0; k < 2; ++k) dst[n][k] = *(const LAS bf16x8*)(lds + PG8_SB(b, h) + boff + n * 2048 + k * 1024); } while (0)
#define PG8_MMA(ai, bj, At, Bt) do { __builtin_amdgcn_s_setprio(1); _Pragma("unroll") for (int m = 0; m < 4; ++m) _Pragma("unroll") for (int n = 0; n < 2; ++n) _Pragma("unroll") for (int k = 0; k < 2; ++k) \
        acc[ai][bj][m][n] = __builtin_amdgcn_mfma_f32_16x16x32_bf16(Bt[n][k], At[m][k], acc[ai][bj][m][n], 0, 0, 0); __builtin_amdgcn_s_setprio(0); } while (0)
#define PG8_WAIT_V(n) asm volatile("s_waitcnt vmcnt(" #n ")" ::: "memory")
#define PG8_WAIT_L(n) asm volatile("s_waitcnt lgkmcnt(" #n ")" ::: "memory")
#define PG8_BAR __builtin_amdgcn_s_barrier()
#define PG8_SCHED __builtin_amdgcn_sched_barrier(0)
    Unit cur, nxt; int ui = 0;
    if (!S.next(0, cur)) return;
    if constexpr (ZERO) {
#pragma unroll
    for (int a = 0; a < 2; ++a)
#pragma unroll
        for (int b = 0; b < 2; ++b)
#pragma unroll
            for (int m = 0; m < 4; ++m)
#pragma unroll
                for (int n = 0; n < 2; ++n) acc[a][b][m][n] = (f32x4){0.f, 0.f, 0.f, 0.f};
    }
    bf16x8 At[4][2], B0[2][2], B1[2][2];
    const char* cA = (const char*)g.A + (size_t)cur.pm * tstep; const char* cB = (const char*)g.Bt + (size_t)cur.pn * tstep;
    PG8_STAGE(PG8_SB(0, 0), cB, voffB); PG8_STAGE(PG8_SA(0, 0), cA, voffA); PG8_STAGE(PG8_SB(0, 1), cB + hstep, voffB); PG8_STAGE(PG8_SA(0, 1), cA + hstep, voffA);
    if (wr == 1) PG8_BAR;
    PG8_WAIT_V(4); PG8_BAR;
    PG8_STAGE(PG8_SB(1, 0), cB + kstep, voffB); PG8_STAGE(PG8_SA(1, 0), cA + kstep, voffA); PG8_STAGE(PG8_SB(1, 1), cB + hstep + kstep, voffB);
    PG8_WAIT_V(6); PG8_BAR;
    for (;;) {
        const bool has_next = S.next(ui + 1, nxt);
        const char* nA = has_next ? (const char*)g.A + (size_t)nxt.pm * tstep : cA; const char* nB = has_next ? (const char*)g.Bt + (size_t)nxt.pn * tstep : cB;
        for (int t = 0; t < nt; t += 2) {
            const bool last = (t == nt - 2);
            const char* a1 = cA + (size_t)(t + 1) * kstep;
            const char* a2 = last ? nA : cA + (size_t)(t + 2) * kstep; const char* b2 = last ? nB : cB + (size_t)(t + 2) * kstep;
            const char* a3 = a2 + kstep; const char* b3 = b2 + kstep;
            PG8_LDB(B0, 0, 0); PG8_SCHED; PG8_LDA(At, 0, 0); PG8_STAGE(PG8_SA(1, 1), a1 + hstep, voffA);
            PG8_WAIT_L(8); PG8_BAR; PG8_WAIT_L(0); PG8_MMA(0, 0, At, B0); PG8_BAR; PG8_SCHED;
            PG8_LDB(B1, 0, 1); PG8_STAGE(PG8_SB(0, 0), b2, voffB);
            PG8_BAR; PG8_WAIT_L(0); PG8_MMA(0, 1, At, B1); PG8_BAR;
            PG8_LDA(At, 0, 1); PG8_STAGE(PG8_SA(0, 0), a2, voffA);
            PG8_BAR; PG8_WAIT_L(0); PG8_MMA(1, 0, At, B0); PG8_BAR; PG8_SCHED;
            PG8_STAGE(PG8_SB(0, 1), b2 + hstep, voffB);
            PG8_WAIT_V(6); PG8_BAR; PG8_MMA(1, 1, At, B1); PG8_BAR;
            PG8_LDB(B0, 1, 0); PG8_SCHED; PG8_LDA(At, 1, 0); PG8_STAGE(PG8_SA(0, 1), a2 + hstep, voffA);
            PG8_WAIT_L(8); PG8_BAR; PG8_WAIT_L(0); PG8_MMA(0, 0, At, B0); PG8_BAR; PG8_SCHED;
            PG8_LDB(B1, 1, 1); PG8_STAGE(PG8_SB(1, 0), b3, voffB);
            PG8_BAR; PG8_WAIT_L(0); PG8_MMA(0, 1, At, B1); PG8_BAR;
            PG8_LDA(At, 1, 1); PG8_STAGE(PG8_SA(1, 0), a3, voffA);
            PG8_BAR; PG8_WAIT_L(0); PG8_MMA(1, 0, At, B0); PG8_BAR; PG8_SCHED;
            PG8_STAGE(PG8_SB(1, 1), b3 + hstep, voffB);
            PG8_WAIT_V(6); PG8_BAR; PG8_MMA(1, 1, At, B1); PG8_BAR;
        }
        if constexpr (!Epi::AFTER_DRAIN) E(acc, cur, wr, wc, fr, fq);
        if constexpr (Epi::DRAIN) __builtin_amdgcn_s_waitcnt(0x0F70);
        if (!has_next) break;
#pragma unroll
        for (int a = 0; a < 2; ++a)
#pragma unroll
            for (int b = 0; b < 2; ++b)
#pragma unroll
                for (int m = 0; m < 4; ++m)
#pragma unroll
                    for (int n = 0; n < 2; ++n) acc[a][b][m][n] = (f32x4){0.f, 0.f, 0.f, 0.f};
        cur = nxt; cA = nA; cB = nB; ++ui;
    }
    PG8_WAIT_V(0);
    if (wr == 0) PG8_BAR;
    PG8_BAR;
    if constexpr (Epi::AFTER_DRAIN) E.fused(acc, cur, wr, wc, fr, fq, lds);
#undef PG8_SA
#undef PG8_SB
#undef PG8_STAGE
#undef PG8_LDA
#undef PG8_LDB
#undef PG8_MMA
#undef PG8_WAIT_V
#undef PG8_WAIT_L
#undef PG8_BAR
#undef PG8_SCHED
}
template <class Epi, class Sched>
__device__ __forceinline__ void gemm_phase(LAS unsigned char* lds, const Gemm g, const Sched& S, const Epi& E) {
    f32x4 acc[2][2][4][2];
    gemm_phase_acc<Epi, Sched, true>(lds, g, S, E, acc);
}
}
using pg8::Unit;

struct SchedG1 {
    int c;
    __device__ __forceinline__ bool next(int i, Unit& u) const {
        const int xcd = c & 7, slot = c >> 3, pmt = xcd * 8 + (slot >> 2), j = slot & 3;
        if (i < 2) { u.pm = pmt; u.pn = 72 + i * 4 + j; return true; }
        if (i == 2) { u.pm = 72 + 8 + j; u.pn = pmt; return true; }
        if (i == 3) {
            if (j < 2) { u.pm = pmt; u.pn = 72 + 20 + j; return true; }
            if (j == 2) { int cu = pmt;
                if (cu < 32) { u.pm = 64 + (cu >> 2); u.pn = 72 + 4 + (cu & 3); }
                else { cu -= 32; u.pm = 72 + 8 + (cu & 3); u.pn = 64 + (cu >> 2); }
                return true; }
        }
        return false;
    }
};
struct SchedG2 {
    int c;
    __device__ __forceinline__ bool next(int i, Unit& u) const {
        const int xcd = c & 7, slot = c >> 3, pmt = xcd * 8 + (slot >> 2), j = slot & 3;
        u.pm = pmt;
        if (i == 0) { u.pn = 72 + 12 + j; return true; }
        if (i == 1) { u.pn = 72 + 16 + j; return true; }
        if (i == 2) { u.pn = 72 + 24 + j; return true; }
        if (i == 3) { u.pn = 72 + 28 + j; return true; }
        return false;
    }
};
struct SchedOne {
    int pm, pn;
    __device__ __forceinline__ bool next(int i, Unit& u) const { if (i == 0) { u.pm = pm; u.pn = pn; return true; } return false; }
};
struct Sched64 {
    int c, ncol;
    __device__ __forceinline__ bool next(int i, Unit& u) const {
        const int xcd = c & 7, slot = c >> 3, pmt = xcd * 8 + (slot >> 2), j = slot & 3;
        if (i == 0 && j < ncol) { u.pm = pmt; u.pn = j; return true; }
        return false;
    }
};

struct EpiG1 {
    static constexpr bool AFTER_DRAIN = false;
    static constexpr bool DRAIN = false;
    unsigned char* ws;
    __device__ __forceinline__ void operator()(const f32x4 (&acc)[2][2][4][2], const Unit& u, int wr, int wc, int fr, int fq) const {
        const bool sw = u.pm >= 72;
        const int tokt = sw ? u.pn : u.pm, wt = (sw ? u.pm : u.pn) - 72;
        bf16_t* base; int ld; float sc = 1.0f; int rowbase;
        if (!sw) {
            rowbase = tokt * 256;
            if (wt < 4) { base = (bf16_t*)(ws + OFF_Q) + (size_t)(tokt * 4 + wt) * 65536 + ((wr * 4 + wc) * 16 * 64 + (fq * 16 + fr)) * 8; ld = 0; }
            else if (wt < 8) { sc = 0.0625f; ld = 0;
                if (tokt < 64) base = (bf16_t*)(ws + OFF_K) + (size_t)((tokt * 2) * 4 + (wt - 4)) * 32768;
                else base = (bf16_t*)(ws + OFF_KC) + (size_t)(((tokt - 64) * 2) * 4 + (wt - 4)) * 32768; }
            else { base = (bf16_t*)(ws + OFF_P); ld = 0; }
        } else {
            rowbase = (wt - 8) * 256;
            if (tokt < 64) base = (bf16_t*)(ws + OFF_VT) + (size_t)(tokt * 2) * 1024 * 128;
            else base = (bf16_t*)(ws + OFF_VTC) + (size_t)((tokt - 64) * 2) * 1024 * 128;
            ld = 128;
        }
        const int row0 = rowbase + wr * 64 + fr, col0 = wc * 32 + 8 * fq;
        const size_t bjstep = sw ? (size_t)1024 * 128 : (wt >= 20 ? (size_t)16 * 2048 * 8 : (wt >= 4 && wt < 8 ? (size_t)4 * 512 : (wt < 4 ? (size_t)512 : (size_t)128)));
#pragma unroll
        for (int ai = 0; ai < 2; ++ai)
#pragma unroll
            for (int m = 0; m < 4; ++m) {
                const bool isp = !sw && wt >= 20, isk = !sw && wt >= 4 && wt < 8, isq = !sw && wt < 4;
                bf16_t* rowp = sw ? base + (size_t)((((rowbase + wr * 64 + ai * 128 + m * 16) >> 4) * 4 + wc) * 512 + (fr * 4 + fq) * 8)
                             : isq ? base + ((ai * 4 + m) * 2) * 512
                             : isk ? base + (size_t)(ai * 4 * 64 + (wr * 4 + m) * 8 + wc) * 512 + (fr * 4 + fq) * 8
                             : isp ? base + ((size_t)((tokt >> 3) * 64 + (wt - 20) * 32 + wc * 4 + fq) * 2048 + ((row0 + ai * 128 + m * 16) & 2047)) * 8
                                   : base + (size_t)(row0 + ai * 128 + m * 16) * ld + col0;
#pragma unroll
                for (int bj = 0; bj < 2; ++bj) { const f32x4 v0 = acc[ai][bj][m][0] * sc, v1 = acc[ai][bj][m][1] * sc;
                    u32x4 w; w.x = cvt_pk_bf16(v0[0], v0[1]); w.y = cvt_pk_bf16(v0[2], v0[3]); w.z = cvt_pk_bf16(v1[0], v1[1]); w.w = cvt_pk_bf16(v1[2], v1[3]);
                    *(u32x4*)(rowp + bj * bjstep) = w; } }
    }
};
struct EpiG2 {
    static constexpr bool AFTER_DRAIN = false;
    static constexpr bool DRAIN = true;
    unsigned char* ws; bf16_t* am;
    __device__ __forceinline__ void operator()(const f32x4 (&acc)[2][2][4][2], const Unit& u, int wr, int wc, int fr, int fq) const {
        const int wt = u.pn - 72;
        const int gl_off = ((wr * 4 + wc) * 16 * 64 + (fq * 16 + fr)) * 8;
        const int row0 = u.pm * 256 + wr * 64 + fr, col0 = wc * 32 + 8 * fq;
        const bf16_t* ldp = nullptr; bf16_t* stp; bool ld_lm = false, st_lm = false, act_silu = false, recip = false; int ld = 0;
        if (wt < 16) { bf16_t* t = (bf16_t*)(ws + OFF_Q) + (size_t)(u.pm * 4 + (wt - 12)) * 65536 + gl_off; ldp = t; stp = t; ld_lm = st_lm = true; }
        else if (wt < 20) { ldp = (const bf16_t*)(ws + OFF_Q) + (size_t)(u.pm * 4 + (wt - 16)) * 65536 + gl_off; ld_lm = true; stp = am + (wt - 16) * 256; ld = 1024; act_silu = true; }
        else if (wt < 24) { bf16_t* t = (bf16_t*)(ws + OFF_PM) + (wt - 22) * 256; ldp = t; stp = t; ld = 512; act_silu = true; }
        else if (wt < 28) { stp = (bf16_t*)(ws + OFF_GB) + (size_t)(u.pm * 8 + (wt - 24)) * 65536 + gl_off; st_lm = true; }
        else { bf16_t* t = (bf16_t*)(ws + OFF_GB) + (size_t)(u.pm * 8 + (wt - 24)) * 65536 + gl_off; stp = t; st_lm = true; ldp = t - 4 * 65536; ld_lm = true; recip = true; }
#pragma unroll
        for (int ai = 0; ai < 2; ++ai) {
            u32x4 old8[4][2];
            if (ldp) {
#pragma unroll
                for (int m = 0; m < 4; ++m)
#pragma unroll
                    for (int bj = 0; bj < 2; ++bj) old8[m][bj] = ld_lm ? *(const u32x4*)(ldp + ((ai * 4 + m) * 2 + bj) * 512)
                                                                       : *(const u32x4*)(ldp + (size_t)(row0 + ai * 128 + m * 16) * ld + col0 + bj * 128);
            }
#pragma unroll
            for (int m = 0; m < 4; ++m)
#pragma unroll
                for (int bj = 0; bj < 2; ++bj) { const f32x4 a0 = acc[ai][bj][m][0], a1 = acc[ai][bj][m][1];
                    float f[8];
#pragma unroll
                    for (int q = 0; q < 4; ++q) { f[q] = act_silu ? siluf(a0[q]) : sigm(a0[q]); f[4 + q] = act_silu ? siluf(a1[q]) : sigm(a1[q]); }
                    if (ldp) { const u32x4 o = old8[m][bj];
                        if (recip) { f[0] *= __builtin_amdgcn_rcpf(bf_lo(o.x)); f[1] *= __builtin_amdgcn_rcpf(bf_hi(o.x)); f[2] *= __builtin_amdgcn_rcpf(bf_lo(o.y)); f[3] *= __builtin_amdgcn_rcpf(bf_hi(o.y));
                            f[4] *= __builtin_amdgcn_rcpf(bf_lo(o.z)); f[5] *= __builtin_amdgcn_rcpf(bf_hi(o.z)); f[6] *= __builtin_amdgcn_rcpf(bf_lo(o.w)); f[7] *= __builtin_amdgcn_rcpf(bf_hi(o.w)); }
                        else { f[0] *= bf_lo(o.x); f[1] *= bf_hi(o.x); f[2] *= bf_lo(o.y); f[3] *= bf_hi(o.y); f[4] *= bf_lo(o.z); f[5] *= bf_hi(o.z); f[6] *= bf_lo(o.w); f[7] *= bf_hi(o.w); } }
                    u32x4 w; w.x = cvt_pk_bf16(f[0], f[1]); w.y = cvt_pk_bf16(f[2], f[3]); w.z = cvt_pk_bf16(f[4], f[5]); w.w = cvt_pk_bf16(f[6], f[7]);
                    if (st_lm) { if (recip) __builtin_nontemporal_store(w, (u32x4*)(stp + ((ai * 4 + m) * 2 + bj) * 512)); else *(u32x4*)(stp + ((ai * 4 + m) * 2 + bj) * 512) = w; }
                    else *(u32x4*)(stp + (size_t)(row0 + ai * 128 + m * 16) * ld + col0 + bj * 128) = w; } }
    }
};
struct EpiPool {
    static constexpr bool AFTER_DRAIN = false;
    static constexpr bool DRAIN = false;
    unsigned char* ws; const float* pool_scale;
    __device__ __forceinline__ void operator()(const f32x4 (&acc)[2][2][4][2], const Unit& u, int wr, int wc, int fr, int fq) const {
        bf16_t* base = (bf16_t*)(ws + OFF_PM) + u.pn * 256;
        const int row0 = u.pm * 256 + wr * 64 + fr, col0 = wc * 32 + 8 * fq;
        f32x4 s[2][2];
#pragma unroll
        for (int bj = 0; bj < 2; ++bj)
#pragma unroll
            for (int n = 0; n < 2; ++n) s[bj][n] = *(const f32x4*)(pool_scale + u.pn * 256 + col0 + bj * 128 + 4 * n);
#pragma unroll
        for (int ai = 0; ai < 2; ++ai)
#pragma unroll
            for (int m = 0; m < 4; ++m) { bf16_t* rowp = base + (size_t)(row0 + ai * 128 + m * 16) * 512 + col0;
#pragma unroll
                for (int bj = 0; bj < 2; ++bj) { const f32x4 v0 = acc[ai][bj][m][0] * s[bj][0], v1 = acc[ai][bj][m][1] * s[bj][1];
                    u32x4 w; w.x = cvt_pk_bf16(v0[0], v0[1]); w.y = cvt_pk_bf16(v0[2], v0[3]); w.z = cvt_pk_bf16(v1[0], v1[1]); w.w = cvt_pk_bf16(v1[2], v1[3]);
                    *(u32x4*)(rowp + bj * 128) = w; } }
    }
};
struct EpiMergeMid {
    static constexpr bool AFTER_DRAIN = false;
    static constexpr bool DRAIN = false;
    unsigned char* ws;
    __device__ __forceinline__ void operator()(f32x4 (&acc)[2][2][4][2], const Unit& u, int wr, int wc, int fr, int fq) const {
        const bf16_t* gr = (const bf16_t*)(ws + OFF_GB) + (size_t)(u.pm * 8 + 4 + u.pn) * 65536 + ((wr * 4 + wc) * 16 * 64 + (fq * 16 + fr)) * 8;
        const int row0 = u.pm * 256 + wr * 64 + fr, col0 = wc * 32 + 8 * fq;
#pragma unroll
        for (int ai = 0; ai < 2; ++ai) {
            u32x4 g8[4][2];
#pragma unroll
            for (int m = 0; m < 4; ++m)
#pragma unroll
                for (int bj = 0; bj < 2; ++bj) g8[m][bj] = __builtin_nontemporal_load((const u32x4*)(gr + ((ai * 4 + m) * 2 + bj) * 512));
#pragma unroll
            for (int m = 0; m < 4; ++m)
#pragma unroll
                for (int bj = 0; bj < 2; ++bj) { const u32x4 g = g8[m][bj];
                    acc[ai][bj][m][0] *= (f32x4){bf_lo(g.x), bf_hi(g.x), bf_lo(g.y), bf_hi(g.y)}; acc[ai][bj][m][1] *= (f32x4){bf_lo(g.z), bf_hi(g.z), bf_lo(g.w), bf_hi(g.w)}; } }
    }
};
struct EpiMergeFin {
    static constexpr bool AFTER_DRAIN = false;
    static constexpr bool DRAIN = false;
    unsigned char* ws;
    __device__ __forceinline__ void operator()(f32x4 (&acc)[2][2][4][2], const Unit& u, int wr, int wc, int fr, int fq) const {
        asm volatile("" : "+v"(fr), "+v"(fq));
        const bf16_t* gb = (const bf16_t*)(ws + OFF_GB) + (size_t)(u.pm * 8 + u.pn) * 65536 + ((wr * 4 + wc) * 16 * 64 + (fq * 16 + fr)) * 8;
        bf16_t* mg = (bf16_t*)(ws + OFF_MG) + u.pn * 256;
        const int row0 = u.pm * 256 + wr * 64 + fr, col0 = wc * 32 + 8 * fq;
#pragma unroll
        for (int ai = 0; ai < 2; ++ai) {
            u32x4 g8[4][2];
#pragma unroll
            for (int m = 0; m < 4; ++m)
#pragma unroll
                for (int bj = 0; bj < 2; ++bj) g8[m][bj] = *(const u32x4*)(gb + ((ai * 4 + m) * 2 + bj) * 512);
#pragma unroll
            for (int m = 0; m < 4; ++m) { const size_t row = (size_t)(row0 + ai * 128 + m * 16);
#pragma unroll
                for (int bj = 0; bj < 2; ++bj) { const u32x4 g = g8[m][bj]; const f32x4 a0 = acc[ai][bj][m][0], a1 = acc[ai][bj][m][1];
                    u32x4 w; w.x = cvt_pk_bf16(a0[0] * bf_lo(g.x), a0[1] * bf_hi(g.x)); w.y = cvt_pk_bf16(a0[2] * bf_lo(g.y), a0[3] * bf_hi(g.y));
                    w.z = cvt_pk_bf16(a1[0] * bf_lo(g.z), a1[1] * bf_hi(g.z)); w.w = cvt_pk_bf16(a1[2] * bf_lo(g.w), a1[3] * bf_hi(g.w));
                    *(u32x4*)(mg + row * 1024 + col0 + bj * 128) = w; } } }
    }
};
struct EpiOut {
    static constexpr bool DRAIN = false;
    static constexpr bool AFTER_DRAIN = true;
    unsigned char* ws; const float* x; float* out; const float* fnw;
    __device__ __forceinline__ void operator()(f32x4 (&acc)[2][2][4][2], const Unit& u, int wr, int wc, int fr, int fq) const {}
    __device__ __forceinline__ void fused(f32x4 (&acc)[2][2][4][2], const Unit& u, int wr, int wc, int fr, int fq, LAS unsigned char* lds) const {
        const int b = u.pm >> 3;
        const float* gv = (const float*)(ws + OFF_GATEV) + b * 1024 + u.pn * 256;
        float* ssq = (float*)(ws + OFF_SSQ);
        unsigned* cnt = (unsigned*)(ws + OFF_PCNT) + 64 * u.pm;
        const int row0 = u.pm * 256 + wr * 64 + fr, col0 = wc * 32 + 8 * fq;
        f32x4 gg[2][2];
#pragma unroll
        for (int bj = 0; bj < 2; ++bj)
#pragma unroll
            for (int n = 0; n < 2; ++n) gg[bj][n] = *(const f32x4*)(gv + col0 + bj * 128 + 4 * n);
        f32x4 xb[2][2][2][2];
#define EO_LOAD(k) do { _Pragma("unroll") for (int m2 = 0; m2 < 2; ++m2) _Pragma("unroll") for (int bj = 0; bj < 2; ++bj) _Pragma("unroll") for (int n = 0; n < 2; ++n) \
            xb[(k) & 1][m2][bj][n] = __builtin_nontemporal_load((const f32x4*)(x + (size_t)(row0 + ((k) >> 1) * 128 + (((k) & 1) * 2 + m2) * 16) * 1024 + u.pn * 256 + col0 + bj * 128 + 4 * n)); } while (0)
        EO_LOAD(0);
#pragma unroll
        for (int k = 0; k < 4; ++k) { const int ai = k >> 1;
            if (k + 1 < 4) EO_LOAD(k + 1);
#pragma unroll
            for (int m2 = 0; m2 < 2; ++m2) { const int m = (k & 1) * 2 + m2; const size_t row = (size_t)(row0 + ai * 128 + m * 16); float s = 0.f;
#pragma unroll
                for (int bj = 0; bj < 2; ++bj)
#pragma unroll
                    for (int n = 0; n < 2; ++n) { const f32x4 o = xb[k & 1][m2][bj][n] + gg[bj][n] * acc[ai][bj][m][n];
                        acc[ai][bj][m][n] = o; s += (o[0] * o[0] + o[1] * o[1]) + (o[2] * o[2] + o[3] * o[3]); }
                s += __shfl_xor(s, 16); s += __shfl_xor(s, 32);
                if (fq == 0) __hip_atomic_store(ssq + row * 16 + u.pn * 4 + wc, s, __ATOMIC_RELAXED, __HIP_MEMORY_SCOPE_AGENT); } }
#undef EO_LOAD
        asm volatile("s_waitcnt vmcnt(0)" ::: "memory");
        const int lane = fr + 16 * fq, wid = wr * 4 + wc;
        if (lane == 0) __hip_atomic_fetch_add(cnt, 1u, __ATOMIC_RELAXED, __HIP_MEMORY_SCOPE_AGENT);
        if (wid == 0) {
            unsigned spins = 0;
            while ((unsigned)__builtin_amdgcn_readfirstlane(__hip_atomic_load(cnt, __ATOMIC_RELAXED, __HIP_MEMORY_SCOPE_AGENT)) < 32u) { __builtin_amdgcn_s_sleep(2); if (++spins > (1u << 20)) break; }
            __builtin_amdgcn_fence(__ATOMIC_ACQUIRE, "agent");
            asm volatile("s_waitcnt vmcnt(0)" ::: "memory");
        }
        __syncthreads();
        LAS float* rs = (LAS float*)lds;
        { const int t = wid * 64 + lane;
          if (t < 256) { const float* sp = ssq + (size_t)(u.pm * 256 + t) * 16;
            float tot = 0.f;
#pragma unroll
            for (int q = 0; q < 16; ++q) tot += __hip_atomic_load(sp + q, __ATOMIC_RELAXED, __HIP_MEMORY_SCOPE_AGENT);
            rs[t] = rsqrtf(tot * (1.0f / 1024.0f) + 1e-6f); } }
        __syncthreads();
        f32x4 fw[2][2];
#pragma unroll
        for (int bj = 0; bj < 2; ++bj)
#pragma unroll
            for (int n = 0; n < 2; ++n) fw[bj][n] = *(const f32x4*)(fnw + u.pn * 256 + col0 + bj * 128 + 4 * n);
#pragma unroll
        for (int ai = 0; ai < 2; ++ai)
#pragma unroll
            for (int m = 0; m < 4; ++m) { const int rl = wr * 64 + fr + ai * 128 + m * 16; const float r = rs[rl]; float* op = out + (size_t)(u.pm * 256 + rl) * 1024 + u.pn * 256 + col0;
#pragma unroll
                for (int bj = 0; bj < 2; ++bj)
#pragma unroll
                    for (int n = 0; n < 2; ++n) *(f32x4*)(op + bj * 128 + 4 * n) = acc[ai][bj][m][n] * r * fw[bj][n]; }
    }
};

__device__ __forceinline__ void transpose_tile(const float* src, int ld_src, int k0, int c0, bf16_t* dst, int ld_dst, int n0, LAS float* T) {
    const int tid = opaque_tid();
#pragma unroll
    for (int i = 0; i < 2; ++i) { const int r = (tid >> 4) + i * 32, c4 = (tid & 15) * 4;
        const f32x4 v = __builtin_nontemporal_load((const f32x4*)(src + (size_t)(k0 + r) * ld_src + c0 + c4));
        T[r * 65 + c4] = v[0]; T[r * 65 + c4 + 1] = v[1]; T[r * 65 + c4 + 2] = v[2]; T[r * 65 + c4 + 3] = v[3]; }
    __syncthreads();
    { const int n = tid >> 3, kc = (tid & 7) * 8; float f[8];
#pragma unroll
        for (int j = 0; j < 8; ++j) f[j] = T[(kc + j) * 65 + n];
        u32x4 w; w.x = cvt_pk_bf16(f[0], f[1]); w.y = cvt_pk_bf16(f[2], f[3]); w.z = cvt_pk_bf16(f[4], f[5]); w.w = cvt_pk_bf16(f[6], f[7]);
        *(u32x4*)(dst + (size_t)(n0 + n) * ld_dst + k0 + kc) = w; }
    __syncthreads();
}
__device__ __forceinline__ float wave_sum(float v) {
    v += __shfl_xor(v, 32); v += __shfl_xor(v, 16); v += __shfl_xor(v, 8); v += __shfl_xor(v, 4); v += __shfl_xor(v, 2); v += __shfl_xor(v, 1); return v;
}
__device__ __forceinline__ float log_sigmoid(float x) { return fminf(x, 0.f) - log1pf(expf(-fabsf(x))); }

__device__ void phase0(const Params& p, LAS unsigned char* lds) {
    const int tid = opaque_tid();
    LAS float* T = (LAS float*)lds;
    bf16_t* WinT = (bf16_t*)(p.ws + OFF_AB) + (size_t)18432 * 1024;
    float* modp = (float*)(p.ws + OFF_MODP);
    for (int job = blockIdx.x; job < 256; job += gridDim.x) {
        const int cgp = job & 31, ks = job >> 5;
        LAS float* sl = (LAS float*)lds;
        LAS float* red = sl + 9 * 128;
        for (int i = tid; i < 9 * 128; i += 512) { const int v = i >> 7, kk = i & 127; const float cv = v < 8 ? p.c[v * 1024 + ks * 128 + kk] : p.c_ctx[ks * 128 + kk]; sl[i] = cv / (1.0f + expf(-cv)); }
        __syncthreads();
        const int col = tid % 96, kr = tid / 96;
        float a0 = 0.f, a1 = 0.f, a2 = 0.f, a3 = 0.f, a4 = 0.f, a5 = 0.f, a6 = 0.f, a7 = 0.f, a8 = 0.f;
        if (kr < 5) {
#pragma unroll 1
            for (int k0 = kr; k0 < 128; k0 += 65) { float wv13[13];
#pragma unroll
                for (int q = 0; q < 13; ++q) { const int kk = k0 + 5 * q; wv13[q] = kk < 128 ? __builtin_nontemporal_load(p.ada_w + (size_t)(ks * 128 + kk) * 3072 + cgp * 96 + col) : 0.f; }
#pragma unroll
                for (int q = 0; q < 13; ++q) { const int kk = min(k0 + 5 * q, 127); const float wv = wv13[q];
                    a0 += sl[kk] * wv; a1 += sl[128 + kk] * wv; a2 += sl[256 + kk] * wv; a3 += sl[384 + kk] * wv; a4 += sl[512 + kk] * wv; a5 += sl[640 + kk] * wv; a6 += sl[768 + kk] * wv; a7 += sl[896 + kk] * wv; a8 += sl[1024 + kk] * wv; } }
            LAS float* rp = red + (kr * 9) * 96 + col;
            rp[0] = a0; rp[96] = a1; rp[192] = a2; rp[288] = a3; rp[384] = a4; rp[480] = a5; rp[576] = a6; rp[672] = a7; rp[768] = a8;
        }
        __syncthreads();
        for (int i = tid; i < 9 * 96; i += 512) { const int v = i / 96, cc = i % 96; float s = 0.f;
#pragma unroll
            for (int r = 0; r < 5; ++r) s += red[(r * 9 + v) * 96 + cc];
            __hip_atomic_store(&modp[(size_t)(ks * 9 + v) * 3072 + cgp * 96 + cc], s, __ATOMIC_RELAXED, __HIP_MEMORY_SCOPE_AGENT); }
        __syncthreads();
    }
    asm volatile("s_waitcnt vmcnt(0)" ::: "memory");
    __syncthreads();
    if (tid == 0) (void)__hip_atomic_fetch_add((unsigned*)(p.ws + OFF_ACNT), 1u, __ATOMIC_RELAXED, __HIP_MEMORY_SCOPE_AGENT);
    {
        const int r0 = tid >> 4, c4 = (tid & 15) * 4;
        int job = blockIdx.x;
        f32x4 va, vb;
        { const int kt = job & 15, ntile = job >> 4; const int n0 = ntile * 64, k0 = kt * 64; const int c0 = n0 < 5120 ? n0 : n0 + 16;
          va = __builtin_nontemporal_load((const f32x4*)(p.in_w + (size_t)(k0 + r0) * 8208 + c0 + c4)); vb = __builtin_nontemporal_load((const f32x4*)(p.in_w + (size_t)(k0 + r0 + 32) * 8208 + c0 + c4)); }
        for (; job < 2048; job += gridDim.x) {
            const int kt = job & 15, ntile = job >> 4; const int n0 = ntile * 64, k0 = kt * 64;
            T[r0 * 65 + c4] = va[0]; T[r0 * 65 + c4 + 1] = va[1]; T[r0 * 65 + c4 + 2] = va[2]; T[r0 * 65 + c4 + 3] = va[3];
            T[(r0 + 32) * 65 + c4] = vb[0]; T[(r0 + 32) * 65 + c4 + 1] = vb[1]; T[(r0 + 32) * 65 + c4 + 2] = vb[2]; T[(r0 + 32) * 65 + c4 + 3] = vb[3];
            __syncthreads();
            const int nj = job + gridDim.x;
            if (nj < 2048) { const int kt2 = nj & 15, nt2 = nj >> 4; const int n2 = nt2 * 64, k2 = kt2 * 64; const int c2 = n2 < 5120 ? n2 : n2 + 16;
                va = __builtin_nontemporal_load((const f32x4*)(p.in_w + (size_t)(k2 + r0) * 8208 + c2 + c4)); vb = __builtin_nontemporal_load((const f32x4*)(p.in_w + (size_t)(k2 + r0 + 32) * 8208 + c2 + c4)); }
            { const int n = tid >> 3, kc = (tid & 7) * 8; float f[8];
#pragma unroll
              for (int j = 0; j < 8; ++j) f[j] = T[(kc + j) * 65 + n];
              u32x4 w; w.x = cvt_pk_bf16(f[0], f[1]); w.y = cvt_pk_bf16(f[2], f[3]); w.z = cvt_pk_bf16(f[4], f[5]); w.w = cvt_pk_bf16(f[6], f[7]);
              *(u32x4*)(WinT + (size_t)(n0 + n) * 1024 + k0 + kc) = w; }
            __syncthreads();
        }
    }
}

__device__ __forceinline__ float dot4(const f32x4 a, const f32x4 b) { return (a[0] * b[0] + a[1] * b[1]) + (a[2] * b[2] + a[3] * b[3]); }
__device__ __forceinline__ float bfly16(const f32x4 p0, const f32x4 p1, const f32x4 p2, const f32x4 p3, int lane) {
    const bool b3 = lane & 8, b2 = lane & 4, b1 = lane & 2, b0 = lane & 1;
    const f32x4 s0 = b3 ? p0 : p2, s1 = b3 ? p1 : p3, k0 = b3 ? p2 : p0, k1 = b3 ? p3 : p1;
    f32x4 a, c;
    a[0] = k0[0] + __shfl_xor(s0[0], 8); a[1] = k0[1] + __shfl_xor(s0[1], 8); a[2] = k0[2] + __shfl_xor(s0[2], 8); a[3] = k0[3] + __shfl_xor(s0[3], 8);
    c[0] = k1[0] + __shfl_xor(s1[0], 8); c[1] = k1[1] + __shfl_xor(s1[1], 8); c[2] = k1[2] + __shfl_xor(s1[2], 8); c[3] = k1[3] + __shfl_xor(s1[3], 8);
    const f32x4 s4 = b2 ? a : c, k4 = b2 ? c : a;
    const float d0 = k4[0] + __shfl_xor(s4[0], 4), d1 = k4[1] + __shfl_xor(s4[1], 4), d2 = k4[2] + __shfl_xor(s4[2], 4), d3 = k4[3] + __shfl_xor(s4[3], 4);
    const float e0 = (b1 ? d2 : d0) + __shfl_xor(b1 ? d0 : d2, 2), e1 = (b1 ? d3 : d1) + __shfl_xor(b1 ? d1 : d3, 2);
    float q1 = (b0 ? e1 : e0) + __shfl_xor(b0 ? e0 : e1, 1);
    q1 += __shfl_xor(q1, 16); q1 += __shfl_xor(q1, 32);
    return q1;
}
__device__ __forceinline__ void norm_rows2(const f32x4 (&xa)[4], const f32x4 (&xb)[4], const LAS float* gsa, const LAS float* sha, const LAS float* gsb, const LAS float* shb, const LAS float* WgT,
                                           bf16_t* oa, bf16_t* ob, float* ga, float* gb, const float* gate_b, int lane) {
    float ssa = 0.f, ssb = 0.f;
#pragma unroll
    for (int i = 0; i < 4; ++i) { ssa += dot4(xa[i], xa[i]); ssb += dot4(xb[i], xb[i]); }
    ssa = wave_sum(ssa); ssb = wave_sum(ssb);
    const float ra = rsqrtf(ssa * (1.0f / 1024.0f) + 1e-6f), rb = rsqrtf(ssb * (1.0f / 1024.0f) + 1e-6f);
    f32x4 ya[4], yb[4];
#pragma unroll
    for (int i = 0; i < 4; ++i) {
        ya[i] = xa[i] * ra * *(const LAS f32x4*)(gsa + i * 256 + lane * 4) + *(const LAS f32x4*)(sha + i * 256 + lane * 4);
        yb[i] = xb[i] * rb * *(const LAS f32x4*)(gsb + i * 256 + lane * 4) + *(const LAS f32x4*)(shb + i * 256 + lane * 4);
        u32x2 w; w.x = cvt_pk_bf16(ya[i][0], ya[i][1]); w.y = cvt_pk_bf16(ya[i][2], ya[i][3]); *(u32x2*)(oa + i * 256 + lane * 4) = w;
        u32x2 v; v.x = cvt_pk_bf16(yb[i][0], yb[i][1]); v.y = cvt_pk_bf16(yb[i][2], yb[i][3]); *(u32x2*)(ob + i * 256 + lane * 4) = v; }
    f32x4 pa[4], pb[4];
#pragma unroll
    for (int jq = 0; jq < 4; ++jq) { f32x4 sa = (f32x4){0.f, 0.f, 0.f, 0.f}, sb = sa;
#pragma unroll
        for (int i = 0; i < 4; ++i) { const LAS float* wp = WgT + (jq * 4) * 1024 + i * 256 + lane * 4;
            const f32x4 w0 = *(const LAS f32x4*)wp, w1 = *(const LAS f32x4*)(wp + 1024), w2 = *(const LAS f32x4*)(wp + 2048), w3 = *(const LAS f32x4*)(wp + 3072);
            sa += (f32x4){dot4(ya[i], w0), dot4(ya[i], w1), dot4(ya[i], w2), dot4(ya[i], w3)};
            sb += (f32x4){dot4(yb[i], w0), dot4(yb[i], w1), dot4(yb[i], w2), dot4(yb[i], w3)}; }
        pa[jq] = sa; pb[jq] = sb; }
    const float qa = bfly16(pa[0], pa[1], pa[2], pa[3], lane), qb = bfly16(pb[0], pb[1], pb[2], pb[3], lane);
    if (lane < 16) { const float gbv = gate_b[lane]; const bool ls = (lane >> 2) & 1;
        const float prea = qa + gbv, preb = qb + gbv;
        ga[0] = ls ? log_sigmoid(prea) : prea; gb[0] = ls ? log_sigmoid(preb) : preb; }
}
__device__ void phase1(const Params& p, LAS unsigned char* lds) {
    const int tid = opaque_tid(), wid = tid >> 6, lane = tid & 63;
    LAS float* gs = (LAS float*)lds; LAS float* sh = gs + 1024; LAS float* gsc = sh + 1024; LAS float* shc = gsc + 1024; LAS float* WgT = shc + 1024;
    const float* modp = (const float*)(p.ws + OFF_MODP);
    bf16_t* AB = (bf16_t*)(p.ws + OFF_AB);
    if (tid < 64) {
        unsigned spins = 0;
        while ((unsigned)__builtin_amdgcn_readfirstlane(__hip_atomic_load((unsigned*)(p.ws + OFF_ACNT), __ATOMIC_RELAXED, __HIP_MEMORY_SCOPE_AGENT)) < gridDim.x) { __builtin_amdgcn_s_sleep(2); if (++spins > (1u << 22)) break; }
        __builtin_amdgcn_fence(__ATOMIC_ACQUIRE, "agent"); asm volatile("s_waitcnt vmcnt(0)" ::: "memory"); }
    __syncthreads();
    for (int job = blockIdx.x; job < 256; job += gridDim.x) {
        const int b = job >> 5;
        for (int i = tid; i < 1024; i += 512) {
            float s0 = p.ada_b[i], s1 = p.ada_b[1024 + i], s2 = p.ada_b[2048 + i], c0 = s0, c1 = s1;
#pragma unroll
            for (int ks = 0; ks < 8; ++ks) { const float* mp = modp + (size_t)(ks * 9 + b) * 3072; s0 += mp[i]; s1 += mp[1024 + i]; s2 += mp[2048 + i];
                const float* mc = modp + (size_t)(ks * 9 + 8) * 3072; c0 += mc[i]; c1 += mc[1024 + i]; }
            const float nw = p.norm_w[i];
            gs[i] = nw * (1.0f + s1); sh[i] = s0; gsc[i] = nw * (1.0f + c1); shc[i] = c0;
            if ((job & 31) == 0) ((float*)(p.ws + OFF_GATEV))[b * 1024 + i] = s2;
        }
        for (int i = tid; i < 16384; i += 512) { const int j = i & 15, k = i >> 4; WgT[j * 1024 + k] = p.in_w[(size_t)k * 8208 + 5120 + j]; }
        __syncthreads();
        const int crow = job * 8 + wid; const int cb = crow >> 8;
        float* gl = (float*)(p.ws + OFF_GL) + (size_t)b * 16 * 2048 + (size_t)lane * 2048; float* gc = (float*)(p.ws + OFF_GC) + (size_t)cb * 16 * 256 + (size_t)lane * 256 + (crow & 255);
        const int rbase = job * 64 + wid * 8;
#pragma unroll 1
        for (int pr = 0; pr < 5; ++pr) {
            const int ra_ = pr < 4 ? rbase + 2 * pr : rbase + 7;
            const float* xa_ = p.x + (size_t)ra_ * 1024; const float* xb_ = pr < 4 ? xa_ + 1024 : p.ctx + (size_t)crow * 1024;
            f32x4 xa[4], xb[4];
#pragma unroll
            for (int i = 0; i < 4; ++i) { xa[i] = __builtin_nontemporal_load((const f32x4*)(xa_ + i * 256 + lane * 4)); xb[i] = __builtin_nontemporal_load((const f32x4*)(xb_ + i * 256 + lane * 4)); }
            const LAS float* gsb_ = pr < 4 ? gs : gsc; const LAS float* shb_ = pr < 4 ? sh : shc;
            bf16_t* ob_ = pr < 4 ? AB + (size_t)(ra_ + 1) * 1024 : AB + (size_t)(16384 + crow) * 1024;
            float* gb_ = pr < 4 ? gl + ((ra_ + 1) & 2047) : gc;
            norm_rows2(xa, xb, gs, sh, gsb_, shb_, WgT, AB + (size_t)ra_ * 1024, ob_, gl + (ra_ & 2047), gb_, p.gate_b, lane);
        }
        __syncthreads();
    }
}

__device__ __forceinline__ bf16_t* cst_ptr(const Params& p, int sid, int chunk) {
    bf16_t* base = sid < 32 ? (bf16_t*)p.out : (bf16_t*)(p.ws + OFF_CST2);
    return base + ((size_t)((sid & 31) * 16 + chunk)) * 65536;
}
__device__ __forceinline__ void passA_chunk(const Params& p, int st, int b, int h, int dir, int vs, bool& isctx, int& ci, const bf16_t*& Kbase, const bf16_t*& Vbase) {
    isctx = st < 2;
    if (isctx) { ci = dir ? 1 - st : st;
        Kbase = (const bf16_t*)(p.ws + OFF_KC) + (size_t)((b * 2 + ci) * 4 + h) * 32768;
        Vbase = (const bf16_t*)(p.ws + OFF_VTC) + (size_t)(b * 2 + ci) * 131072 + (h * 16 + vs * 4) * 2048; }
    else { const int s2 = st - 2; ci = dir ? 15 - s2 : s2;
        Kbase = (const bf16_t*)(p.ws + OFF_K) + (size_t)((b * 16 + ci) * 4 + h) * 32768;
        Vbase = (const bf16_t*)(p.ws + OFF_VT) + (size_t)(b * 16 + ci) * 131072 + (h * 16 + vs * 4) * 2048; }
}
__device__ void passA(const Params& p, LAS unsigned char* lds, int wg) {
    const int tid = opaque_tid(), wid = tid >> 6, lane = tid & 63, fr = lane & 15, fq = lane >> 4;
    const int sid = wg >> 2, vs = wg & 3; const int b = sid >> 3, h = (sid >> 1) & 3, dir = sid & 1;
    LAS bf16_t* Kt = (LAS bf16_t*)lds;
    LAS bf16_t* Ve = Kt + 256 * 136;
    LAS float* eA = (LAS float*)(lds + 87040);
    LAS float* bendA = eA + 18 * 128; LAS float* maxwA = bendA + 32; LAS float* decayA = maxwA + 32; LAS float* mprevA = decayA + 32; LAS float* mnewA = mprevA + 32;
    LAS bf16_t* eB = (LAS bf16_t*)(mnewA + 32);
    const float* GL = (const float*)(p.ws + OFF_GL); const float* GC = (const float*)(p.ws + OFF_GC);
    for (int st = wid; st < 18; st += 8) {
        const bool isctx = st < 2; const int ci = isctx ? (dir ? 1 - st : st) : (dir ? 15 - (st - 2) : st - 2);
        const int T = isctx ? 256 : 2048; const float* G = isctx ? GC + (size_t)b * 16 * 256 : GL + (size_t)b * 16 * 2048;
        const float* pli = G + (size_t)(dir * 8 + h) * T + ci * 128; const float* plf = G + (size_t)(dir * 8 + 4 + h) * T + ci * 128;
        const int s0 = dir ? 127 - 2 * lane : 2 * lane, s1 = dir ? 126 - 2 * lane : 2 * lane + 1;
        const float lf0 = plf[s0], lf1 = plf[s1], li0 = pli[s0], li1 = pli[s1];
        const float p1 = lf0 + lf1; float inc = p1;
#pragma unroll
        for (int off = 1; off < 64; off <<= 1) { const float n = __shfl_up(inc, off); inc += (lane >= off) ? n : 0.f; }
        const float bend = __shfl(inc, 63);
        const float b0 = inc - p1 + lf0, b1 = inc;
        const float w0 = bend - b0 + li0, w1 = bend - b1 + li1;
        float mx = fmaxf(w0, w1);
#pragma unroll
        for (int off = 32; off > 0; off >>= 1) mx = fmaxf(mx, __shfl_xor(mx, off));
        eA[st * 128 + s0] = w0; eA[st * 128 + s1] = w1;
        if (lane == 0) { bendA[st] = bend; maxwA[st] = mx; }
    }
    __syncthreads();
    if (tid == 0) { float m = -1e30f;
        for (int st = 0; st < 18; ++st) { mprevA[st] = m; const float mn = fmaxf(bendA[st] + m, maxwA[st]); decayA[st] = expf(bendA[st] + m - mn); mnewA[st] = mn; m = mn; } }
    __syncthreads();
    for (int i = tid; i < 18 * 128; i += 512) { const float e = expf(eA[i] - mnewA[i >> 7]); eA[i] = e; eB[i] = (bf16_t)(cvt_pk_bf16(e, 0.f) & 0xffffu); }
    __syncthreads();
    f32x4 nacc[2] = {(f32x4){0.f, 0.f, 0.f, 0.f}, (f32x4){0.f, 0.f, 0.f, 0.f}};
    f32x4 acc[2][4];
#pragma unroll
    for (int a = 0; a < 2; ++a)
#pragma unroll
        for (int v = 0; v < 4; ++v) acc[a][v] = (f32x4){0.f, 0.f, 0.f, 0.f};
    u32x4 vr[2], kr[2][4];
    { bool ic; int ci; const bf16_t* Kb; const bf16_t* Vb; passA_chunk(p, 0, b, h, dir, vs, ic, ci, Kb, Vb);
#pragma unroll
        for (int rep = 0; rep < 2; ++rep) { const int it = tid + rep * 512;
            vr[rep] = *(const u32x4*)(Vb + (size_t)it * 8);
            const int sq = (it & 15) | (((it >> 6) & 1) << 4), ko = ((it >> 4) & 3) | ((it >> 7) << 2); const bf16_t* src = Kb + (size_t)((sq >> 2) * 8 + (ko >> 2)) * 512 + ((sq & 3) * 16 + (ko & 3)) * 8;
            kr[rep][0] = *(const u32x4*)src; kr[rep][1] = *(const u32x4*)(src + 32); kr[rep][2] = *(const u32x4*)(src + 64); kr[rep][3] = *(const u32x4*)(src + 96); } }
    for (int st = 0; st < 18; ++st) {
        bool isctx; int ci; const bf16_t* Kb; const bf16_t* Vb; passA_chunk(p, st, b, h, dir, vs, isctx, ci, Kb, Vb);
        if (!isctx) {
            bf16_t* cs = cst_ptr(p, sid, ci);
#pragma unroll
            for (int vt = 0; vt < 4; ++vt) { u32x4 w; w.x = cvt_pk_bf16(acc[0][vt][0], acc[0][vt][1]); w.y = cvt_pk_bf16(acc[0][vt][2], acc[0][vt][3]);
                w.z = cvt_pk_bf16(acc[1][vt][0], acc[1][vt][1]); w.w = cvt_pk_bf16(acc[1][vt][2], acc[1][vt][3]);
                __builtin_nontemporal_store(w, (u32x4*)(cs + (size_t)((vs * 4 + vt) * 8 + wid) * 512 + (fr * 4 + fq) * 8)); }
            if (vs == 0) { if (fr == 0) { float* np = (float*)(p.ws + OFF_NST) + (size_t)(sid * 16 + ci) * 256 + wid * 32 + fq * 8; *(f32x4*)np = nacc[0]; *(f32x4*)(np + 4) = nacc[1]; }
                if (tid == 0) ((float*)(p.ws + OFF_MST))[sid * 16 + ci] = mprevA[st]; }
        }
        if (st == 17) break;
        const LAS float* e_s = eA + st * 128; const float decay = decayA[st];
#pragma unroll
        for (int rep = 0; rep < 2; ++rep) { const int it = tid + rep * 512; const int v = (it >> 8) * 16 + ((it >> 2) & 15), sg = ((it >> 6) & 3) * 32 + (it & 3) * 8;
            const u32x4 raw = vr[rep];
            u32x4 w; w.x = cvt_pk_bf16(bf_lo(raw.x) * e_s[sg], bf_hi(raw.x) * e_s[sg + 1]); w.y = cvt_pk_bf16(bf_lo(raw.y) * e_s[sg + 2], bf_hi(raw.y) * e_s[sg + 3]);
            w.z = cvt_pk_bf16(bf_lo(raw.z) * e_s[sg + 4], bf_hi(raw.z) * e_s[sg + 5]); w.w = cvt_pk_bf16(bf_lo(raw.w) * e_s[sg + 6], bf_hi(raw.w) * e_s[sg + 7]);
            *(LAS u32x4*)(Ve + v * 136 + sg) = w; }
#pragma unroll
        for (int rep = 0; rep < 2; ++rep) { const int it = tid + rep * 512; const int sq = (it & 15) | (((it >> 6) & 1) << 4), ko = ((it >> 4) & 3) | ((it >> 7) << 2);
            const u32x4 r0 = kr[rep][0], r1 = kr[rep][1], r2 = kr[rep][2], r3 = kr[rep][3];
            LAS bf16_t* dst = Kt + (ko * 8) * 136 + sq * 4;
#define TRW(j, a0, a1, a2, a3, HI) { u32x2 w; if (HI) { w.x = (a0 >> 16) | (a1 & 0xffff0000u); w.y = (a2 >> 16) | (a3 & 0xffff0000u); } else { w.x = (a0 & 0xffffu) | (a1 << 16); w.y = (a2 & 0xffffu) | (a3 << 16); } *(LAS u32x2*)(dst + (j) * 136) = w; }
            TRW(0, r0.x, r1.x, r2.x, r3.x, 0) TRW(1, r0.x, r1.x, r2.x, r3.x, 1) TRW(2, r0.y, r1.y, r2.y, r3.y, 0) TRW(3, r0.y, r1.y, r2.y, r3.y, 1)
            TRW(4, r0.z, r1.z, r2.z, r3.z, 0) TRW(5, r0.z, r1.z, r2.z, r3.z, 1) TRW(6, r0.w, r1.w, r2.w, r3.w, 0) TRW(7, r0.w, r1.w, r2.w, r3.w, 1)
#undef TRW
        }
        __syncthreads();
        if (st + 1 < 17) {
            bool ic2; int ci2; const bf16_t* Kb2; const bf16_t* Vb2; passA_chunk(p, st + 1, b, h, dir, vs, ic2, ci2, Kb2, Vb2);
#pragma unroll
            for (int rep = 0; rep < 2; ++rep) { const int it = tid + rep * 512;
                vr[rep] = *(const u32x4*)(Vb2 + (size_t)it * 8);
                const int sq = (it & 15) | (((it >> 6) & 1) << 4), ko = ((it >> 4) & 3) | ((it >> 7) << 2); const bf16_t* src = Kb2 + (size_t)((sq >> 2) * 8 + (ko >> 2)) * 512 + ((sq & 3) * 16 + (ko & 3)) * 8;
                kr[rep][0] = *(const u32x4*)src; kr[rep][1] = *(const u32x4*)(src + 32); kr[rep][2] = *(const u32x4*)(src + 64); kr[rep][3] = *(const u32x4*)(src + 96); } }
#pragma unroll
        for (int a = 0; a < 2; ++a) { nacc[a] *= decay;
#pragma unroll
            for (int v = 0; v < 4; ++v) acc[a][v] *= decay; }
#pragma unroll
        for (int ks = 0; ks < 4; ++ks) { bf16x8 kf[2], vf[4];
#pragma unroll
            for (int kt = 0; kt < 2; ++kt) kf[kt] = *(const LAS bf16x8*)(Kt + (wid * 32 + 8 * (fr >> 2) + 4 * kt + (fr & 3)) * 136 + ks * 32 + fq * 8);
#pragma unroll
            for (int vt = 0; vt < 4; ++vt) vf[vt] = *(const LAS bf16x8*)(Ve + (vt * 16 + fr) * 136 + ks * 32 + fq * 8);
            bf16x8 ef = *(const LAS bf16x8*)(eB + st * 128 + ks * 32 + fq * 8);
            if (fr != 0) ef = (bf16x8){0, 0, 0, 0, 0, 0, 0, 0};
#pragma unroll
            for (int kt = 0; kt < 2; ++kt) {
#pragma unroll
                for (int vt = 0; vt < 4; ++vt) acc[kt][vt] = __builtin_amdgcn_mfma_f32_16x16x32_bf16(kf[kt], vf[vt], acc[kt][vt], 0, 0, 0);
                nacc[kt] = __builtin_amdgcn_mfma_f32_16x16x32_bf16(kf[kt], ef, nacc[kt], 0, 0, 0); } }
        __syncthreads();
    }
    __syncthreads();
}

__device__ void boxfilter_unit(const Params& p, LAS unsigned char* lds, int u) {
    const int tid = opaque_tid();
    const int b = u >> 6, g = (u >> 4) & 3, cb = u & 15; const int hw = 1 << g;
    LAS float* X = (LAS float*)lds; LAS float* Y = X + 2048 * 8;
    const bf16_t* src = (const bf16_t*)(p.ws + OFF_P) + (size_t)(b * 64 + g * 16 + cb) * 2048 * 8;
    bf16_t* dst = (bf16_t*)(p.ws + OFF_MX) + (size_t)(b * 2048) * 512 + g * 128 + cb * 8;
#pragma unroll
    for (int i = 0; i < 4; ++i) { const int tok = tid + 512 * i; const u32x4 v = *(const u32x4*)(src + (size_t)tok * 8);
        *(LAS f32x4*)(X + tok * 8) = (f32x4){bf_lo(v.x), bf_hi(v.x), bf_lo(v.y), bf_hi(v.y)}; *(LAS f32x4*)(X + tok * 8 + 4) = (f32x4){bf_lo(v.z), bf_hi(v.z), bf_lo(v.w), bf_hi(v.w)}; }
    __syncthreads();
    for (int i = 0; i < 4; ++i) { const int tok = tid + 512 * i; const int r = tok >> 6, c = tok & 63; const int lo = max(r - hw, 0), hi = min(r + hw, 32);
        f32x4 s0 = (f32x4){0.f, 0.f, 0.f, 0.f}, s1 = s0;
        for (int rr = lo; rr < hi; ++rr) { s0 += *(const LAS f32x4*)(X + (rr * 64 + c) * 8); s1 += *(const LAS f32x4*)(X + (rr * 64 + c) * 8 + 4); }
        const float cnt = (float)(hi - lo);
        *(LAS f32x4*)(Y + tok * 8) = s0 / cnt; *(LAS f32x4*)(Y + tok * 8 + 4) = s1 / cnt; }
    __syncthreads();
    for (int i = 0; i < 4; ++i) { const int tok = tid + 512 * i; const int r = tok >> 6, c = tok & 63; const int lo = max(c - hw, 0), hi = min(c + hw, 64);
        f32x4 s0 = (f32x4){0.f, 0.f, 0.f, 0.f}, s1 = s0;
        for (int cc = lo; cc < hi; ++cc) { s0 += *(const LAS f32x4*)(Y + (r * 64 + cc) * 8); s1 += *(const LAS f32x4*)(Y + (r * 64 + cc) * 8 + 4); }
        const float cnt = (float)(hi - lo);
        const f32x4 m0 = s0 / cnt - *(const LAS f32x4*)(X + tok * 8), m1 = s1 / cnt - *(const LAS f32x4*)(X + tok * 8 + 4);
        u32x4 w; w.x = cvt_pk_bf16(m0[0], m0[1]); w.y = cvt_pk_bf16(m0[2], m0[3]); w.z = cvt_pk_bf16(m1[0], m1[1]); w.w = cvt_pk_bf16(m1[2], m1[3]);
        *(u32x4*)(dst + (size_t)tok * 512) = w; }
    __syncthreads();
}

__device__ void passB_unit(const Params& p, LAS unsigned char* lds, int u, bool do_store = true) {
    const int tid = opaque_tid(), wid = tid >> 6, lane = tid & 63, fr = lane & 15, fq = lane >> 4;
    const int b = u >> 6, h = (u >> 4) & 3, c = u & 15;
    const int tokbase = b * 2048 + c * 128;
    LAS bf16_t* Qs = (LAS bf16_t*)lds;
    LAS bf16_t* Pd = Qs + 128 * 264;
    LAS float* fl = (LAS float*)(lds + 137216);
    LAS float* lfA = fl; LAS float* liA = fl + 256; LAS float* aA = fl + 512; LAS float* MA = fl + 768; LAS float* winA = fl + 1024; LAS float* clampA = fl + 1280;
    LAS float* nqA = fl + 1536; LAS float* nvec = fl + 1792; LAS float* rsP = fl + 2304; LAS float* ssP = fl + 3328;
    const float* GL = (const float*)(p.ws + OFF_GL) + (size_t)b * 16 * 2048 + c * 128;
    bf16_t* Qg = (bf16_t*)(p.ws + OFF_Q) + (size_t)((tokbase >> 8) * 4 + h) * 65536 + (c & 1) * 8 * 512;
    const int sid0 = (b * 4 + h) * 2;
    LAS float* wtot = lfA; LAS float* wmax = lfA + 8;
    float sc_b = 0.f, sc_li = 0.f; int sc_t = 0;
    if (tid < 256) { const int d = tid >> 7, i = tid & 127; sc_t = d ? 127 - i : i;
        sc_li = GL[(size_t)(d * 8 + h) * 2048 + sc_t]; float inc = GL[(size_t)(d * 8 + 4 + h) * 2048 + sc_t];
#pragma unroll
        for (int off = 1; off < 64; off <<= 1) { const float n = __shfl_up(inc, off); inc += (lane >= off) ? n : 0.f; }
        sc_b = inc; if (lane == 63) wtot[wid] = inc; }
    { const int d = tid >> 8, k = tid & 255; nvec[tid] = ((const float*)(p.ws + OFF_NST))[(size_t)((sid0 + d) * 16 + c) * 256 + k]; }
#pragma unroll
    for (int i = 0; i < 8; ++i) { const int id = tid + 512 * i; const int w = id >> 9, m = (id >> 7) & 3, bj = (id >> 6) & 1, ln = id & 63;
        *(LAS u32x4*)(Qs + ((w >> 2) * 64 + m * 16 + (ln & 15)) * 264 + bj * 128 + (w & 3) * 32 + (ln >> 4) * 8) = *(const u32x4*)(Qg + (size_t)((w * 16 + m * 2 + bj) * 64 + ln) * 8); }
    __syncthreads();
    float sc_a = 0.f, sc_pm = 0.f;
    if (tid < 256) { if (wid & 1) sc_b += wtot[wid - 1];
        sc_a = sc_li - sc_b; float pm = sc_a;
#pragma unroll
        for (int off = 1; off < 64; off <<= 1) { const float n = __shfl_up(pm, off); pm = (lane >= off) ? fmaxf(pm, n) : pm; }
        sc_pm = pm; if (lane == 63) wmax[wid] = pm; }
    __syncthreads();
    const int wt2 = wid >> 2, w4 = wid & 3;
    const bf16_t* Kg = (const bf16_t*)(p.ws + OFF_K) + (size_t)((b * 16 + c) * 4 + h) * 32768 + (size_t)(w4 * 2 * 8) * 512 + (fr * 4 + fq) * 8;
    bf16x8 kfa[8][2];
#pragma unroll
    for (int ks = 0; ks < 8; ++ks)
#pragma unroll
        for (int nt = 0; nt < 2; ++nt) kfa[ks][nt] = *(const bf16x8*)(Kg + (size_t)(nt * 8 + ks) * 512);
    if (tid < 256) { const int d = tid >> 7, t = sc_t; if (wid & 1) sc_pm = fmaxf(sc_pm, wmax[wid - 1]);
        const float mc = ((const float*)(p.ws + OFF_MST))[(sid0 + d) * 16 + c];
        const float Mt = fmaxf(mc, sc_pm); const int dt = d * 128 + t;
        aA[dt] = sc_a; MA[dt] = Mt; winA[dt] = expf(mc - Mt); clampA[dt] = expf(-(sc_b + Mt));
        float s = 0.f; const LAS float* nv = nvec + d * 256;
#pragma unroll 4
        for (int k8 = 0; k8 < 32; ++k8) { const u32x4 qv = *(const LAS u32x4*)(Qs + t * 264 + k8 * 8); const LAS float* np = nv + k8 * 8;
            s += bf_lo(qv.x) * np[0] + bf_hi(qv.x) * np[1] + bf_lo(qv.y) * np[2] + bf_hi(qv.y) * np[3] + bf_lo(qv.z) * np[4] + bf_hi(qv.z) * np[5] + bf_lo(qv.w) * np[6] + bf_hi(qv.w) * np[7]; }
        nqA[dt] = s; }
    __syncthreads();
    const bf16_t* Cd0 = cst_ptr(p, sid0, c) + (size_t)(w4 * 32) * 512 + (fr * 4 + fq) * 8;
    const bf16_t* Cd1 = cst_ptr(p, sid0 + 1, c) + (size_t)(w4 * 32) * 512 + (fr * 4 + fq) * 8;
    const bf16_t* Vd = (const bf16_t*)(p.ws + OFF_VT) + (size_t)(b * 16 + c) * 131072 + (h * 16 + w4 * 4) * 2048 + (fr * 4 + fq) * 8;
    bf16x8 F[3][4][2];
#define PB_ISSUE(q) do { const int _nh = (q) / 6, _d = ((q) % 6) / 3, _kind = (q) % 3; \
        _Pragma("unroll") for (int ks = 0; ks < 4; ++ks) _Pragma("unroll") for (int n2 = 0; n2 < 2; ++n2) \
            F[(q) % 3][ks][n2] = (_kind < 2) ? __builtin_nontemporal_load((const bf16x8*)((_d ? Cd1 : Cd0) + (size_t)((_nh * 2 + n2) * 8 + _kind * 4 + ks) * 512)) \
                                            : *(const bf16x8*)(Vd + (size_t)((_nh * 2 + n2) * 4 + ks) * 512); } while (0)
    {
        f32x4 sacc[4][2];
#pragma unroll
        for (int mt = 0; mt < 4; ++mt)
#pragma unroll
            for (int nt = 0; nt < 2; ++nt) sacc[mt][nt] = (f32x4){0.f, 0.f, 0.f, 0.f};
#pragma unroll
        for (int ks = 0; ks < 8; ++ks) { bf16x8 qf[4];
#pragma unroll
            for (int mt = 0; mt < 4; ++mt) qf[mt] = *(const LAS bf16x8*)(Qs + (wt2 * 64 + mt * 16 + fr) * 264 + ks * 32 + fq * 8);
#pragma unroll
            for (int mt = 0; mt < 4; ++mt)
#pragma unroll
                for (int nt = 0; nt < 2; ++nt) sacc[mt][nt] = __builtin_amdgcn_mfma_f32_16x16x32_bf16(kfa[ks][nt], qf[mt], sacc[mt][nt], 0, 0, 0); }
        PB_ISSUE(0); PB_ISSUE(1);
        __builtin_amdgcn_sched_barrier(0);
#pragma unroll
        for (int mt = 0; mt < 4; ++mt) { const int t = wt2 * 64 + mt * 16 + fr; const float Mf = MA[t], Mb = MA[128 + t]; float rf = 0.f, rb = 0.f;
#pragma unroll
            for (int nt = 0; nt < 2; ++nt) { const int s0 = w4 * 32 + nt * 16 + fq * 4; float pf[4], pb[4];
#pragma unroll
                for (int r = 0; r < 4; ++r) { const int s = s0 + r; const float val = sacc[mt][nt][r];
                    const float ef = __expf(fminf(aA[s] - Mf, 0.f)), eb = __expf(fminf(aA[128 + s] - Mb, 0.f));
                    pf[r] = (s <= t) ? val * ef : 0.f; pb[r] = (s >= t) ? val * eb : 0.f; rf += pf[r]; rb += pb[r]; }
                u32x2 wf, wb; wf.x = cvt_pk_bf16(pf[0], pf[1]); wf.y = cvt_pk_bf16(pf[2], pf[3]); wb.x = cvt_pk_bf16(pb[0], pb[1]); wb.y = cvt_pk_bf16(pb[2], pb[3]);
                *(LAS u32x2*)(Pd + t * 136 + s0) = wf; *(LAS u32x2*)(Pd + 128 * 136 + t * 136 + s0) = wb; }
            rf += __shfl_xor(rf, 16); rf += __shfl_xor(rf, 32); rb += __shfl_xor(rb, 16); rb += __shfl_xor(rb, 32);
            if (fq == 0) { rsP[w4 * 128 + t] = rf; rsP[512 + w4 * 128 + t] = rb; } }
    }
    __syncthreads();
    LAS float* invA = fl + 3840;
    if (tid < 256) { const int d = tid >> 7, t = tid & 127;
        const float den = winA[tid] * nqA[tid] + ((rsP[d * 512 + t] + rsP[d * 512 + 128 + t]) + (rsP[d * 512 + 256 + t] + rsP[d * 512 + 384 + t]));
        invA[tid] = 1.0f / fmaxf(fabsf(den), clampA[tid]); }
    __syncthreads();
    f32x4 hsum[4][4], acc[4][2];
#pragma unroll
    for (int q = 0; q < 12; ++q) {
        const int nh = q / 6, d = (q % 6) / 3, kind = q % 3;
        if (q + 2 < 12) PB_ISSUE(q + 2);
        __builtin_amdgcn_sched_barrier(0);
        if (kind == 0) {
#pragma unroll
            for (int mt = 0; mt < 4; ++mt)
#pragma unroll
                for (int n2 = 0; n2 < 2; ++n2) { acc[mt][n2] = (f32x4){0.f, 0.f, 0.f, 0.f}; if (d == 0) hsum[mt][nh * 2 + n2] = (f32x4){0.f, 0.f, 0.f, 0.f}; }
        }
        if (kind < 2) {
#pragma unroll
            for (int ks = 0; ks < 4; ++ks) { bf16x8 qf[4];
#pragma unroll
                for (int mt = 0; mt < 4; ++mt) qf[mt] = *(const LAS bf16x8*)(Qs + (wt2 * 64 + mt * 16 + fr) * 264 + (kind * 4 + ks) * 32 + fq * 8);
#pragma unroll
                for (int mt = 0; mt < 4; ++mt)
#pragma unroll
                    for (int n2 = 0; n2 < 2; ++n2) acc[mt][n2] = __builtin_amdgcn_mfma_f32_16x16x32_bf16(F[q % 3][ks][n2], qf[mt], acc[mt][n2], 0, 0, 0); }
        } else {
            const LAS bf16_t* Pp = Pd + d * 128 * 136;
#pragma unroll
            for (int mt = 0; mt < 4; ++mt) { const float wv = winA[d * 128 + wt2 * 64 + mt * 16 + fr];
#pragma unroll
                for (int n2 = 0; n2 < 2; ++n2) acc[mt][n2] *= wv; }
#pragma unroll
            for (int ks = 0; ks < 4; ++ks) { bf16x8 pf[4];
#pragma unroll
                for (int mt = 0; mt < 4; ++mt) pf[mt] = *(const LAS bf16x8*)(Pp + (wt2 * 64 + mt * 16 + fr) * 136 + ks * 32 + fq * 8);
#pragma unroll
                for (int mt = 0; mt < 4; ++mt)
#pragma unroll
                    for (int n2 = 0; n2 < 2; ++n2) acc[mt][n2] = __builtin_amdgcn_mfma_f32_16x16x32_bf16(F[q % 3][ks][n2], pf[mt], acc[mt][n2], 0, 0, 0); }
#pragma unroll
            for (int mt = 0; mt < 4; ++mt) { const float iv = invA[d * 128 + wt2 * 64 + mt * 16 + fr];
#pragma unroll
                for (int n2 = 0; n2 < 2; ++n2) hsum[mt][nh * 2 + n2] += acc[mt][n2] * iv; }
        }
    }
#undef PB_ISSUE
#pragma unroll
    for (int mt = 0; mt < 4; ++mt) { float sv = 0.f;
#pragma unroll
        for (int nt = 0; nt < 4; ++nt) { const f32x4 hv = hsum[mt][nt]; sv += (hv[0] * hv[0] + hv[1] * hv[1]) + (hv[2] * hv[2] + hv[3] * hv[3]); }
        sv += __shfl_xor(sv, 16); sv += __shfl_xor(sv, 32);
        if (fq == 0) ssP[w4 * 128 + wt2 * 64 + mt * 16 + fr] = sv; }
    __syncthreads();
#pragma unroll
    for (int mt = 0; mt < 4; ++mt) { const int t = wt2 * 64 + mt * 16 + fr;
        const float tot = (ssP[t] + ssP[128 + t]) + (ssP[256 + t] + ssP[384 + t]); const float rinv = rsqrtf(tot * (1.0f / 256.0f) + 1e-6f);
#pragma unroll
        for (int nt = 0; nt < 4; ++nt) { const int v = w4 * 64 + nt * 16 + fq * 4; const f32x4 hw = *(const f32x4*)(p.head_norm_w + h * 256 + v);
            const f32x4 o = hsum[mt][nt] * rinv * hw;
            u32x2 w; w.x = cvt_pk_bf16(o[0], o[1]); w.y = cvt_pk_bf16(o[2], o[3]);
            *(LAS u32x2*)(Pd + t * 264 + v) = w; } }
    __syncthreads();
    __builtin_amdgcn_sched_barrier(0);
    if (do_store) {
#pragma unroll 2
        for (int i = 0; i < 8; ++i) { const int id = tid + 512 * i; const int w = id >> 9, m = (id >> 7) & 3, bj = (id >> 6) & 1, ln = id & 63;
            *(u32x4*)(Qg + (size_t)((w * 16 + m * 2 + bj) * 64 + ln) * 8) = *(const LAS u32x4*)(Pd + ((w >> 2) * 64 + m * 16 + (ln & 15)) * 264 + bj * 128 + (w & 3) * 32 + (ln >> 4) * 8); } }
    __syncthreads();
}

__device__ void phase_final(const Params& p) {
    const int tid = opaque_tid(), wid = tid >> 6, lane = tid & 63;
    const float* ssq = (const float*)(p.ws + OFF_SSQ);
    for (int row = blockIdx.x * 8 + wid; row < 16384; row += gridDim.x * 8) {
        const f32x4 s0 = *(const f32x4*)(ssq + (size_t)row * 16), s1 = *(const f32x4*)(ssq + (size_t)row * 16 + 4), s2 = *(const f32x4*)(ssq + (size_t)row * 16 + 8), s3 = *(const f32x4*)(ssq + (size_t)row * 16 + 12);
        const float tot = ((s0[0] + s0[1]) + (s0[2] + s0[3])) + ((s1[0] + s1[1]) + (s1[2] + s1[3])) + ((s2[0] + s2[1]) + (s2[2] + s2[3])) + ((s3[0] + s3[1]) + (s3[2] + s3[3]));
        const float rstd = rsqrtf(tot * (1.0f / 1024.0f) + 1e-6f);
        float* orow = p.out + (size_t)row * 1024;
#pragma unroll
        for (int i = 0; i < 4; ++i) { const f32x4 v = *(const f32x4*)(orow + i * 256 + lane * 4); const f32x4 w = *(const f32x4*)(p.final_norm_w + i * 256 + lane * 4);
            *(f32x4*)(orow + i * 256 + lane * 4) = v * rstd * w; }
    }
}


#define XB_TMO      128
#define XB_XCNT(j)  (256  + 64 * (j))
#define XB_XSUB(j)  (1280 + 64 * (j))
#define XB_XGEN(j)  (2304 + 64 * (j))
#define XB_TOP      3328
#define XB_TOPGEN   3392
#define XCD_BAR_WORDS 3456
#define XB_SPIN_CAP (1u << 18)
__device__ __forceinline__ unsigned xb_ld(unsigned* p)              { return __hip_atomic_load(p, __ATOMIC_RELAXED, __HIP_MEMORY_SCOPE_AGENT); }
__device__ __forceinline__ unsigned xb_add(unsigned* p, unsigned v) { return __hip_atomic_fetch_add(p, v, __ATOMIC_RELAXED, __HIP_MEMORY_SCOPE_AGENT); }
__device__ __forceinline__ unsigned xb_xcc_id() { return (unsigned)__builtin_amdgcn_s_getreg((3 << 11) | 20) & 0xFu; }
#define XB_SPIN(cond, bar) do { unsigned _sp = 0; while (cond) { __builtin_amdgcn_s_sleep(1); \
    if ((++_sp & 255u) == 0u) { if (xb_ld(&(bar)[XB_TMO])) break; if (_sp > XB_SPIN_CAP) { atomicAdd(&(bar)[XB_TMO], 1u); break; } } } } while (0)
struct XcdBarrier { unsigned* bar; unsigned x; volatile LAS unsigned* st; };
__device__ __forceinline__ XcdBarrier xcd_barrier_post(unsigned* bar, volatile LAS unsigned* st) {
    XcdBarrier b; b.bar = bar; b.x = xb_xcc_id(); b.st = st;
    if (threadIdx.x == 0) (void)xb_add(&bar[XB_XCNT(b.x)], 1u);
    return b;
}
__device__ __forceinline__ void xcd_barrier_complete(unsigned* bar, unsigned x, unsigned& nloc, unsigned& nx) {
    const unsigned G = gridDim.x * gridDim.y * gridDim.z;
    unsigned sum, cnt, mine, sp = 0u;
    for (;;) {
        sum = 0u; cnt = 0u; mine = 0u;
#pragma unroll
        for (unsigned j = 0; j < 16; ++j) { const unsigned c = xb_ld(&bar[XB_XCNT(j)]); sum += c; cnt += (c > 0u) ? 1u : 0u; mine = (j == x) ? c : mine; }
        if (sum == G) break;
        __builtin_amdgcn_s_sleep(1);
        if ((++sp & 255u) == 0u) { if (xb_ld(&bar[XB_TMO])) break; if (sp > XB_SPIN_CAP) { atomicAdd(&bar[XB_TMO], 1u); break; } }
    }
    nloc = mine > 0u ? mine : 1u; nx = cnt > 0u ? cnt : 1u;
}
__device__ __forceinline__ void xcd_barrier(const XcdBarrier& b) {
    asm volatile("s_waitcnt vmcnt(0)" ::: "memory");
    __syncthreads();
    if (threadIdx.x == 0) {
        unsigned* bar = b.bar;
        __builtin_amdgcn_s_waitcnt(0);
        unsigned nloc = b.st[0], nx = b.st[1];
        if (nloc == 0u) { xcd_barrier_complete(bar, b.x, nloc, nx); b.st[0] = nloc; b.st[1] = nx; }
        const unsigned old = xb_add(&bar[XB_XSUB(b.x)], 1u);
        const unsigned gen = old / nloc;
        if (old + 1u == (gen + 1u) * nloc) {
            __builtin_amdgcn_fence(__ATOMIC_RELEASE, "agent");
            asm volatile("s_waitcnt vmcnt(0)" ::: "memory");
            const unsigned og = xb_add(&bar[XB_TOP], 1u);
            const unsigned tg = og / nx;
            if (og + 1u == (tg + 1u) * nx) xb_add(&bar[XB_TOPGEN], 1u);
            else XB_SPIN(xb_ld(&bar[XB_TOPGEN]) == tg, bar);
            __builtin_amdgcn_fence(__ATOMIC_ACQUIRE, "agent");
            xb_add(&bar[XB_XGEN(b.x)], 1u);
            asm volatile("s_waitcnt vmcnt(0)" ::: "memory");
        } else {
            XB_SPIN(xb_ld(&bar[XB_XGEN(b.x)]) == gen, bar);
            __builtin_amdgcn_fence(__ATOMIC_ACQUIRE, "agent");
            asm volatile("s_waitcnt vmcnt(0)" ::: "memory");
        }
    }
    __syncthreads();
}

__device__ __forceinline__ void run_phase(const Params& p, LAS unsigned char* lds, int ph) {
    const int tid = opaque_tid();
    const bf16_t* AB = (const bf16_t*)(p.ws + OFF_AB);
    switch (ph) {
    case 0: phase0(p, lds); break;
    case 1: phase1(p, lds); break;
    case 2: { SchedG1 S{(int)blockIdx.x}; EpiG1 E{p.ws}; pg8::gemm_phase(lds, pg8::Gemm{AB, AB, 1024}, S, E); } break;
    case 3: {
        { const int c3 = blockIdx.x, xcd = c3 & 7, sl = c3 >> 3;
          passA(p, lds, (xcd * 8 + (sl >> 2)) * 4 + (sl & 3));
          const int G = (sl >> 2) * 8 + xcd, mem = sl & 3;
          boxfilter_unit(p, lds, G * 4 + mem); boxfilter_unit(p, lds, (127 - G) * 4 + mem); }
        bf16_t* bt = (bf16_t*)(p.ws + OFF_BTPOOL);
        for (int idx = blockIdx.x * 512 + tid; idx < 512 * 512; idx += NWG * 512) { const int n = idx >> 9, k = idx & 511; const int gn = n >> 7, gk = k >> 7;
            const float v = (gn == gk) ? p.pool_w[(size_t)(gn * 128 + (k & 127)) * 128 + (n & 127)] : 0.f;
            bt[idx] = (bf16_t)(cvt_pk_bf16(v, 0.f) & 0xffffu); }
    } break;
    case 4: {
        const int c4 = blockIdx.x, pmt = (c4 & 7) * 8 + (c4 >> 5), j = (c4 >> 3) & 3;
        unsigned* flags = (unsigned*)(p.ws + OFF_PFLAG);
        if (j < 2) {
            Sched64 S{c4, 2}; EpiPool E{p.ws, p.pool_scale};
            pg8::gemm_phase(lds, pg8::Gemm{(const bf16_t*)(p.ws + OFF_MX), (const bf16_t*)(p.ws + OFF_BTPOOL), 512}, S, E);
            asm volatile("s_waitcnt vmcnt(0)" ::: "memory");
            __syncthreads();
            if (threadIdx.x == 0) { __builtin_amdgcn_fence(__ATOMIC_RELEASE, "agent"); asm volatile("s_waitcnt vmcnt(0)" ::: "memory");
                __hip_atomic_store(flags + 64 * (pmt * 2 + j), 1u, __ATOMIC_RELAXED, __HIP_MEMORY_SCOPE_AGENT); }
        }
        passB_unit(p, lds, c4 * 2); passB_unit(p, lds, c4 * 2 + 1);
        if (j < 2) {
            LAS float* T = (LAS float*)lds; const int w128 = pmt * 2 + j;
            for (int job = w128; job < 640; job += 128) {
                if (job < 256) { const int kt = job & 15, ntile = job >> 4; transpose_tile(p.branch_m_w, 1024, kt * 64, ntile * 64, (bf16_t*)(p.ws + OFF_WMT), 1024, ntile * 64, T); }
                else if (job < 512) { const int j2 = job - 256; const int kt = j2 & 15, ntile = j2 >> 4; transpose_tile(p.out_w, 1024, kt * 64, ntile * 64, (bf16_t*)(p.ws + OFF_WOT), 1024, ntile * 64, T); }
                else { const int j2 = job - 512; const int kt = j2 & 7, ntile = j2 >> 3; transpose_tile(p.branch_p_w, 1024, kt * 64, ntile * 64, (bf16_t*)(p.ws + OFF_WPT), 512, ntile * 64, T); }
            }
        }
        if (j >= 2) {
            if (threadIdx.x < 64) { unsigned spins = 0;
                while ((unsigned)__builtin_amdgcn_readfirstlane(__hip_atomic_load(flags + 64 * (pmt * 2 + j - 2), __ATOMIC_RELAXED, __HIP_MEMORY_SCOPE_AGENT)) == 0u) { __builtin_amdgcn_s_sleep(2); if (++spins > (1u << 22)) break; }
                __builtin_amdgcn_fence(__ATOMIC_ACQUIRE, "agent"); asm volatile("s_waitcnt vmcnt(0)" ::: "memory"); }
            __syncthreads();
            SchedOne S{pmt, 72 + 22 + (j - 2)}; EpiG2 E{p.ws, (bf16_t*)p.out};
            pg8::gemm_phase(lds, pg8::Gemm{AB, AB, 1024}, S, E);
        }
    } break;
    case 5: {
        SchedG2 S{(int)blockIdx.x}; EpiG2 E{p.ws, (bf16_t*)p.out}; pg8::gemm_phase(lds, pg8::Gemm{AB, AB, 1024}, S, E);
    } break;
    case 6: {
        Sched64 S{(int)blockIdx.x, 4};
        f32x4 macc[2][2][4][2];
        { EpiMergeMid E{p.ws}; pg8::gemm_phase_acc<EpiMergeMid, Sched64, true>(lds, pg8::Gemm{(const bf16_t*)(p.ws + OFF_PM), (const bf16_t*)(p.ws + OFF_WPT), 512}, S, E, macc); }
        { EpiMergeFin E{p.ws}; pg8::gemm_phase_acc<EpiMergeFin, Sched64, false>(lds, pg8::Gemm{(const bf16_t*)p.out, (const bf16_t*)(p.ws + OFF_WMT), 1024}, S, E, macc); }
    } break;
    case 7: { Sched64 S{(int)blockIdx.x, 4}; EpiOut E{p.ws, p.x, p.out, p.final_norm_w}; pg8::gemm_phase(lds, pg8::Gemm{(const bf16_t*)(p.ws + OFF_MG), (const bf16_t*)(p.ws + OFF_WOT), 1024}, S, E); } break;
    case 8: phase_final(p); break;
    default: break;
    }
}
#if MULTI_LAUNCH
template <int PH> __global__ void __launch_bounds__(512, 2) k_one(Params p) {
    extern __shared__ __attribute__((aligned(16))) unsigned char shm[];
    run_phase(p, (LAS unsigned char*)shm, PH);
}
#else
__global__ void __launch_bounds__(512, 2) fwd_megakernel(Params p) {
    extern __shared__ __attribute__((aligned(16))) unsigned char shm[];
    LAS unsigned char* lds = (LAS unsigned char*)shm;
    cg::grid_group grid = cg::this_grid();
    volatile LAS unsigned* xbst = (volatile LAS unsigned*)(lds + LDS_BYTES - 16);
    if (threadIdx.x == 0) { xbst[0] = 0u; xbst[1] = 0u; }
    __syncthreads();
    const XcdBarrier xb = xcd_barrier_post((unsigned*)(p.ws + OFF_BAR), xbst);
    if (p.ph_lo == 0x7fffffff) grid.sync();
    run_phase(p, lds, 0);
    run_phase(p, lds, 1); xcd_barrier(xb);
    run_phase(p, lds, 2); xcd_barrier(xb);
#ifdef PROBE_G1
    run_phase(p, lds, 2); xcd_barrier(xb);
#endif
    run_phase(p, lds, 3); xcd_barrier(xb);
#ifdef PROBE_A
    passA(p, lds, blockIdx.x); xcd_barrier(xb);
#endif
#ifdef PROBE_BOX
    boxfilter_unit(p, lds, blockIdx.x); boxfilter_unit(p, lds, 511 - blockIdx.x); xcd_barrier(xb);
#endif
    run_phase(p, lds, 4); xcd_barrier(xb);
    run_phase(p, lds, 5); xcd_barrier(xb);
    run_phase(p, lds, 6); xcd_barrier(xb);
    run_phase(p, lds, 7);
}
#endif

extern "C" void kernel_launch(void* const* d_in, const int* in_sizes, int n_in, void* d_out, int out_size, void* d_ws, size_t ws_size, hipStream_t stream) {
#if MULTI_LAUNCH
#define SETATTR(PH) (void)hipFuncSetAttribute((const void*)k_one<PH>, hipFuncAttributeMaxDynamicSharedMemorySize, LDS_BYTES)
    static int configured = 0;
    if (!configured) { SETATTR(0); SETATTR(1); SETATTR(2); SETATTR(3); SETATTR(4); SETATTR(5); SETATTR(6); SETATTR(7); SETATTR(8); configured = 1; }
#else
    static int configured = 0;
    if (!configured) {
        (void)hipFuncSetAttribute((const void*)fwd_megakernel, hipFuncAttributeMaxDynamicSharedMemorySize, LDS_BYTES);
        int dev = 0, cus = 0, per_cu = 0;
        (void)hipGetDevice(&dev); (void)hipDeviceGetAttribute(&cus, hipDeviceAttributeMultiprocessorCount, dev);
        (void)hipOccupancyMaxActiveBlocksPerMultiprocessor(&per_cu, fwd_megakernel, 512, LDS_BYTES);
        if (cus * per_cu < NWG) fprintf(stderr, "grid %d exceeds resident capacity %d x %d\n", NWG, cus, per_cu);
        if (ws_size < 256 * MiB) fprintf(stderr, "workspace too small: %zu\n", ws_size);
        configured = 1;
    }
#endif
    Params p{};
    p.x = (const float*)d_in[0]; p.c = (const float*)d_in[1]; p.ctx = (const float*)d_in[2]; p.c_ctx = (const float*)d_in[3]; p.norm_w = (const float*)d_in[4];
    p.ada_w = (const float*)d_in[5]; p.ada_b = (const float*)d_in[6]; p.in_w = (const float*)d_in[7]; p.gate_b = (const float*)d_in[8]; p.head_norm_w = (const float*)d_in[9];
    p.pool_w = (const float*)d_in[10]; p.pool_scale = (const float*)d_in[11]; p.branch_m_w = (const float*)d_in[12]; p.branch_p_w = (const float*)d_in[13]; p.out_w = (const float*)d_in[14];
    p.final_norm_w = (const float*)d_in[15];
    p.out = (float*)d_out; p.ws = (unsigned char*)d_ws;
#if MULTI_LAUNCH
    (void)hipMemsetAsync((unsigned char*)d_ws + OFF_BAR, 0, 65536, stream);
#define LAUNCH(PH) hipLaunchKernelGGL(k_one<PH>, dim3(NWG), dim3(512), LDS_BYTES, stream, p)
    LAUNCH(0); LAUNCH(1); LAUNCH(2); LAUNCH(3); LAUNCH(4); LAUNCH(5); LAUNCH(6); LAUNCH(7);
#else
    p.ph_lo = 0; p.ph_hi = 8;
    (void)hipMemsetAsync((unsigned char*)d_ws + OFF_BAR, 0, 65536, stream);
    void* args[] = {&p};
    hipError_t e = hipLaunchCooperativeKernel((const void*)fwd_megakernel, dim3(NWG), dim3(512), args, LDS_BYTES, stream);
    if (e != hipSuccess) fprintf(stderr, "cooperative launch failed: %s\n", hipGetErrorString(e));
#endif
}
```

```cpp
#include <hip/hip_runtime.h>
#include <hip/hip_cooperative_groups.h>
#include <cstdio>
namespace cg = cooperative_groups;

#ifndef MULTI_LAUNCH
#define MULTI_LAUNCH 0
#endif

#define LAS __attribute__((address_space(3)))
typedef unsigned short bf16_t;
typedef short bf16x8 __attribute__((ext_vector_type(8)));
typedef float f32x4 __attribute__((ext_vector_type(4)));
typedef unsigned u32x4 __attribute__((ext_vector_type(4)));
typedef unsigned u32x2 __attribute__((ext_vector_type(2)));

constexpr size_t MiB = 1024u * 1024u;
constexpr int LDS_BYTES = 155648;
constexpr int NWG = 256;
constexpr size_t OFF_AB = 0;
constexpr size_t OFF_BTPOOL = 32 * MiB;
constexpr size_t OFF_Q = 52 * MiB;
constexpr size_t OFF_K = 84 * MiB;
constexpr size_t OFF_VT = 116 * MiB;
constexpr size_t OFF_KC = 148 * MiB;
constexpr size_t OFF_VTC = 152 * MiB;
constexpr size_t OFF_P = 156 * MiB;
constexpr size_t OFF_PM = 148 * MiB;
constexpr size_t OFF_MX = 172 * MiB;
constexpr size_t OFF_CST2 = 188 * MiB;
constexpr size_t OFF_GB = 188 * MiB;
constexpr size_t OFF_WMT = 36 * MiB, OFF_WPT = 38 * MiB, OFF_WOT = 39 * MiB;
constexpr size_t OFF_MG = 116 * MiB;
constexpr size_t OFF_SMALL = 252 * MiB;
constexpr size_t OFF_GL = OFF_SMALL;
constexpr size_t OFF_SSQ = OFF_SMALL;
constexpr size_t OFF_GC = OFF_SMALL + 1 * MiB;
constexpr size_t OFF_NST = OFF_SMALL + 1 * MiB + 128 * 1024;
constexpr size_t OFF_MST = OFF_NST + 1 * MiB;
constexpr size_t OFF_MODP = OFF_MST + 4096;
constexpr size_t OFF_GATEV = OFF_MODP + 8 * 9 * 3072 * 4;
constexpr size_t OFF_PCNT = OFF_SMALL + 3 * MiB + 512 * 1024 + 16384;
constexpr size_t OFF_PFLAG = OFF_SMALL + 3 * MiB + 512 * 1024 + 32768;
constexpr size_t OFF_ACNT = OFF_SMALL + 3 * MiB + 512 * 1024 + 15360;
constexpr size_t OFF_BAR = OFF_SMALL + 3 * MiB + 512 * 1024;

struct Params {
    const float *x, *c, *ctx, *c_ctx, *norm_w, *ada_w, *ada_b, *in_w, *gate_b, *head_norm_w, *pool_w, *pool_scale, *branch_m_w, *branch_p_w, *out_w, *final_norm_w;
    float* out; unsigned char* ws;
    int ph_lo, ph_hi;
};

__device__ __forceinline__ int opaque_tid() { int t = (int)threadIdx.x; asm volatile("" : "+v"(t)); return t; }
__device__ __forceinline__ float bf_lo(unsigned w) { return __uint_as_float(w << 16); }
__device__ __forceinline__ float bf_hi(unsigned w) { return __uint_as_float(w & 0xffff0000u); }
__device__ __forceinline__ unsigned cvt_pk_bf16(float lo, float hi) { unsigned r; asm volatile("v_cvt_pk_bf16_f32 %0, %1, %2" : "=v"(r) : "v"(lo), "v"(hi)); return r; }
__device__ __forceinline__ float sigm(float x) { return __builtin_amdgcn_rcpf(1.0f + __expf(-x)); }
__device__ __forceinline__ float siluf(float x) { return x * __builtin_amdgcn_rcpf(1.0f + __expf(-x)); }

namespace pg8 {
constexpr int BM = 256, BK = 64, HALF = 128, HTB = HALF * BK * 2, STAGE_BYTES = 8 * HTB;
__device__ __forceinline__ int lds_byte(int r, int c) { const int st = (r >> 4) * 2 + (c >> 5), rr = r & 15, cc = c & 31, ob = rr * 64 + cc * 2; return st * 1024 + (ob ^ (((ob >> 9) & 1) << 5)); }
__device__ __forceinline__ void stage_rc(int b, int& R, int& C) { const int st = b / 1024, sb = b % 1024, swz = sb ^ (((sb >> 9) & 1) << 5); R = (st >> 1) * 16 + swz / 64; C = (st & 1) * 32 + (swz % 64) / 2; }
__device__ __forceinline__ int perm32(int rho) { const int n = rho >> 4, i = rho & 15; return 8 * (i >> 2) + 4 * n + (i & 3); }
struct Unit { int pm, pn; };
struct Gemm { const bf16_t* A; const bf16_t* Bt; int K; };

template <class Epi, class Sched, bool ZERO>
__device__ __forceinline__ void gemm_phase_acc(LAS unsigned char* lds, const Gemm g, const Sched& S, const Epi& E, f32x4 (&acc)[2][2][4][2]) {
    const int tid = opaque_tid(), wid = __builtin_amdgcn_readfirstlane(tid >> 6), lane = tid & 63, wr = wid >> 2, wc = wid & 3, fr = lane & 15, fq = lane >> 4;
    const int K = g.K, nt = K / BK;
    unsigned voffA[2], voffB[2];
#pragma unroll
    for (int i = 0; i < 2; ++i) { int R, C; stage_rc(tid * 16 + i * 8192, R, C); const int Rb = (R & ~31) + perm32(R & 31);
        voffA[i] = (unsigned)(R * K + C) * 2u; voffB[i] = (unsigned)(Rb * K + C) * 2u; }
    const size_t kstep = (size_t)(BK * 2);
    const size_t hstep = (size_t)HALF * K * 2;
    const size_t tstep = 2 * hstep;
    const unsigned ldsw = (unsigned)wid * 1024u;
    const int aoff = lds_byte(wr * 64 + fr, fq * 8), boff = lds_byte(wc * 32 + fr, fq * 8);
#define PG8_SA(b, h) (((b) * 2 + (h)) * HTB)
#define PG8_SB(b, h) ((4 + (b) * 2 + (h)) * HTB)
#define PG8_STAGE(bufoff, gbase, voff) do { _Pragma("unroll") for (int _i = 0; _i < 2; ++_i) \
        __builtin_amdgcn_global_load_lds((const unsigned*)((const char*)(gbase) + (voff)[_i]), (LAS unsigned*)(lds + (bufoff) + ldsw + _i * 8192), 16, 0, 0); } while (0)
#define PG8_LDA(dst, b, h) do { _Pragma("unroll") for (int m = 0; m < 4; ++m) _Pragma("unroll") for (int k = 0; k < 2; ++k) dst[m][k] = *(const LAS bf16x8*)(lds + PG8_SA(b, h) + aoff + m * 2048 + k * 1024); } while (0)
#define PG8_LDB(dst, b, h) do { _Pragma("unroll") for (int n = 0; n < 2; ++n) _Pragma("unroll") for (int k = 0; k < 2; ++k) dst[n][k] = *(const LAS bf16x8*)(lds + PG8_SB(b, h) + boff + n * 2048 + k * 1024); } while (0)
#define PG8_MMA(ai, bj, At, Bt) do { __builtin_amdgcn_s_setprio(1); _Pragma("unroll") for (int m = 0; m < 4; ++m) _Pragma("unroll") for (int n = 0; n < 2; ++n) _Pragma("unroll") for (int k = 0; k < 2; ++k) \
        acc[ai][bj][m][n] = __builtin_amdgcn_mfma_f32_16x16x32_bf16(Bt[n][k], At[m][k], acc[ai][bj][m][n], 0, 0, 0); __builtin_amdgcn_s_setprio(0); } while (0)
#define PG8_WAIT_V(n) asm volatile("s_waitcnt vmcnt(" #n ")" ::: "memory")
#define PG8_WAIT_L(n) asm volatile("s_waitcnt lgkmcnt(" #n ")" ::: "memory")
#define PG8_BAR __builtin_amdgcn_s_barrier()
#define PG8_SCHED __builtin_amdgcn_sched_barrier(0)
    Unit cur, nxt; int ui = 0;
    if (!S.next(0, cur)) return;
    if constexpr (ZERO) {
#pragma unroll
    for (int a = 0; a < 2; ++a)
#pragma unroll
        for (int b = 0; b < 2; ++b)
#pragma unroll
            for (int m = 0; m < 4; ++m)
#pragma unroll
                for (int n = 0; n < 2; ++n) acc[a][b][m][n] = (f32x4){0.f, 0.f, 0.f, 0.f};
    }
    bf16x8 At[4][2], B0[2][2], B1[2][2];
    const char* cA = (const char*)g.A + (size_t)cur.pm * tstep; const char* cB = (const char*)g.Bt + (size_t)cur.pn * tstep;
    PG8_STAGE(PG8_SB(0, 0), cB, voffB); PG8_STAGE(PG8_SA(0, 0), cA, voffA); PG8_STAGE(PG8_SB(0, 1), cB + hstep, voffB); PG8_STAGE(PG8_SA(0, 1), cA + hstep, voffA);
    if (wr == 1) PG8_BAR;
    PG8_WAIT_V(4); PG8_BAR;
    PG8_STAGE(PG8_SB(1, 0), cB + kstep, voffB); PG8_STAGE(PG8_SA(1, 0), cA + kstep, voffA); PG8_STAGE(PG8_SB(1, 1), cB + hstep + kstep, voffB);
    PG8_WAIT_V(6); PG8_BAR;
    for (;;) {
        const bool has_next = S.next(ui + 1, nxt);
        const char* nA = has_next ? (const char*)g.A + (size_t)nxt.pm * tstep : cA; const char* nB = has_next ? (const char*)g.Bt + (size_t)nxt.pn * tstep : cB;
        for (int t = 0; t < nt; t += 2) {
            const bool last = (t == nt - 2);
            const char* a1 = cA + (size_t)(t + 1) * kstep;
            const char* a2 = last ? nA : cA + (size_t)(t + 2) * kstep; const char* b2 = last ? nB : cB + (size_t)(t + 2) * kstep;
            const char* a3 = a2 + kstep; const char* b3 = b2 + kstep;
            PG8_LDB(B0, 0, 0); PG8_SCHED; PG8_LDA(At, 0, 0); PG8_STAGE(PG8_SA(1, 1), a1 + hstep, voffA);
            PG8_WAIT_L(8); PG8_BAR; PG8_WAIT_L(0); PG8_MMA(0, 0, At, B0); PG8_BAR; PG8_SCHED;
            PG8_LDB(B1, 0, 1); PG8_STAGE(PG8_SB(0, 0), b2, voffB);
            PG8_BAR; PG8_WAIT_L(0); PG8_MMA(0, 1, At, B1); PG8_BAR;
            PG8_LDA(At, 0, 1); PG8_STAGE(PG8_SA(0, 0), a2, voffA);
            PG8_BAR; PG8_WAIT_L(0); PG8_MMA(1, 0, At, B0); PG8_BAR; PG8_SCHED;
            PG8_STAGE(PG8_SB(0, 1), b2 + hstep, voffB);
            PG8_WAIT_V(6); PG8_BAR; PG8_MMA(1, 1, At, B1); PG8_BAR;
            PG8_LDB(B0, 1, 0); PG8_SCHED; PG8_LDA(At, 1, 0); PG8_STAGE(PG8_SA(0, 1), a2 + hstep, voffA);
            PG8_WAIT_L(8); PG8_BAR; PG8_WAIT_L(0); PG8_MMA(0, 0, At, B0); PG8_BAR; PG8_SCHED;
            PG8_LDB(B1, 1, 1); PG8_STAGE(PG8_SB(1, 0), b3, voffB);
            PG8_BAR; PG8_WAIT_L(0); PG8_MMA(0, 1, At, B1); PG8_BAR;
            PG8_LDA(At, 1, 1); PG8_STAGE(PG8_SA(1, 0), a3, voffA);
            PG8_BAR; PG8_WAIT_L(0); PG8_MMA(1, 0, At, B0); PG8_BAR; PG8_SCHED;
            PG8_STAGE(PG8_SB(1, 1), b3 + hstep, voffB);
            PG8_WAIT_V(6); PG8_BAR; PG8_MMA(1, 1, At, B1); PG8_BAR;
        }
        if constexpr (!Epi::AFTER_DRAIN) E(acc, cur, wr, wc, fr, fq);
        if constexpr (Epi::DRAIN) __builtin_amdgcn_s_waitcnt(0x0F70);
        if (!has_next) break;
#pragma unroll
        for (int a = 0; a < 2; ++a)
#pragma unroll
            for (int b = 0; b < 2; ++b)
#pragma unroll
                for (int m = 0; m < 4; ++m)
#pragma unroll
                    for (int n = 0; n < 2; ++n) acc[a][b][m][n] = (f32x4){0.f, 0.f, 0.f, 0.f};
        cur = nxt; cA = nA; cB = nB; ++ui;
    }
    PG8_WAIT_V(0);
    if (wr == 0) PG8_BAR;
    PG8_BAR;
    if constexpr (Epi::AFTER_DRAIN) E.fused(acc, cur, wr, wc, fr, fq, lds);
#undef PG8_SA
#undef PG8_SB
#undef PG8_STAGE
#undef PG8_LDA
#undef PG8_LDB
#undef PG8_MMA
#undef PG8_WAIT_V
#undef PG8_WAIT_L
#undef PG8_BAR
#undef PG8_SCHED
}
template <class Epi, class Sched>
__device__ __forceinline__ void gemm_phase(LAS unsigned char* lds, const Gemm g, const Sched& S, const Epi& E) {
    f32x4 acc[2][2][4][2];
    gemm_phase_acc<Epi, Sched, true>(lds, g, S, E, acc);
}
}
using pg8::Unit;

struct SchedG1 {
    int c;
    __device__ __forceinline__ bool next(int i, Unit& u) const {
        const int xcd = c & 7, slot = c >> 3, pmt = xcd * 8 + (slot >> 2), j = slot & 3;
        if (i < 2) { u.pm = pmt; u.pn = 72 + i * 4 + j; return true; }
        if (i == 2) { u.pm = 72 + 8 + j; u.pn = pmt; return true; }
        if (i == 3) {
            if (j < 2) { u.pm = pmt; u.pn = 72 + 20 + j; return true; }
            if (j == 2) { int cu = pmt;
                if (cu < 32) { u.pm = 64 + (cu >> 2); u.pn = 72 + 4 + (cu & 3); }
                else { cu -= 32; u.pm = 72 + 8 + (cu & 3); u.pn = 64 + (cu >> 2); }
                return true; }
        }
        return false;
    }
};
struct SchedG2 {
    int c;
    __device__ __forceinline__ bool next(int i, Unit& u) const {
        const int xcd = c & 7, slot = c >> 3, pmt = xcd * 8 + (slot >> 2), j = slot & 3;
        u.pm = pmt;
        if (i == 0) { u.pn = 72 + 12 + j; return true; }
        if (i == 1) { u.pn = 72 + 16 + j; return true; }
        if (i == 2) { u.pn = 72 + 24 + j; return true; }
        if (i == 3) { u.pn = 72 + 28 + j; return true; }
        return false;
    }
};
struct SchedOne {
    int pm, pn;
    __device__ __forceinline__ bool next(int i, Unit& u) const { if (i == 0) { u.pm = pm; u.pn = pn; return true; } return false; }
};
struct Sched64 {
    int c, ncol;
    __device__ __forceinline__ bool next(int i, Unit& u) const {
        const int xcd = c & 7, slot = c >> 3, pmt = xcd * 8 + (slot >> 2), j = slot & 3;
        if (i == 0 && j < ncol) { u.pm = pmt; u.pn = j; return true; }
        return false;
    }
};

struct EpiG1 {
    static constexpr bool AFTER_DRAIN = false;
    static constexpr bool DRAIN = false;
    unsigned char* ws;
    __device__ __forceinline__ void operator()(const f32x4 (&acc)[2][2][4][2], const Unit& u, int wr, int wc, int fr, int fq) const {
        const bool sw = u.pm >= 72;
        const int tokt = sw ? u.pn : u.pm, wt = (sw ? u.pm : u.pn) - 72;
        bf16_t* base; int ld; float sc = 1.0f; int rowbase;
        if (!sw) {
            rowbase = tokt * 256;
            if (wt < 4) { base = (bf16_t*)(ws + OFF_Q) + (size_t)(tokt * 4 + wt) * 65536 + ((wr * 4 + wc) * 16 * 64 + (fq * 16 + fr)) * 8; ld = 0; }
            else if (wt < 8) { sc = 0.0625f; ld = 0;
                if (tokt < 64) base = (bf16_t*)(ws + OFF_K) + (size_t)((tokt * 2) * 4 + (wt - 4)) * 32768;
                else base = (bf16_t*)(ws + OFF_KC) + (size_t)(((tokt - 64) * 2) * 4 + (wt - 4)) * 32768; }
            else { base = (bf16_t*)(ws + OFF_P); ld = 0; }
        } else {
            rowbase = (wt - 8) * 256;
            if (tokt < 64) base = (bf16_t*)(ws + OFF_VT) + (size_t)(tokt * 2) * 1024 * 128;
            else base = (bf16_t*)(ws + OFF_VTC) + (size_t)((tokt - 64) * 2) * 1024 * 128;
            ld = 128;
        }
        const int row0 = rowbase + wr * 64 + fr, col0 = wc * 32 + 8 * fq;
        const size_t bjstep = sw ? (size_t)1024 * 128 : (wt >= 20 ? (size_t)16 * 2048 * 8 : (wt >= 4 && wt < 8 ? (size_t)4 * 512 : (wt < 4 ? (size_t)512 : (size_t)128)));
#pragma unroll
        for (int ai = 0; ai < 2; ++ai)
#pragma unroll
            for (int m = 0; m < 4; ++m) {
                const bool isp = !sw && wt >= 20, isk = !sw && wt >= 4 && wt < 8, isq = !sw && wt < 4;
                bf16_t* rowp = sw ? base + (size_t)((((rowbase + wr * 64 + ai * 128 + m * 16) >> 4) * 4 + wc) * 512 + (fr * 4 + fq) * 8)
                             : isq ? base + ((ai * 4 + m) * 2) * 512
                             : isk ? base + (size_t)(ai * 4 * 64 + (wr * 4 + m) * 8 + wc) * 512 + (fr * 4 + fq) * 8
                             : isp ? base + ((size_t)((tokt >> 3) * 64 + (wt - 20) * 32 + wc * 4 + fq) * 2048 + ((row0 + ai * 128 + m * 16) & 2047)) * 8
                                   : base + (size_t)(row0 + ai * 128 + m * 16) * ld + col0;
#pragma unroll
                for (int bj = 0; bj < 2; ++bj) { const f32x4 v0 = acc[ai][bj][m][0] * sc, v1 = acc[ai][bj][m][1] * sc;
                    u32x4 w; w.x = cvt_pk_bf16(v0[0], v0[1]); w.y = cvt_pk_bf16(v0[2], v0[3]); w.z = cvt_pk_bf16(v1[0], v1[1]); w.w = cvt_pk_bf16(v1[2], v1[3]);
                    *(u32x4*)(rowp + bj * bjstep) = w; } }
    }
};
struct EpiG2 {
    static constexpr bool AFTER_DRAIN = false;
    static constexpr bool DRAIN = true;
    unsigned char* ws; bf16_t* am;
    __device__ __forceinline__ void operator()(const f32x4 (&acc)[2][2][4][2], const Unit& u, int wr, int wc, int fr, int fq) const {
        const int wt = u.pn - 72;
        const int gl_off = ((wr * 4 + wc) * 16 * 64 + (fq * 16 + fr)) * 8;
        const int row0 = u.pm * 256 + wr * 64 + fr, col0 = wc * 32 + 8 * fq;
        const bf16_t* ldp = nullptr; bf16_t* stp; bool ld_lm = false, st_lm = false, act_silu = false, recip = false; int ld = 0;
        if (wt < 16) { bf16_t* t = (bf16_t*)(ws + OFF_Q) + (size_t)(u.pm * 4 + (wt - 12)) * 65536 + gl_off; ldp = t; stp = t; ld_lm = st_lm = true; }
        else if (wt < 20) { ldp = (const bf16_t*)(ws + OFF_Q) + (size_t)(u.pm * 4 + (wt - 16)) * 65536 + gl_off; ld_lm = true; stp = am + (wt - 16) * 256; ld = 1024; act_silu = true; }
        else if (wt < 24) { bf16_t* t = (bf16_t*)(ws + OFF_PM) + (wt - 22) * 256; ldp = t; stp = t; ld = 512; act_silu = true; }
        else if (wt < 28) { stp = (bf16_t*)(ws + OFF_GB) + (size_t)(u.pm * 8 + (wt - 24)) * 65536 + gl_off; st_lm = true; }
        else { bf16_t* t = (bf16_t*)(ws + OFF_GB) + (size_t)(u.pm * 8 + (wt - 24)) * 65536 + gl_off; stp = t; st_lm = true; ldp = t - 4 * 65536; ld_lm = true; recip = true; }
#pragma unroll
        for (int ai = 0; ai < 2; ++ai) {
            u32x4 old8[4][2];
            if (ldp) {
#pragma unroll
                for (int m = 0; m < 4; ++m)
#pragma unroll
                    for (int bj = 0; bj < 2; ++bj) old8[m][bj] = ld_lm ? *(const u32x4*)(ldp + ((ai * 4 + m) * 2 + bj) * 512)
                                                                       : *(const u32x4*)(ldp + (size_t)(row0 + ai * 128 + m * 16) * ld + col0 + bj * 128);
            }
#pragma unroll
            for (int m = 0; m < 4; ++m)
#pragma unroll
                for (int bj = 0; bj < 2; ++bj) { const f32x4 a0 = acc[ai][bj][m][0], a1 = acc[ai][bj][m][1];
                    float f[8];
#pragma unroll
                    for (int q = 0; q < 4; ++q) { f[q] = act_silu ? siluf(a0[q]) : sigm(a0[q]); f[4 + q] = act_silu ? siluf(a1[q]) : sigm(a1[q]); }
                    if (ldp) { const u32x4 o = old8[m][bj];
                        if (recip) { f[0] *= __builtin_amdgcn_rcpf(bf_lo(o.x)); f[1] *= __builtin_amdgcn_rcpf(bf_hi(o.x)); f[2] *= __builtin_amdgcn_rcpf(bf_lo(o.y)); f[3] *= __builtin_amdgcn_rcpf(bf_hi(o.y));
                            f[4] *= __builtin_amdgcn_rcpf(bf_lo(o.z)); f[5] *= __builtin_amdgcn_rcpf(bf_hi(o.z)); f[6] *= __builtin_amdgcn_rcpf(bf_lo(o.w)); f[7] *= __builtin_amdgcn_rcpf(bf_hi(o.w)); }
                        else { f[0] *= bf_lo(o.x); f[1] *= bf_hi(o.x); f[2] *= bf_lo(o.y); f[3] *= bf_hi(o.y); f[4] *= bf_lo(o.z); f[5] *= bf_hi(o.z); f[6] *= bf_lo(o.w); f[7] *= bf_hi(o.w); } }
                    u32x4 w; w.x = cvt_pk_bf16(f[0], f[1]); w.y = cvt_pk_bf16(f[2], f[3]); w.z = cvt_pk_bf16(f[4], f[5]); w.w = cvt_pk_bf16(f[6], f[7]);
                    if (st_lm) { if (recip) __builtin_nontemporal_store(w, (u32x4*)(stp + ((ai * 4 + m) * 2 + bj) * 512)); else *(u32x4*)(stp + ((ai * 4 + m) * 2 + bj) * 512) = w; }
                    else *(u32x4*)(stp + (size_t)(row0 + ai * 128 + m * 16) * ld + col0 + bj * 128) = w; } }
    }
};
struct EpiPool {
    static constexpr bool AFTER_DRAIN = false;
    static constexpr bool DRAIN = false;
    unsigned char* ws; const float* pool_scale;
    __device__ __forceinline__ void operator()(const f32x4 (&acc)[2][2][4][2], const Unit& u, int wr, int wc, int fr, int fq) const {
        bf16_t* base = (bf16_t*)(ws + OFF_PM) + u.pn * 256;
        const int row0 = u.pm * 256 + wr * 64 + fr, col0 = wc * 32 + 8 * fq;
        f32x4 s[2][2];
#pragma unroll
        for (int bj = 0; bj < 2; ++bj)
#pragma unroll
            for (int n = 0; n < 2; ++n) s[bj][n] = *(const f32x4*)(pool_scale + u.pn * 256 + col0 + bj * 128 + 4 * n);
#pragma unroll
        for (int ai = 0; ai < 2; ++ai)
#pragma unroll
            for (int m = 0; m < 4; ++m) { bf16_t* rowp = base + (size_t)(row0 + ai * 128 + m * 16) * 512 + col0;
#pragma unroll
                for (int bj = 0; bj < 2; ++bj) { const f32x4 v0 = acc[ai][bj][m][0] * s[bj][0], v1 = acc[ai][bj][m][1] * s[bj][1];
                    u32x4 w; w.x = cvt_pk_bf16(v0[0], v0[1]); w.y = cvt_pk_bf16(v0[2], v0[3]); w.z = cvt_pk_bf16(v1[0], v1[1]); w.w = cvt_pk_bf16(v1[2], v1[3]);
                    *(u32x4*)(rowp + bj * 128) = w; } }
    }
};
struct EpiMergeMid {
    static constexpr bool AFTER_DRAIN = false;
    static constexpr bool DRAIN = false;
    unsigned char* ws;
    __device__ __forceinline__ void operator()(f32x4 (&acc)[2][2][4][2], const Unit& u, int wr, int wc, int fr, int fq) const {
        const bf16_t* gr = (const bf16_t*)(ws + OFF_GB) + (size_t)(u.pm * 8 + 4 + u.pn) * 65536 + ((wr * 4 + wc) * 16 * 64 + (fq * 16 + fr)) * 8;
        const int row0 = u.pm * 256 + wr * 64 + fr, col0 = wc * 32 + 8 * fq;
#pragma unroll
        for (int ai = 0; ai < 2; ++ai) {
            u32x4 g8[4][2];
#pragma unroll
            for (int m = 0; m < 4; ++m)
#pragma unroll
                for (int bj = 0; bj < 2; ++bj) g8[m][bj] = __builtin_nontemporal_load((const u32x4*)(gr + ((ai * 4 + m) * 2 + bj) * 512));
#pragma unroll
            for (int m = 0; m < 4; ++m)
#pragma unroll
                for (int bj = 0; bj < 2; ++bj) { const u32x4 g = g8[m][bj];
                    acc[ai][bj][m][0] *= (f32x4){bf_lo(g.x), bf_hi(g.x), bf_lo(g.y), bf_hi(g.y)}; acc[ai][bj][m][1] *= (f32x4){bf_lo(g.z), bf_hi(g.z), bf_lo(g.w), bf_hi(g.w)}; } }
    }
};
struct EpiMergeFin {
    static constexpr bool AFTER_DRAIN = false;
    static constexpr bool DRAIN = false;
    unsigned char* ws;
    __device__ __forceinline__ void operator()(f32x4 (&acc)[2][2][4][2], const Unit& u, int wr, int wc, int fr, int fq) const {
        asm volatile("" : "+v"(fr), "+v"(fq));
        const bf16_t* gb = (const bf16_t*)(ws + OFF_GB) + (size_t)(u.pm * 8 + u.pn) * 65536 + ((wr * 4 + wc) * 16 * 64 + (fq * 16 + fr)) * 8;
        bf16_t* mg = (bf16_t*)(ws + OFF_MG) + u.pn * 256;
        const int row0 = u.pm * 256 + wr * 64 + fr, col0 = wc * 32 + 8 * fq;
#pragma unroll
        for (int ai = 0; ai < 2; ++ai) {
            u32x4 g8[4][2];
#pragma unroll
            for (int m = 0; m < 4; ++m)
#pragma unroll
                for (int bj = 0; bj < 2; ++bj) g8[m][bj] = __builtin_nontemporal_load((const u32x4*)(gb + ((ai * 4 + m) * 2 + bj) * 512));
#pragma unroll
            for (int m = 0; m < 4; ++m) { const size_t row = (size_t)(row0 + ai * 128 + m * 16);
#pragma unroll
                for (int bj = 0; bj < 2; ++bj) { const u32x4 g = g8[m][bj]; const f32x4 a0 = acc[ai][bj][m][0], a1 = acc[ai][bj][m][1];
                    u32x4 w; w.x = cvt_pk_bf16(a0[0] * bf_lo(g.x), a0[1] * bf_hi(g.x)); w.y = cvt_pk_bf16(a0[2] * bf_lo(g.y), a0[3] * bf_hi(g.y));
                    w.z = cvt_pk_bf16(a1[0] * bf_lo(g.z), a1[1] * bf_hi(g.z)); w.w = cvt_pk_bf16(a1[2] * bf_lo(g.w), a1[3] * bf_hi(g.w));
                    *(u32x4*)(mg + row * 1024 + col0 + bj * 128) = w; } } }
    }
};
struct EpiOut {
    static constexpr bool DRAIN = false;
    static constexpr bool AFTER_DRAIN = true;
    unsigned char* ws; const float* x; float* out; const float* fnw;
    __device__ __forceinline__ void operator()(f32x4 (&acc)[2][2][4][2], const Unit& u, int wr, int wc, int fr, int fq) const {}
    __device__ __forceinline__ void fused(f32x4 (&acc)[2][2][4][2], const Unit& u, int wr, int wc, int fr, int fq, LAS unsigned char* lds) const {
        const int b = u.pm >> 3;
        const float* gv = (const float*)(ws + OFF_GATEV) + b * 1024 + u.pn * 256;
        float* ssq = (float*)(ws + OFF_SSQ);
        unsigned* cnt = (unsigned*)(ws + OFF_PCNT) + 64 * u.pm;
        const int row0 = u.pm * 256 + wr * 64 + fr, col0 = wc * 32 + 8 * fq;
        f32x4 gg[2][2];
#pragma unroll
        for (int bj = 0; bj < 2; ++bj)
#pragma unroll
            for (int n = 0; n < 2; ++n) gg[bj][n] = *(const f32x4*)(gv + col0 + bj * 128 + 4 * n);
        f32x4 xb[2][2][2][2];
#define EO_LOAD(k) do { _Pragma("unroll") for (int m2 = 0; m2 < 2; ++m2) _Pragma("unroll") for (int bj = 0; bj < 2; ++bj) _Pragma("unroll") for (int n = 0; n < 2; ++n) \
            xb[(k) & 1][m2][bj][n] = __builtin_nontemporal_load((const f32x4*)(x + (size_t)(row0 + ((k) >> 1) * 128 + (((k) & 1) * 2 + m2) * 16) * 1024 + u.pn * 256 + col0 + bj * 128 + 4 * n)); } while (0)
        EO_LOAD(0);
#pragma unroll
        for (int k = 0; k < 4; ++k) { const int ai = k >> 1;
            if (k + 1 < 4) EO_LOAD(k + 1);
#pragma unroll
            for (int m2 = 0; m2 < 2; ++m2) { const int m = (k & 1) * 2 + m2; const size_t row = (size_t)(row0 + ai * 128 + m * 16); float s = 0.f;
#pragma unroll
                for (int bj = 0; bj < 2; ++bj)
#pragma unroll
                    for (int n = 0; n < 2; ++n) { const f32x4 o = xb[k & 1][m2][bj][n] + gg[bj][n] * acc[ai][bj][m][n];
                        acc[ai][bj][m][n] = o; s += (o[0] * o[0] + o[1] * o[1]) + (o[2] * o[2] + o[3] * o[3]); }
                s += __shfl_xor(s, 16); s += __shfl_xor(s, 32);
                if (fq == 0) __hip_atomic_store(ssq + row * 16 + u.pn * 4 + wc, s, __ATOMIC_RELAXED, __HIP_MEMORY_SCOPE_AGENT); } }
#undef EO_LOAD
        asm volatile("s_waitcnt vmcnt(0)" ::: "memory");
        const int lane = fr + 16 * fq, wid = wr * 4 + wc;
        if (lane == 0) __hip_atomic_fetch_add(cnt, 1u, __ATOMIC_RELAXED, __HIP_MEMORY_SCOPE_AGENT);
        if (wid == 0) {
            unsigned spins = 0;
            while ((unsigned)__builtin_amdgcn_readfirstlane(__hip_atomic_load(cnt, __ATOMIC_RELAXED, __HIP_MEMORY_SCOPE_AGENT)) < 32u) { __builtin_amdgcn_s_sleep(2); if (++spins > (1u << 20)) break; }
            __builtin_amdgcn_fence(__ATOMIC_ACQUIRE, "agent");
            asm volatile("s_waitcnt vmcnt(0)" ::: "memory");
        }
        __syncthreads();
        LAS float* rs = (LAS float*)lds;
        { const int t = wid * 64 + lane;
          if (t < 256) { const float* sp = ssq + (size_t)(u.pm * 256 + t) * 16;
            float tot = 0.f;
#pragma unroll
            for (int q = 0; q < 16; ++q) tot += __hip_atomic_load(sp + q, __ATOMIC_RELAXED, __HIP_MEMORY_SCOPE_AGENT);
            rs[t] = rsqrtf(tot * (1.0f / 1024.0f) + 1e-6f); } }
        __syncthreads();
        f32x4 fw[2][2];
#pragma unroll
        for (int bj = 0; bj < 2; ++bj)
#pragma unroll
            for (int n = 0; n < 2; ++n) fw[bj][n] = *(const f32x4*)(fnw + u.pn * 256 + col0 + bj * 128 + 4 * n);
#pragma unroll
        for (int ai = 0; ai < 2; ++ai)
#pragma unroll
            for (int m = 0; m < 4; ++m) { const int rl = wr * 64 + fr + ai * 128 + m * 16; const float r = rs[rl]; float* op = out + (size_t)(u.pm * 256 + rl) * 1024 + u.pn * 256 + col0;
#pragma unroll
                for (int bj = 0; bj < 2; ++bj)
#pragma unroll
                    for (int n = 0; n < 2; ++n) *(f32x4*)(op + bj * 128 + 4 * n) = acc[ai][bj][m][n] * r * fw[bj][n]; }
    }
};

__device__ __forceinline__ void transpose_tile(const float* src, int ld_src, int k0, int c0, bf16_t* dst, int ld_dst, int n0, LAS float* T) {
    const int tid = opaque_tid();
#pragma unroll
    for (int i = 0; i < 2; ++i) { const int r = (tid >> 4) + i * 32, c4 = (tid & 15) * 4;
        const f32x4 v = __builtin_nontemporal_load((const f32x4*)(src + (size_t)(k0 + r) * ld_src + c0 + c4));
        T[r * 65 + c4] = v[0]; T[r * 65 + c4 + 1] = v[1]; T[r * 65 + c4 + 2] = v[2]; T[r * 65 + c4 + 3] = v[3]; }
    __syncthreads();
    { const int n = tid >> 3, kc = (tid & 7) * 8; float f[8];
#pragma unroll
        for (int j = 0; j < 8; ++j) f[j] = T[(kc + j) * 65 + n];
        u32x4 w; w.x = cvt_pk_bf16(f[0], f[1]); w.y = cvt_pk_bf16(f[2], f[3]); w.z = cvt_pk_bf16(f[4], f[5]); w.w = cvt_pk_bf16(f[6], f[7]);
        *(u32x4*)(dst + (size_t)(n0 + n) * ld_dst + k0 + kc) = w; }
    __syncthreads();
}
__device__ __forceinline__ float wave_sum(float v) {
    v += __shfl_xor(v, 32); v += __shfl_xor(v, 16); v += __shfl_xor(v, 8); v += __shfl_xor(v, 4); v += __shfl_xor(v, 2); v += __shfl_xor(v, 1); return v;
}
__device__ __forceinline__ float log_sigmoid(float x) { return fminf(x, 0.f) - log1pf(expf(-fabsf(x))); }

__device__ void phase0(const Params& p, LAS unsigned char* lds) {
    const int tid = opaque_tid();
    LAS float* T = (LAS float*)lds;
    bf16_t* WinT = (bf16_t*)(p.ws + OFF_AB) + (size_t)18432 * 1024;
    float* modp = (float*)(p.ws + OFF_MODP);
    for (int job = blockIdx.x; job < 256; job += gridDim.x) {
        const int cgp = job & 31, ks = job >> 5;
        LAS float* sl = (LAS float*)lds;
        LAS float* red = sl + 9 * 128;
        for (int i = tid; i < 9 * 128; i += 512) { const int v = i >> 7, kk = i & 127; const float cv = v < 8 ? p.c[v * 1024 + ks * 128 + kk] : p.c_ctx[ks * 128 + kk]; sl[i] = cv / (1.0f + expf(-cv)); }
        __syncthreads();
        const int col = tid % 96, kr = tid / 96;
        float a0 = 0.f, a1 = 0.f, a2 = 0.f, a3 = 0.f, a4 = 0.f, a5 = 0.f, a6 = 0.f, a7 = 0.f, a8 = 0.f;
        if (kr < 5) {
#pragma unroll 1
            for (int k0 = kr; k0 < 128; k0 += 65) { float wv13[13];
#pragma unroll
                for (int q = 0; q < 13; ++q) { const int kk = k0 + 5 * q; wv13[q] = kk < 128 ? __builtin_nontemporal_load(p.ada_w + (size_t)(ks * 128 + kk) * 3072 + cgp * 96 + col) : 0.f; }
#pragma unroll
                for (int q = 0; q < 13; ++q) { const int kk = min(k0 + 5 * q, 127); const float wv = wv13[q];
                    a0 += sl[kk] * wv; a1 += sl[128 + kk] * wv; a2 += sl[256 + kk] * wv; a3 += sl[384 + kk] * wv; a4 += sl[512 + kk] * wv; a5 += sl[640 + kk] * wv; a6 += sl[768 + kk] * wv; a7 += sl[896 + kk] * wv; a8 += sl[1024 + kk] * wv; } }
            LAS float* rp = red + (kr * 9) * 96 + col;
            rp[0] = a0; rp[96] = a1; rp[192] = a2; rp[288] = a3; rp[384] = a4; rp[480] = a5; rp[576] = a6; rp[672] = a7; rp[768] = a8;
        }
        __syncthreads();
        for (int i = tid; i < 9 * 96; i += 512) { const int v = i / 96, cc = i % 96; float s = 0.f;
#pragma unroll
            for (int r = 0; r < 5; ++r) s += red[(r * 9 + v) * 96 + cc];
            __hip_atomic_store(&modp[(size_t)(ks * 9 + v) * 3072 + cgp * 96 + cc], s, __ATOMIC_RELAXED, __HIP_MEMORY_SCOPE_AGENT); }
        __syncthreads();
    }
    asm volatile("s_waitcnt vmcnt(0)" ::: "memory");
    __syncthreads();
    if (tid == 0) (void)__hip_atomic_fetch_add((unsigned*)(p.ws + OFF_ACNT), 1u, __ATOMIC_RELAXED, __HIP_MEMORY_SCOPE_AGENT);
    {
        const int r0 = tid >> 4, c4 = (tid & 15) * 4;
        int job = blockIdx.x;
        f32x4 va, vb;
        { const int kt = job & 15, ntile = job >> 4; const int n0 = ntile * 64, k0 = kt * 64; const int c0 = n0 < 5120 ? n0 : n0 + 16;
          va = __builtin_nontemporal_load((const f32x4*)(p.in_w + (size_t)(k0 + r0) * 8208 + c0 + c4)); vb = __builtin_nontemporal_load((const f32x4*)(p.in_w + (size_t)(k0 + r0 + 32) * 8208 + c0 + c4)); }
        for (; job < 2048; job += gridDim.x) {
            const int kt = job & 15, ntile = job >> 4; const int n0 = ntile * 64, k0 = kt * 64;
            T[r0 * 65 + c4] = va[0]; T[r0 * 65 + c4 + 1] = va[1]; T[r0 * 65 + c4 + 2] = va[2]; T[r0 * 65 + c4 + 3] = va[3];
            T[(r0 + 32) * 65 + c4] = vb[0]; T[(r0 + 32) * 65 + c4 + 1] = vb[1]; T[(r0 + 32) * 65 + c4 + 2] = vb[2]; T[(r0 + 32) * 65 + c4 + 3] = vb[3];
            __syncthreads();
            const int nj = job + gridDim.x;
            if (nj < 2048) { const int kt2 = nj & 15, nt2 = nj >> 4; const int n2 = nt2 * 64, k2 = kt2 * 64; const int c2 = n2 < 5120 ? n2 : n2 + 16;
                va = __builtin_nontemporal_load((const f32x4*)(p.in_w + (size_t)(k2 + r0) * 8208 + c2 + c4)); vb = __builtin_nontemporal_load((const f32x4*)(p.in_w + (size_t)(k2 + r0 + 32) * 8208 + c2 + c4)); }
            { const int n = tid >> 3, kc = (tid & 7) * 8; float f[8];
#pragma unroll
              for (int j = 0; j < 8; ++j) f[j] = T[(kc + j) * 65 + n];
              u32x4 w; w.x = cvt_pk_bf16(f[0], f[1]); w.y = cvt_pk_bf16(f[2], f[3]); w.z = cvt_pk_bf16(f[4], f[5]); w.w = cvt_pk_bf16(f[6], f[7]);
              *(u32x4*)(WinT + (size_t)(n0 + n) * 1024 + k0 + kc) = w; }
            __syncthreads();
        }
    }
}

__device__ __forceinline__ float dot4(const f32x4 a, const f32x4 b) { return (a[0] * b[0] + a[1] * b[1]) + (a[2] * b[2] + a[3] * b[3]); }
__device__ __forceinline__ float bfly16(const f32x4 p0, const f32x4 p1, const f32x4 p2, const f32x4 p3, int lane) {
    const bool b3 = lane & 8, b2 = lane & 4, b1 = lane & 2, b0 = lane & 1;
    const f32x4 s0 = b3 ? p0 : p2, s1 = b3 ? p1 : p3, k0 = b3 ? p2 : p0, k1 = b3 ? p3 : p1;
    f32x4 a, c;
    a[0] = k0[0] + __shfl_xor(s0[0], 8); a[1] = k0[1] + __shfl_xor(s0[1], 8); a[2] = k0[2] + __shfl_xor(s0[2], 8); a[3] = k0[3] + __shfl_xor(s0[3], 8);
    c[0] = k1[0] + __shfl_xor(s1[0], 8); c[1] = k1[1] + __shfl_xor(s1[1], 8); c[2] = k1[2] + __shfl_xor(s1[2], 8); c[3] = k1[3] + __shfl_xor(s1[3], 8);
    const f32x4 s4 = b2 ? a : c, k4 = b2 ? c : a;
    const float d0 = k4[0] + __shfl_xor(s4[0], 4), d1 = k4[1] + __shfl_xor(s4[1], 4), d2 = k4[2] + __shfl_xor(s4[2], 4), d3 = k4[3] + __shfl_xor(s4[3], 4);
    const float e0 = (b1 ? d2 : d0) + __shfl_xor(b1 ? d0 : d2, 2), e1 = (b1 ? d3 : d1) + __shfl_xor(b1 ? d1 : d3, 2);
    float q1 = (b0 ? e1 : e0) + __shfl_xor(b0 ? e0 : e1, 1);
    q1 += __shfl_xor(q1, 16); q1 += __shfl_xor(q1, 32);
    return q1;
}
__device__ __forceinline__ void norm_rows2(const f32x4 (&xa)[4], const f32x4 (&xb)[4], const LAS float* gsa, const LAS float* sha, const LAS float* gsb, const LAS float* shb, const LAS float* WgT,
                                           bf16_t* oa, bf16_t* ob, float* ga, float* gb, const float* gate_b, int lane) {
    float ssa = 0.f, ssb = 0.f;
#pragma unroll
    for (int i = 0; i < 4; ++i) { ssa += dot4(xa[i], xa[i]); ssb += dot4(xb[i], xb[i]); }
    ssa = wave_sum(ssa); ssb = wave_sum(ssb);
    const float ra = rsqrtf(ssa * (1.0f / 1024.0f) + 1e-6f), rb = rsqrtf(ssb * (1.0f / 1024.0f) + 1e-6f);
    f32x4 ya[4], yb[4];
#pragma unroll
    for (int i = 0; i < 4; ++i) {
        ya[i] = xa[i] * ra * *(const LAS f32x4*)(gsa + i * 256 + lane * 4) + *(const LAS f32x4*)(sha + i * 256 + lane * 4);
        yb[i] = xb[i] * rb * *(const LAS f32x4*)(gsb + i * 256 + lane * 4) + *(const LAS f32x4*)(shb + i * 256 + lane * 4);
        u32x2 w; w.x = cvt_pk_bf16(ya[i][0], ya[i][1]); w.y = cvt_pk_bf16(ya[i][2], ya[i][3]); *(u32x2*)(oa + i * 256 + lane * 4) = w;
        u32x2 v; v.x = cvt_pk_bf16(yb[i][0], yb[i][1]); v.y = cvt_pk_bf16(yb[i][2], yb[i][3]); *(u32x2*)(ob + i * 256 + lane * 4) = v; }
    f32x4 pa[4], pb[4];
#pragma unroll
    for (int jq = 0; jq < 4; ++jq) { f32x4 sa = (f32x4){0.f, 0.f, 0.f, 0.f}, sb = sa;
#pragma unroll
        for (int i = 0; i < 4; ++i) { const LAS float* wp = WgT + (jq * 4) * 1024 + i * 256 + lane * 4;
            const f32x4 w0 = *(const LAS f32x4*)wp, w1 = *(const LAS f32x4*)(wp + 1024), w2 = *(const LAS f32x4*)(wp + 2048), w3 = *(const LAS f32x4*)(wp + 3072);
            sa += (f32x4){dot4(ya[i], w0), dot4(ya[i], w1), dot4(ya[i], w2), dot4(ya[i], w3)};
            sb += (f32x4){dot4(yb[i], w0), dot4(yb[i], w1), dot4(yb[i], w2), dot4(yb[i], w3)}; }
        pa[jq] = sa; pb[jq] = sb; }
    const float qa = bfly16(pa[0], pa[1], pa[2], pa[3], lane), qb = bfly16(pb[0], pb[1], pb[2], pb[3], lane);
    if (lane < 16) { const float gbv = gate_b[lane]; const bool ls = (lane >> 2) & 1;
        const float prea = qa + gbv, preb = qb + gbv;
        ga[0] = ls ? log_sigmoid(prea) : prea; gb[0] = ls ? log_sigmoid(preb) : preb; }
}
__device__ void phase1(const Params& p, LAS unsigned char* lds) {
    const int tid = opaque_tid(), wid = tid >> 6, lane = tid & 63;
    LAS float* gs = (LAS float*)lds; LAS float* sh = gs + 1024; LAS float* gsc = sh + 1024; LAS float* shc = gsc + 1024; LAS float* WgT = shc + 1024;
    const float* modp = (const float*)(p.ws + OFF_MODP);
    bf16_t* AB = (bf16_t*)(p.ws + OFF_AB);
    if (tid < 64) {
        unsigned spins = 0;
        while ((unsigned)__builtin_amdgcn_readfirstlane(__hip_atomic_load((unsigned*)(p.ws + OFF_ACNT), __ATOMIC_RELAXED, __HIP_MEMORY_SCOPE_AGENT)) < gridDim.x) { __builtin_amdgcn_s_sleep(2); if (++spins > (1u << 22)) break; }
        __builtin_amdgcn_fence(__ATOMIC_ACQUIRE, "agent"); asm volatile("s_waitcnt vmcnt(0)" ::: "memory"); }
    __syncthreads();
    for (int job = blockIdx.x; job < 256; job += gridDim.x) {
        const int b = job >> 5;
        for (int i = tid; i < 1024; i += 512) {
            float s0 = p.ada_b[i], s1 = p.ada_b[1024 + i], s2 = p.ada_b[2048 + i], c0 = s0, c1 = s1;
#pragma unroll
            for (int ks = 0; ks < 8; ++ks) { const float* mp = modp + (size_t)(ks * 9 + b) * 3072; s0 += mp[i]; s1 += mp[1024 + i]; s2 += mp[2048 + i];
                const float* mc = modp + (size_t)(ks * 9 + 8) * 3072; c0 += mc[i]; c1 += mc[1024 + i]; }
            const float nw = p.norm_w[i];
            gs[i] = nw * (1.0f + s1); sh[i] = s0; gsc[i] = nw * (1.0f + c1); shc[i] = c0;
            if ((job & 31) == 0) ((float*)(p.ws + OFF_GATEV))[b * 1024 + i] = s2;
        }
        for (int i = tid; i < 16384; i += 512) { const int j = i & 15, k = i >> 4; WgT[j * 1024 + k] = p.in_w[(size_t)k * 8208 + 5120 + j]; }
        __syncthreads();
        const int crow = job * 8 + wid; const int cb = crow >> 8;
        float* gl = (float*)(p.ws + OFF_GL) + (size_t)b * 16 * 2048 + (size_t)lane * 2048; float* gc = (float*)(p.ws + OFF_GC) + (size_t)cb * 16 * 256 + (size_t)lane * 256 + (crow & 255);
        const int rbase = job * 64 + wid * 8;
#pragma unroll 1
        for (int pr = 0; pr < 5; ++pr) {
            const int ra_ = pr < 4 ? rbase + 2 * pr : rbase + 7;
            const float* xa_ = p.x + (size_t)ra_ * 1024; const float* xb_ = pr < 4 ? xa_ + 1024 : p.ctx + (size_t)crow * 1024;
            f32x4 xa[4], xb[4];
#pragma unroll
            for (int i = 0; i < 4; ++i) { xa[i] = __builtin_nontemporal_load((const f32x4*)(xa_ + i * 256 + lane * 4)); xb[i] = __builtin_nontemporal_load((const f32x4*)(xb_ + i * 256 + lane * 4)); }
            const LAS float* gsb_ = pr < 4 ? gs : gsc; const LAS float* shb_ = pr < 4 ? sh : shc;
            bf16_t* ob_ = pr < 4 ? AB + (size_t)(ra_ + 1) * 1024 : AB + (size_t)(16384 + crow) * 1024;
            float* gb_ = pr < 4 ? gl + ((ra_ + 1) & 2047) : gc;
            norm_rows2(xa, xb, gs, sh, gsb_, shb_, WgT, AB + (size_t)ra_ * 1024, ob_, gl + (ra_ & 2047), gb_, p.gate_b, lane);
        }
        __syncthreads();
    }
}

__device__ __forceinline__ bf16_t* cst_ptr(const Params& p, int sid, int chunk) {
    bf16_t* base = sid < 32 ? (bf16_t*)p.out : (bf16_t*)(p.ws + OFF_CST2);
    return base + ((size_t)((sid & 31) * 16 + chunk)) * 65536;
}
__device__ __forceinline__ void passA_chunk(const Params& p, int st, int b, int h, int dir, int vs, bool& isctx, int& ci, const bf16_t*& Kbase, const bf16_t*& Vbase) {
    isctx = st < 2;
    if (isctx) { ci = dir ? 1 - st : st;
        Kbase = (const bf16_t*)(p.ws + OFF_KC) + (size_t)((b * 2 + ci) * 4 + h) * 32768;
        Vbase = (const bf16_t*)(p.ws + OFF_VTC) + (size_t)(b * 2 + ci) * 131072 + (h * 16 + vs * 4) * 2048; }
    else { const int s2 = st - 2; ci = dir ? 15 - s2 : s2;
        Kbase = (const bf16_t*)(p.ws + OFF_K) + (size_t)((b * 16 + ci) * 4 + h) * 32768;
        Vbase = (const bf16_t*)(p.ws + OFF_VT) + (size_t)(b * 16 + ci) * 131072 + (h * 16 + vs * 4) * 2048; }
}
__device__ void passA(const Params& p, LAS unsigned char* lds, int wg) {
    const int tid = opaque_tid(), wid = tid >> 6, lane = tid & 63, fr = lane & 15, fq = lane >> 4;
    const int sid = wg >> 2, vs = wg & 3; const int b = sid >> 3, h = (sid >> 1) & 3, dir = sid & 1;
    LAS bf16_t* Kt = (LAS bf16_t*)lds;
    LAS bf16_t* Ve = Kt + 256 * 136;
    LAS float* eA = (LAS float*)(lds + 87040);
    LAS float* bendA = eA + 18 * 128; LAS float* maxwA = bendA + 32; LAS float* decayA = maxwA + 32; LAS float* mprevA = decayA + 32; LAS float* mnewA = mprevA + 32;
    LAS bf16_t* eB = (LAS bf16_t*)(mnewA + 32);
    const float* GL = (const float*)(p.ws + OFF_GL); const float* GC = (const float*)(p.ws + OFF_GC);
    for (int st = wid; st < 18; st += 8) {
        const bool isctx = st < 2; const int ci = isctx ? (dir ? 1 - st : st) : (dir ? 15 - (st - 2) : st - 2);
        const int T = isctx ? 256 : 2048; const float* G = isctx ? GC + (size_t)b * 16 * 256 : GL + (size_t)b * 16 * 2048;
        const float* pli = G + (size_t)(dir * 8 + h) * T + ci * 128; const float* plf = G + (size_t)(dir * 8 + 4 + h) * T + ci * 128;
        const int s0 = dir ? 127 - 2 * lane : 2 * lane, s1 = dir ? 126 - 2 * lane : 2 * lane + 1;
        const float lf0 = plf[s0], lf1 = plf[s1], li0 = pli[s0], li1 = pli[s1];
        const float p1 = lf0 + lf1; float inc = p1;
#pragma unroll
        for (int off = 1; off < 64; off <<= 1) { const float n = __shfl_up(inc, off); inc += (lane >= off) ? n : 0.f; }
        const float bend = __shfl(inc, 63);
        const float b0 = inc - p1 + lf0, b1 = inc;
        const float w0 = bend - b0 + li0, w1 = bend - b1 + li1;
        float mx = fmaxf(w0, w1);
#pragma unroll
        for (int off = 32; off > 0; off >>= 1) mx = fmaxf(mx, __shfl_xor(mx, off));
        eA[st * 128 + s0] = w0; eA[st * 128 + s1] = w1;
        if (lane == 0) { bendA[st] = bend; maxwA[st] = mx; }
    }
    __syncthreads();
    if (tid == 0) { float m = -1e30f;
        for (int st = 0; st < 18; ++st) { mprevA[st] = m; const float mn = fmaxf(bendA[st] + m, maxwA[st]); decayA[st] = expf(bendA[st] + m - mn); mnewA[st] = mn; m = mn; } }
    __syncthreads();
    for (int i = tid; i < 18 * 128; i += 512) { const float e = expf(eA[i] - mnewA[i >> 7]); eA[i] = e; eB[i] = (bf16_t)(cvt_pk_bf16(e, 0.f) & 0xffffu); }
    __syncthreads();
    f32x4 nacc[2] = {(f32x4){0.f, 0.f, 0.f, 0.f}, (f32x4){0.f, 0.f, 0.f, 0.f}};
    f32x4 acc[2][4];
#pragma unroll
    for (int a = 0; a < 2; ++a)
#pragma unroll
        for (int v = 0; v < 4; ++v) acc[a][v] = (f32x4){0.f, 0.f, 0.f, 0.f};
    u32x4 vr[2], kr[2][4];
    { bool ic; int ci; const bf16_t* Kb; const bf16_t* Vb; passA_chunk(p, 0, b, h, dir, vs, ic, ci, Kb, Vb);
#pragma unroll
        for (int rep = 0; rep < 2; ++rep) { const int it = tid + rep * 512;
            vr[rep] = *(const u32x4*)(Vb + (size_t)it * 8);
            const int sq = (it & 15) | (((it >> 6) & 1) << 4), ko = ((it >> 4) & 3) | ((it >> 7) << 2); const bf16_t* src = Kb + (size_t)((sq >> 2) * 8 + (ko >> 2)) * 512 + ((sq & 3) * 16 + (ko & 3)) * 8;
            kr[rep][0] = *(const u32x4*)src; kr[rep][1] = *(const u32x4*)(src + 32); kr[rep][2] = *(const u32x4*)(src + 64); kr[rep][3] = *(const u32x4*)(src + 96); } }
    for (int st = 0; st < 18; ++st) {
        bool isctx; int ci; const bf16_t* Kb; const bf16_t* Vb; passA_chunk(p, st, b, h, dir, vs, isctx, ci, Kb, Vb);
        if (!isctx) {
            bf16_t* cs = cst_ptr(p, sid, ci);
#pragma unroll
            for (int vt = 0; vt < 4; ++vt) { u32x4 w; w.x = cvt_pk_bf16(acc[0][vt][0], acc[0][vt][1]); w.y = cvt_pk_bf16(acc[0][vt][2], acc[0][vt][3]);
                w.z = cvt_pk_bf16(acc[1][vt][0], acc[1][vt][1]); w.w = cvt_pk_bf16(acc[1][vt][2], acc[1][vt][3]);
                __builtin_nontemporal_store(w, (u32x4*)(cs + (size_t)((vs * 4 + vt) * 8 + wid) * 512 + (fr * 4 + fq) * 8)); }
            if (vs == 0) { if (fr == 0) { float* np = (float*)(p.ws + OFF_NST) + (size_t)(sid * 16 + ci) * 256 + wid * 32 + fq * 8; *(f32x4*)np = nacc[0]; *(f32x4*)(np + 4) = nacc[1]; }
                if (tid == 0) ((float*)(p.ws + OFF_MST))[sid * 16 + ci] = mprevA[st]; }
        }
        if (st == 17) break;
        const LAS float* e_s = eA + st * 128; const float decay = decayA[st];
#pragma unroll
        for (int rep = 0; rep < 2; ++rep) { const int it = tid + rep * 512; const int v = (it >> 8) * 16 + ((it >> 2) & 15), sg = ((it >> 6) & 3) * 32 + (it & 3) * 8;
            const u32x4 raw = vr[rep];
            u32x4 w; w.x = cvt_pk_bf16(bf_lo(raw.x) * e_s[sg], bf_hi(raw.x) * e_s[sg + 1]); w.y = cvt_pk_bf16(bf_lo(raw.y) * e_s[sg + 2], bf_hi(raw.y) * e_s[sg + 3]);
            w.z = cvt_pk_bf16(bf_lo(raw.z) * e_s[sg + 4], bf_hi(raw.z) * e_s[sg + 5]); w.w = cvt_pk_bf16(bf_lo(raw.w) * e_s[sg + 6], bf_hi(raw.w) * e_s[sg + 7]);
            *(LAS u32x4*)(Ve + v * 136 + sg) = w; }
#pragma unroll
        for (int rep = 0; rep < 2; ++rep) { const int it = tid + rep * 512; const int sq = (it & 15) | (((it >> 6) & 1) << 4), ko = ((it >> 4) & 3) | ((it >> 7) << 2);
            const u32x4 r0 = kr[rep][0], r1 = kr[rep][1], r2 = kr[rep][2], r3 = kr[rep][3];
            LAS bf16_t* dst = Kt + (ko * 8) * 136 + sq * 4;
#define TRW(j, a0, a1, a2, a3, HI) { u32x2 w; if (HI) { w.x = (a0 >> 16) | (a1 & 0xffff0000u); w.y = (a2 >> 16) | (a3 & 0xffff0000u); } else { w.x = (a0 & 0xffffu) | (a1 << 16); w.y = (a2 & 0xffffu) | (a3 << 16); } *(LAS u32x2*)(dst + (j) * 136) = w; }
            TRW(0, r0.x, r1.x, r2.x, r3.x, 0) TRW(1, r0.x, r1.x, r2.x, r3.x, 1) TRW(2, r0.y, r1.y, r2.y, r3.y, 0) TRW(3, r0.y, r1.y, r2.y, r3.y, 1)
            TRW(4, r0.z, r1.z, r2.z, r3.z, 0) TRW(5, r0.z, r1.z, r2.z, r3.z, 1) TRW(6, r0.w, r1.w, r2.w, r3.w, 0) TRW(7, r0.w, r1.w, r2.w, r3.w, 1)
#undef TRW
        }
        __syncthreads();
        if (st + 1 < 17) {
            bool ic2; int ci2; const bf16_t* Kb2; const bf16_t* Vb2; passA_chunk(p, st + 1, b, h, dir, vs, ic2, ci2, Kb2, Vb2);
#pragma unroll
            for (int rep = 0; rep < 2; ++rep) { const int it = tid + rep * 512;
                vr[rep] = *(const u32x4*)(Vb2 + (size_t)it * 8);
                const int sq = (it & 15) | (((it >> 6) & 1) << 4), ko = ((it >> 4) & 3) | ((it >> 7) << 2); const bf16_t* src = Kb2 + (size_t)((sq >> 2) * 8 + (ko >> 2)) * 512 + ((sq & 3) * 16 + (ko & 3)) * 8;
                kr[rep][0] = *(const u32x4*)src; kr[rep][1] = *(const u32x4*)(src + 32); kr[rep][2] = *(const u32x4*)(src + 64); kr[rep][3] = *(const u32x4*)(src + 96); } }
#pragma unroll
        for (int a = 0; a < 2; ++a) { nacc[a] *= decay;
#pragma unroll
            for (int v = 0; v < 4; ++v) acc[a][v] *= decay; }
#pragma unroll
        for (int ks = 0; ks < 4; ++ks) { bf16x8 kf[2], vf[4];
#pragma unroll
            for (int kt = 0; kt < 2; ++kt) kf[kt] = *(const LAS bf16x8*)(Kt + (wid * 32 + 8 * (fr >> 2) + 4 * kt + (fr & 3)) * 136 + ks * 32 + fq * 8);
#pragma unroll
            for (int vt = 0; vt < 4; ++vt) vf[vt] = *(const LAS bf16x8*)(Ve + (vt * 16 + fr) * 136 + ks * 32 + fq * 8);
            bf16x8 ef = *(const LAS bf16x8*)(eB + st * 128 + ks * 32 + fq * 8);
            if (fr != 0) ef = (bf16x8){0, 0, 0, 0, 0, 0, 0, 0};
#pragma unroll
            for (int kt = 0; kt < 2; ++kt) {
#pragma unroll
                for (int vt = 0; vt < 4; ++vt) acc[kt][vt] = __builtin_amdgcn_mfma_f32_16x16x32_bf16(kf[kt], vf[vt], acc[kt][vt], 0, 0, 0);
                nacc[kt] = __builtin_amdgcn_mfma_f32_16x16x32_bf16(kf[kt], ef, nacc[kt], 0, 0, 0); } }
        __syncthreads();
    }
    __syncthreads();
}

__device__ void boxfilter_unit(const Params& p, LAS unsigned char* lds, int u) {
    const int tid = opaque_tid();
    const int b = u >> 6, g = (u >> 4) & 3, cb = u & 15; const int hw = 1 << g;
    LAS float* X = (LAS float*)lds; LAS float* Y = X + 2048 * 8;
    const bf16_t* src = (const bf16_t*)(p.ws + OFF_P) + (size_t)(b * 64 + g * 16 + cb) * 2048 * 8;
    bf16_t* dst = (bf16_t*)(p.ws + OFF_MX) + (size_t)(b * 2048) * 512 + g * 128 + cb * 8;
#pragma unroll
    for (int i = 0; i < 4; ++i) { const int tok = tid + 512 * i; const u32x4 v = __builtin_nontemporal_load((const u32x4*)(src + (size_t)tok * 8));
        *(LAS f32x4*)(X + tok * 8) = (f32x4){bf_lo(v.x), bf_hi(v.x), bf_lo(v.y), bf_hi(v.y)}; *(LAS f32x4*)(X + tok * 8 + 4) = (f32x4){bf_lo(v.z), bf_hi(v.z), bf_lo(v.w), bf_hi(v.w)}; }
    __syncthreads();
    for (int i = 0; i < 4; ++i) { const int tok = tid + 512 * i; const int r = tok >> 6, c = tok & 63; const int lo = max(r - hw, 0), hi = min(r + hw, 32);
        f32x4 s0 = (f32x4){0.f, 0.f, 0.f, 0.f}, s1 = s0;
        for (int rr = lo; rr < hi; ++rr) { s0 += *(const LAS f32x4*)(X + (rr * 64 + c) * 8); s1 += *(const LAS f32x4*)(X + (rr * 64 + c) * 8 + 4); }
        const float cnt = (float)(hi - lo);
        *(LAS f32x4*)(Y + tok * 8) = s0 / cnt; *(LAS f32x4*)(Y + tok * 8 + 4) = s1 / cnt; }
    __syncthreads();
    for (int i = 0; i < 4; ++i) { const int tok = tid + 512 * i; const int r = tok >> 6, c = tok & 63; const int lo = max(c - hw, 0), hi = min(c + hw, 64);
        f32x4 s0 = (f32x4){0.f, 0.f, 0.f, 0.f}, s1 = s0;
        for (int cc = lo; cc < hi; ++cc) { s0 += *(const LAS f32x4*)(Y + (r * 64 + cc) * 8); s1 += *(const LAS f32x4*)(Y + (r * 64 + cc) * 8 + 4); }
        const float cnt = (float)(hi - lo);
        const f32x4 m0 = s0 / cnt - *(const LAS f32x4*)(X + tok * 8), m1 = s1 / cnt - *(const LAS f32x4*)(X + tok * 8 + 4);
        u32x4 w; w.x = cvt_pk_bf16(m0[0], m0[1]); w.y = cvt_pk_bf16(m0[2], m0[3]); w.z = cvt_pk_bf16(m1[0], m1[1]); w.w = cvt_pk_bf16(m1[2], m1[3]);
        *(u32x4*)(dst + (size_t)tok * 512) = w; }
    __syncthreads();
}

__device__ void passB_unit(const Params& p, LAS unsigned char* lds, int u, bool do_store = true) {
    const int tid = opaque_tid(), wid = tid >> 6, lane = tid & 63, fr = lane & 15, fq = lane >> 4;
    const int b = u >> 6, h = (u >> 4) & 3, c = u & 15;
    const int tokbase = b * 2048 + c * 128;
    LAS bf16_t* Qs = (LAS bf16_t*)lds;
    LAS bf16_t* Pd = Qs + 128 * 264;
    LAS float* fl = (LAS float*)(lds + 137216);
    LAS float* lfA = fl; LAS float* liA = fl + 256; LAS float* aA = fl + 512; LAS float* MA = fl + 768; LAS float* winA = fl + 1024; LAS float* clampA = fl + 1280;
    LAS float* nqA = fl + 1536; LAS float* nvec = fl + 1792; LAS float* rsP = fl + 2304; LAS float* ssP = fl + 3328;
    const float* GL = (const float*)(p.ws + OFF_GL) + (size_t)b * 16 * 2048 + c * 128;
    bf16_t* Qg = (bf16_t*)(p.ws + OFF_Q) + (size_t)((tokbase >> 8) * 4 + h) * 65536 + (c & 1) * 8 * 512;
    const int sid0 = (b * 4 + h) * 2;
    LAS float* wtot = lfA; LAS float* wmax = lfA + 8;
    float sc_b = 0.f, sc_li = 0.f; int sc_t = 0;
    if (tid < 256) { const int d = tid >> 7, i = tid & 127; sc_t = d ? 127 - i : i;
        sc_li = GL[(size_t)(d * 8 + h) * 2048 + sc_t]; float inc = GL[(size_t)(d * 8 + 4 + h) * 2048 + sc_t];
#pragma unroll
        for (int off = 1; off < 64; off <<= 1) { const float n = __shfl_up(inc, off); inc += (lane >= off) ? n : 0.f; }
        sc_b = inc; if (lane == 63) wtot[wid] = inc; }
    { const int d = tid >> 8, k = tid & 255; nvec[tid] = ((const float*)(p.ws + OFF_NST))[(size_t)((sid0 + d) * 16 + c) * 256 + k]; }
#pragma unroll
    for (int i = 0; i < 8; ++i) { const int id = tid + 512 * i; const int w = id >> 9, m = (id >> 7) & 3, bj = (id >> 6) & 1, ln = id & 63;
        *(LAS u32x4*)(Qs + ((w >> 2) * 64 + m * 16 + (ln & 15)) * 264 + bj * 128 + (w & 3) * 32 + (ln >> 4) * 8) = __builtin_nontemporal_load((const u32x4*)(Qg + (size_t)((w * 16 + m * 2 + bj) * 64 + ln) * 8)); }
    __syncthreads();
    float sc_a = 0.f, sc_pm = 0.f;
    if (tid < 256) { if (wid & 1) sc_b += wtot[wid - 1];
        sc_a = sc_li - sc_b; float pm = sc_a;
#pragma unroll
        for (int off = 1; off < 64; off <<= 1) { const float n = __shfl_up(pm, off); pm = (lane >= off) ? fmaxf(pm, n) : pm; }
        sc_pm = pm; if (lane == 63) wmax[wid] = pm; }
    __syncthreads();
    const int wt2 = wid >> 2, w4 = wid & 3;
    const bf16_t* Kg = (const bf16_t*)(p.ws + OFF_K) + (size_t)((b * 16 + c) * 4 + h) * 32768 + (size_t)(w4 * 2 * 8) * 512 + (fr * 4 + fq) * 8;
    bf16x8 kfa[8][2];
#pragma unroll
    for (int ks = 0; ks < 8; ++ks)
#pragma unroll
        for (int nt = 0; nt < 2; ++nt) kfa[ks][nt] = *(const bf16x8*)(Kg + (size_t)(nt * 8 + ks) * 512);
    if (tid < 256) { const int d = tid >> 7, t = sc_t; if (wid & 1) sc_pm = fmaxf(sc_pm, wmax[wid - 1]);
        const float mc = ((const float*)(p.ws + OFF_MST))[(sid0 + d) * 16 + c];
        const float Mt = fmaxf(mc, sc_pm); const int dt = d * 128 + t;
        aA[dt] = sc_a; MA[dt] = Mt; winA[dt] = expf(mc - Mt); clampA[dt] = expf(-(sc_b + Mt));
        float s = 0.f; const LAS float* nv = nvec + d * 256;
#pragma unroll 4
        for (int k8 = 0; k8 < 32; ++k8) { const u32x4 qv = *(const LAS u32x4*)(Qs + t * 264 + k8 * 8); const LAS float* np = nv + k8 * 8;
            s += bf_lo(qv.x) * np[0] + bf_hi(qv.x) * np[1] + bf_lo(qv.y) * np[2] + bf_hi(qv.y) * np[3] + bf_lo(qv.z) * np[4] + bf_hi(qv.z) * np[5] + bf_lo(qv.w) * np[6] + bf_hi(qv.w) * np[7]; }
        nqA[dt] = s; }
    __syncthreads();
    const bf16_t* Cd0 = cst_ptr(p, sid0, c) + (size_t)(w4 * 32) * 512 + (fr * 4 + fq) * 8;
    const bf16_t* Cd1 = cst_ptr(p, sid0 + 1, c) + (size_t)(w4 * 32) * 512 + (fr * 4 + fq) * 8;
    const bf16_t* Vd = (const bf16_t*)(p.ws + OFF_VT) + (size_t)(b * 16 + c) * 131072 + (h * 16 + w4 * 4) * 2048 + (fr * 4 + fq) * 8;
    bf16x8 F[3][4][2];
#define PB_ISSUE(q) do { const int _nh = (q) / 6, _d = ((q) % 6) / 3, _kind = (q) % 3; \
        _Pragma("unroll") for (int ks = 0; ks < 4; ++ks) _Pragma("unroll") for (int n2 = 0; n2 < 2; ++n2) \
            F[(q) % 3][ks][n2] = (_kind < 2) ? __builtin_nontemporal_load((const bf16x8*)((_d ? Cd1 : Cd0) + (size_t)((_nh * 2 + n2) * 8 + _kind * 4 + ks) * 512)) \
                                            : *(const bf16x8*)(Vd + (size_t)((_nh * 2 + n2) * 4 + ks) * 512); } while (0)
    {
        f32x4 sacc[4][2];
#pragma unroll
        for (int mt = 0; mt < 4; ++mt)
#pragma unroll
            for (int nt = 0; nt < 2; ++nt) sacc[mt][nt] = (f32x4){0.f, 0.f, 0.f, 0.f};
#pragma unroll
        for (int ks = 0; ks < 8; ++ks) { bf16x8 qf[4];
#pragma unroll
            for (int mt = 0; mt < 4; ++mt) qf[mt] = *(const LAS bf16x8*)(Qs + (wt2 * 64 + mt * 16 + fr) * 264 + ks * 32 + fq * 8);
#pragma unroll
            for (int mt = 0; mt < 4; ++mt)
#pragma unroll
                for (int nt = 0; nt < 2; ++nt) sacc[mt][nt] = __builtin_amdgcn_mfma_f32_16x16x32_bf16(kfa[ks][nt], qf[mt], sacc[mt][nt], 0, 0, 0); }
        PB_ISSUE(0); PB_ISSUE(1);
        __builtin_amdgcn_sched_barrier(0);
#pragma unroll
        for (int mt = 0; mt < 4; ++mt) { const int t = wt2 * 64 + mt * 16 + fr; const float Mf = MA[t], Mb = MA[128 + t]; float rf = 0.f, rb = 0.f;
#pragma unroll
            for (int nt = 0; nt < 2; ++nt) { const int s0 = w4 * 32 + nt * 16 + fq * 4; float pf[4], pb[4];
#pragma unroll
                for (int r = 0; r < 4; ++r) { const int s = s0 + r; const float val = sacc[mt][nt][r];
                    const float ef = __expf(fminf(aA[s] - Mf, 0.f)), eb = __expf(fminf(aA[128 + s] - Mb, 0.f));
                    pf[r] = (s <= t) ? val * ef : 0.f; pb[r] = (s >= t) ? val * eb : 0.f; rf += pf[r]; rb += pb[r]; }
                u32x2 wf, wb; wf.x = cvt_pk_bf16(pf[0], pf[1]); wf.y = cvt_pk_bf16(pf[2], pf[3]); wb.x = cvt_pk_bf16(pb[0], pb[1]); wb.y = cvt_pk_bf16(pb[2], pb[3]);
                *(LAS u32x2*)(Pd + t * 136 + s0) = wf; *(LAS u32x2*)(Pd + 128 * 136 + t * 136 + s0) = wb; }
            rf += __shfl_xor(rf, 16); rf += __shfl_xor(rf, 32); rb += __shfl_xor(rb, 16); rb += __shfl_xor(rb, 32);
            if (fq == 0) { rsP[w4 * 128 + t] = rf; rsP[512 + w4 * 128 + t] = rb; } }
    }
    __syncthreads();
    LAS float* invA = fl + 3840;
    if (tid < 256) { const int d = tid >> 7, t = tid & 127;
        const float den = winA[tid] * nqA[tid] + ((rsP[d * 512 + t] + rsP[d * 512 + 128 + t]) + (rsP[d * 512 + 256 + t] + rsP[d * 512 + 384 + t]));
        invA[tid] = 1.0f / fmaxf(fabsf(den), clampA[tid]); }
    __syncthreads();
    f32x4 hsum[4][4], acc[4][2];
#pragma unroll
    for (int q = 0; q < 12; ++q) {
        const int nh = q / 6, d = (q % 6) / 3, kind = q % 3;
        if (q + 2 < 12) PB_ISSUE(q + 2);
        __builtin_amdgcn_sched_barrier(0);
        if (kind == 0) {
#pragma unroll
            for (int mt = 0; mt < 4; ++mt)
#pragma unroll
                for (int n2 = 0; n2 < 2; ++n2) { acc[mt][n2] = (f32x4){0.f, 0.f, 0.f, 0.f}; if (d == 0) hsum[mt][nh * 2 + n2] = (f32x4){0.f, 0.f, 0.f, 0.f}; }
        }
        if (kind < 2) {
#pragma unroll
            for (int ks = 0; ks < 4; ++ks) { bf16x8 qf[4];
#pragma unroll
                for (int mt = 0; mt < 4; ++mt) qf[mt] = *(const LAS bf16x8*)(Qs + (wt2 * 64 + mt * 16 + fr) * 264 + (kind * 4 + ks) * 32 + fq * 8);
#pragma unroll
                for (int mt = 0; mt < 4; ++mt)
#pragma unroll
                    for (int n2 = 0; n2 < 2; ++n2) acc[mt][n2] = __builtin_amdgcn_mfma_f32_16x16x32_bf16(F[q % 3][ks][n2], qf[mt], acc[mt][n2], 0, 0, 0); }
        } else {
            const LAS bf16_t* Pp = Pd + d * 128 * 136;
#pragma unroll
            for (int mt = 0; mt < 4; ++mt) { const float wv = winA[d * 128 + wt2 * 64 + mt * 16 + fr];
#pragma unroll
                for (int n2 = 0; n2 < 2; ++n2) acc[mt][n2] *= wv; }
#pragma unroll
            for (int ks = 0; ks < 4; ++ks) { bf16x8 pf[4];
#pragma unroll
                for (int mt = 0; mt < 4; ++mt) pf[mt] = *(const LAS bf16x8*)(Pp + (wt2 * 64 + mt * 16 + fr) * 136 + ks * 32 + fq * 8);
#pragma unroll
                for (int mt = 0; mt < 4; ++mt)
#pragma unroll
                    for (int n2 = 0; n2 < 2; ++n2) acc[mt][n2] = __builtin_amdgcn_mfma_f32_16x16x32_bf16(F[q % 3][ks][n2], pf[mt], acc[mt][n2], 0, 0, 0); }
#pragma unroll
            for (int mt = 0; mt < 4; ++mt) { const float iv = invA[d * 128 + wt2 * 64 + mt * 16 + fr];
#pragma unroll
                for (int n2 = 0; n2 < 2; ++n2) hsum[mt][nh * 2 + n2] += acc[mt][n2] * iv; }
        }
    }
#undef PB_ISSUE
#pragma unroll
    for (int mt = 0; mt < 4; ++mt) { float sv = 0.f;
#pragma unroll
        for (int nt = 0; nt < 4; ++nt) { const f32x4 hv = hsum[mt][nt]; sv += (hv[0] * hv[0] + hv[1] * hv[1]) + (hv[2] * hv[2] + hv[3] * hv[3]); }
        sv += __shfl_xor(sv, 16); sv += __shfl_xor(sv, 32);
        if (fq == 0) ssP[w4 * 128 + wt2 * 64 + mt * 16 + fr] = sv; }
    __syncthreads();
#pragma unroll
    for (int mt = 0; mt < 4; ++mt) { const int t = wt2 * 64 + mt * 16 + fr;
        const float tot = (ssP[t] + ssP[128 + t]) + (ssP[256 + t] + ssP[384 + t]); const float rinv = rsqrtf(tot * (1.0f / 256.0f) + 1e-6f);
#pragma unroll
        for (int nt = 0; nt < 4; ++nt) { const int v = w4 * 64 + nt * 16 + fq * 4; const f32x4 hw = *(const f32x4*)(p.head_norm_w + h * 256 + v);
            const f32x4 o = hsum[mt][nt] * rinv * hw;
            u32x2 w; w.x = cvt_pk_bf16(o[0], o[1]); w.y = cvt_pk_bf16(o[2], o[3]);
            *(LAS u32x2*)(Pd + t * 264 + v) = w; } }
    __syncthreads();
    __builtin_amdgcn_sched_barrier(0);
    if (do_store) {
#pragma unroll 2
        for (int i = 0; i < 8; ++i) { const int id = tid + 512 * i; const int w = id >> 9, m = (id >> 7) & 3, bj = (id >> 6) & 1, ln = id & 63;
            *(u32x4*)(Qg + (size_t)((w * 16 + m * 2 + bj) * 64 + ln) * 8) = *(const LAS u32x4*)(Pd + ((w >> 2) * 64 + m * 16 + (ln & 15)) * 264 + bj * 128 + (w & 3) * 32 + (ln >> 4) * 8); } }
    __syncthreads();
}

__device__ void phase_final(const Params& p) {
    const int tid = opaque_tid(), wid = tid >> 6, lane = tid & 63;
    const float* ssq = (const float*)(p.ws + OFF_SSQ);
    for (int row = blockIdx.x * 8 + wid; row < 16384; row += gridDim.x * 8) {
        const f32x4 s0 = *(const f32x4*)(ssq + (size_t)row * 16), s1 = *(const f32x4*)(ssq + (size_t)row * 16 + 4), s2 = *(const f32x4*)(ssq + (size_t)row * 16 + 8), s3 = *(const f32x4*)(ssq + (size_t)row * 16 + 12);
        const float tot = ((s0[0] + s0[1]) + (s0[2] + s0[3])) + ((s1[0] + s1[1]) + (s1[2] + s1[3])) + ((s2[0] + s2[1]) + (s2[2] + s2[3])) + ((s3[0] + s3[1]) + (s3[2] + s3[3]));
        const float rstd = rsqrtf(tot * (1.0f / 1024.0f) + 1e-6f);
        float* orow = p.out + (size_t)row * 1024;
#pragma unroll
        for (int i = 0; i < 4; ++i) { const f32x4 v = *(const f32x4*)(orow + i * 256 + lane * 4); const f32x4 w = *(const f32x4*)(p.final_norm_w + i * 256 + lane * 4);
            *(f32x4*)(orow + i * 256 + lane * 4) = v * rstd * w; }
    }
}


#define XB_TMO      128
#define XB_XCNT(j)  (256  + 64 * (j))
#define XB_XSUB(j)  (1280 + 64 * (j))
#define XB_XGEN(j)  (2304 + 64 * (j))
#define XB_TOP      3328
#define XB_TOPGEN   3392
#define XCD_BAR_WORDS 3456
#define XB_SPIN_CAP (1u << 18)
__device__ __forceinline__ unsigned xb_ld(unsigned* p)              { return __hip_atomic_load(p, __ATOMIC_RELAXED, __HIP_MEMORY_SCOPE_AGENT); }
__device__ __forceinline__ unsigned xb_add(unsigned* p, unsigned v) { return __hip_atomic_fetch_add(p, v, __ATOMIC_RELAXED, __HIP_MEMORY_SCOPE_AGENT); }
__device__ __forceinline__ unsigned xb_xcc_id() { return (unsigned)__builtin_amdgcn_s_getreg((3 << 11) | 20) & 0xFu; }
#define XB_SPIN(cond, bar) do { unsigned _sp = 0; while (cond) { __builtin_amdgcn_s_sleep(1); \
    if ((++_sp & 255u) == 0u) { if (xb_ld(&(bar)[XB_TMO])) break; if (_sp > XB_SPIN_CAP) { atomicAdd(&(bar)[XB_TMO], 1u); break; } } } } while (0)
struct XcdBarrier { unsigned* bar; unsigned x; volatile LAS unsigned* st; };
__device__ __forceinline__ XcdBarrier xcd_barrier_post(unsigned* bar, volatile LAS unsigned* st) {
    XcdBarrier b; b.bar = bar; b.x = xb_xcc_id(); b.st = st;
    if (threadIdx.x == 0) (void)xb_add(&bar[XB_XCNT(b.x)], 1u);
    return b;
}
__device__ __forceinline__ void xcd_barrier_complete(unsigned* bar, unsigned x, unsigned& nloc, unsigned& nx) {
    const unsigned G = gridDim.x * gridDim.y * gridDim.z;
    unsigned sum, cnt, mine, sp = 0u;
    for (;;) {
        sum = 0u; cnt = 0u; mine = 0u;
#pragma unroll
        for (unsigned j = 0; j < 16; ++j) { const unsigned c = xb_ld(&bar[XB_XCNT(j)]); sum += c; cnt += (c > 0u) ? 1u : 0u; mine = (j == x) ? c : mine; }
        if (sum == G) break;
        __builtin_amdgcn_s_sleep(1);
        if ((++sp & 255u) == 0u) { if (xb_ld(&bar[XB_TMO])) break; if (sp > XB_SPIN_CAP) { atomicAdd(&bar[XB_TMO], 1u); break; } }
    }
    nloc = mine > 0u ? mine : 1u; nx = cnt > 0u ? cnt : 1u;
}
__device__ __forceinline__ void xcd_barrier(const XcdBarrier& b) {
    asm volatile("s_waitcnt vmcnt(0)" ::: "memory");
    __syncthreads();
    if (threadIdx.x == 0) {
        unsigned* bar = b.bar;
        __builtin_amdgcn_s_waitcnt(0);
        unsigned nloc = b.st[0], nx = b.st[1];
        if (nloc == 0u) { xcd_barrier_complete(bar, b.x, nloc, nx); b.st[0] = nloc; b.st[1] = nx; }
        const unsigned old = xb_add(&bar[XB_XSUB(b.x)], 1u);
        const unsigned gen = old / nloc;
        if (old + 1u == (gen + 1u) * nloc) {
            __builtin_amdgcn_fence(__ATOMIC_RELEASE, "agent");
            asm volatile("s_waitcnt vmcnt(0)" ::: "memory");
            const unsigned og = xb_add(&bar[XB_TOP], 1u);
            const unsigned tg = og / nx;
            if (og + 1u == (tg + 1u) * nx) xb_add(&bar[XB_TOPGEN], 1u);
            else XB_SPIN(xb_ld(&bar[XB_TOPGEN]) == tg, bar);
            __builtin_amdgcn_fence(__ATOMIC_ACQUIRE, "agent");
            xb_add(&bar[XB_XGEN(b.x)], 1u);
            asm volatile("s_waitcnt vmcnt(0)" ::: "memory");
        } else {
            XB_SPIN(xb_ld(&bar[XB_XGEN(b.x)]) == gen, bar);
            __builtin_amdgcn_fence(__ATOMIC_ACQUIRE, "agent");
            asm volatile("s_waitcnt vmcnt(0)" ::: "memory");
        }
    }
    __syncthreads();
}

__device__ __forceinline__ void run_phase(const Params& p, LAS unsigned char* lds, int ph) {
    const int tid = opaque_tid();
    const bf16_t* AB = (const bf16_t*)(p.ws + OFF_AB);
    switch (ph) {
    case 0: phase0(p, lds); break;
    case 1: phase1(p, lds); break;
    case 2: { SchedG1 S{(int)blockIdx.x}; EpiG1 E{p.ws}; pg8::gemm_phase(lds, pg8::Gemm{AB, AB, 1024}, S, E); } break;
    case 3: {
        { const int c3 = blockIdx.x, xcd = c3 & 7, sl = c3 >> 3;
          passA(p, lds, (xcd * 8 + (sl >> 2)) * 4 + (sl & 3));
          const int G = (sl >> 2) * 8 + xcd, mem = sl & 3;
          boxfilter_unit(p, lds, G * 4 + mem); boxfilter_unit(p, lds, (127 - G) * 4 + mem); }
        bf16_t* bt = (bf16_t*)(p.ws + OFF_BTPOOL);
        for (int idx = blockIdx.x * 512 + tid; idx < 512 * 512; idx += NWG * 512) { const int n = idx >> 9, k = idx & 511; const int gn = n >> 7, gk = k >> 7;
            const float v = (gn == gk) ? p.pool_w[(size_t)(gn * 128 + (k & 127)) * 128 + (n & 127)] : 0.f;
            bt[idx] = (bf16_t)(cvt_pk_bf16(v, 0.f) & 0xffffu); }
    } break;
    case 4: {
        const int c4 = blockIdx.x, pmt = (c4 & 7) * 8 + (c4 >> 5), j = (c4 >> 3) & 3;
        unsigned* flags = (unsigned*)(p.ws + OFF_PFLAG);
        if (j < 2) {
            Sched64 S{c4, 2}; EpiPool E{p.ws, p.pool_scale};
            pg8::gemm_phase(lds, pg8::Gemm{(const bf16_t*)(p.ws + OFF_MX), (const bf16_t*)(p.ws + OFF_BTPOOL), 512}, S, E);
            asm volatile("s_waitcnt vmcnt(0)" ::: "memory");
            __syncthreads();
            if (threadIdx.x == 0) { __builtin_amdgcn_fence(__ATOMIC_RELEASE, "agent"); asm volatile("s_waitcnt vmcnt(0)" ::: "memory");
                __hip_atomic_store(flags + 64 * (pmt * 2 + j), 1u, __ATOMIC_RELAXED, __HIP_MEMORY_SCOPE_AGENT); }
        }
        passB_unit(p, lds, c4 * 2); passB_unit(p, lds, c4 * 2 + 1);
        if (j < 2) {
            LAS float* T = (LAS float*)lds; const int w128 = pmt * 2 + j;
            for (int job = w128; job < 640; job += 128) {
                if (job < 256) { const int kt = job & 15, ntile = job >> 4; transpose_tile(p.branch_m_w, 1024, kt * 64, ntile * 64, (bf16_t*)(p.ws + OFF_WMT), 1024, ntile * 64, T); }
                else if (job < 512) { const int j2 = job - 256; const int kt = j2 & 15, ntile = j2 >> 4; transpose_tile(p.out_w, 1024, kt * 64, ntile * 64, (bf16_t*)(p.ws + OFF_WOT), 1024, ntile * 64, T); }
                else { const int j2 = job - 512; const int kt = j2 & 7, ntile = j2 >> 3; transpose_tile(p.branch_p_w, 1024, kt * 64, ntile * 64, (bf16_t*)(p.ws + OFF_WPT), 512, ntile * 64, T); }
            }
        }
        if (j >= 2) {
            if (threadIdx.x < 64) { unsigned spins = 0;
                while ((unsigned)__builtin_amdgcn_readfirstlane(__hip_atomic_load(flags + 64 * (pmt * 2 + j - 2), __ATOMIC_RELAXED, __HIP_MEMORY_SCOPE_AGENT)) == 0u) { __builtin_amdgcn_s_sleep(2); if (++spins > (1u << 22)) break; }
                __builtin_amdgcn_fence(__ATOMIC_ACQUIRE, "agent"); asm volatile("s_waitcnt vmcnt(0)" ::: "memory"); }
            __syncthreads();
            SchedOne S{pmt, 72 + 22 + (j - 2)}; EpiG2 E{p.ws, (bf16_t*)p.out};
            pg8::gemm_phase(lds, pg8::Gemm{AB, AB, 1024}, S, E);
        }
    } break;
    case 5: {
        SchedG2 S{(int)blockIdx.x}; EpiG2 E{p.ws, (bf16_t*)p.out}; pg8::gemm_phase(lds, pg8::Gemm{AB, AB, 1024}, S, E);
    } break;
    case 6: {
        Sched64 S{(int)blockIdx.x, 4};
        f32x4 macc[2][2][4][2];
        { EpiMergeMid E{p.ws}; pg8::gemm_phase_acc<EpiMergeMid, Sched64, true>(lds, pg8::Gemm{(const bf16_t*)(p.ws + OFF_PM), (const bf16_t*)(p.ws + OFF_WPT), 512}, S, E, macc); }
        { EpiMergeFin E{p.ws}; pg8::gemm_phase_acc<EpiMergeFin, Sched64, false>(lds, pg8::Gemm{(const bf16_t*)p.out, (const bf16_t*)(p.ws + OFF_WMT), 1024}, S, E, macc); }
    } break;
    case 7: { Sched64 S{(int)blockIdx.x, 4}; EpiOut E{p.ws, p.x, p.out, p.final_norm_w}; pg8::gemm_phase(lds, pg8::Gemm{(const bf16_t*)(p.ws + OFF_MG), (const bf16_t*)(p.ws + OFF_WOT), 1024}, S, E); } break;
    case 8: phase_final(p); break;
    default: break;
    }
}
#if MULTI_LAUNCH
template <int PH> __global__ void __launch_bounds__(512, 2) k_one(Params p) {
    extern __shared__ __attribute__((aligned(16))) unsigned char shm[];
    run_phase(p, (LAS unsigned char*)shm, PH);
}
#else
__global__ void __launch_bounds__(512, 2) fwd_megakernel(Params p) {
    extern __shared__ __attribute__((aligned(16))) unsigned char shm[];
    LAS unsigned char* lds = (LAS unsigned char*)shm;
    cg::grid_group grid = cg::this_grid();
    volatile LAS unsigned* xbst = (volatile LAS unsigned*)(lds + LDS_BYTES - 16);
    if (threadIdx.x == 0) { xbst[0] = 0u; xbst[1] = 0u; }
    __syncthreads();
    const XcdBarrier xb = xcd_barrier_post((unsigned*)(p.ws + OFF_BAR), xbst);
    if (p.ph_lo == 0x7fffffff) grid.sync();
    run_phase(p, lds, 0);
    run_phase(p, lds, 1); xcd_barrier(xb);
    run_phase(p, lds, 2); xcd_barrier(xb);
#ifdef PROBE_G1
    run_phase(p, lds, 2); xcd_barrier(xb);
#endif
    run_phase(p, lds, 3); xcd_barrier(xb);
#ifdef PROBE_A
    passA(p, lds, blockIdx.x); xcd_barrier(xb);
#endif
#ifdef PROBE_BOX
    boxfilter_unit(p, lds, blockIdx.x); boxfilter_unit(p, lds, 511 - blockIdx.x); xcd_barrier(xb);
#endif
    run_phase(p, lds, 4); xcd_barrier(xb);
    run_phase(p, lds, 5); xcd_barrier(xb);
    run_phase(p, lds, 6); xcd_barrier(xb);
    run_phase(p, lds, 7);
}
#endif

extern "C" void kernel_launch(void* const* d_in, const int* in_sizes, int n_in, void* d_out, int out_size, void* d_ws, size_t ws_size, hipStream_t stream) {
#if MULTI_LAUNCH
#define SETATTR(PH) (void)hipFuncSetAttribute((const void*)k_one<PH>, hipFuncAttributeMaxDynamicSharedMemorySize, LDS_BYTES)
    static int configured = 0;
    if (!configured) { SETATTR(0); SETATTR(1); SETATTR(2); SETATTR(3); SETATTR(4); SETATTR(5); SETATTR(6); SETATTR(7); SETATTR(8); configured = 1; }
#else
    static int configured = 0;
    if (!configured) {
        (void)hipFuncSetAttribute((const void*)fwd_megakernel, hipFuncAttributeMaxDynamicSharedMemorySize, LDS_BYTES);
        int dev = 0, cus = 0, per_cu = 0;
        (void)hipGetDevice(&dev); (void)hipDeviceGetAttribute(&cus, hipDeviceAttributeMultiprocessorCount, dev);
        (void)hipOccupancyMaxActiveBlocksPerMultiprocessor(&per_cu, fwd_megakernel, 512, LDS_BYTES);
        if (cus * per_cu < NWG) fprintf(stderr, "grid %d exceeds resident capacity %d x %d\n", NWG, cus, per_cu);
        if (ws_size < 256 * MiB) fprintf(stderr, "workspace too small: %zu\n", ws_size);
        configured = 1;
    }
#endif
    Params p{};
    p.x = (const float*)d_in[0]; p.c = (const float*)d_in[1]; p.ctx = (const float*)d_in[2]; p.c_ctx = (const float*)d_in[3]; p.norm_w = (const float*)d_in[4];
    p.ada_w = (const float*)d_in[5]; p.ada_b = (const float*)d_in[6]; p.in_w = (const float*)d_in[7]; p.gate_b = (const float*)d_in[8]; p.head_norm_w = (const float*)d_in[9];
    p.pool_w = (const float*)d_in[10]; p.pool_scale = (const float*)d_in[11]; p.branch_m_w = (const float*)d_in[12]; p.branch_p_w = (const float*)d_in[13]; p.out_w = (const float*)d_in[14];
    p.final_norm_w = (const float*)d_in[15];
    p.out = (float*)d_out; p.ws = (unsigned char*)d_ws;
#if MULTI_LAUNCH
    (void)hipMemsetAsync((unsigned char*)d_ws + OFF_BAR, 0, 65536, stream);
#define LAUNCH(PH) hipLaunchKernelGGL(k_one<PH>, dim3(NWG), dim3(512), LDS_BYTES, stream, p)
    LAUNCH(0); LAUNCH(1); LAUNCH(2); LAUNCH(3); LAUNCH(4); LAUNCH(5); LAUNCH(6); LAUNCH(7);
#else
    p.ph_lo = 0; p.ph_hi = 8;
    (void)hipMemsetAsync((unsigned char*)d_ws + OFF_BAR, 0, 65536, stream);
    void* args[] = {&p};
    hipError_t e = hipLaunchCooperativeKernel((const void*)fwd_megakernel, dim3(NWG), dim3(512), args, LDS_BYTES, stream);
    if (e != hipSuccess) fprintf(stderr, "cooperative launch failed: %s\n", hipGetErrorString(e));
#endif
}
```
